# Optimizing an MI355X kernel written in HIP

```python
import math
import jax, jax.numpy as jnp
from jax import lax
import numpy as np

D_MODEL = 1024
BATCH = 2
SEQ = 8192
DEPTH = 1

CHUNK = 64
EPS = 1e-6

SSD_D_INNER = D_MODEL
SSD_HEAD_DIM = 64
SSD_HEADS = SSD_D_INNER // SSD_HEAD_DIM
SSD_GROUPS = 2
SSD_HEADS_PER_GROUP = SSD_HEADS // SSD_GROUPS
SSD_STATE = 128
SSD_CONV = 4
SSD_CONV_DIM = SSD_D_INNER + 2 * SSD_GROUPS * SSD_STATE

MLA_HEADS = 8
MLA_Q_RANK = 384
MLA_KV_RANK = 256
MLA_NOPE = 128
MLA_ROPE = 64
MLA_QK_DIM = MLA_NOPE + MLA_ROPE
MLA_V = 128
ROPE_BASE = 10000.0
Q_BLOCK = 128

N_EXPERTS = 32
TOP_K = 4
EXPERT_FF = D_MODEL
SWIGLU_ALPHA = 1.702
SWIGLU_LIMIT = 7.0
MOE_BLOCK = 128

N_BRANCHES = 2
OFF_XBC = SSD_D_INNER
OFF_DT = OFF_XBC + SSD_CONV_DIM
OFF_QLAT = OFF_DT + SSD_HEADS
OFF_KVLAT = OFF_QLAT + MLA_Q_RANK
OFF_KROPE = OFF_KVLAT + MLA_KV_RANK
OFF_GATE = OFF_KROPE + MLA_ROPE
IN_DIM = OFF_GATE + N_BRANCHES * D_MODEL

kernel_name = 'hybrid_ssd_mla_moe_block'


def rms_norm(x, gain):
    xf = x.astype(jnp.float32)
    y = xf * lax.rsqrt(jnp.mean(xf * xf, axis=-1, keepdims=True) + EPS)
    return y.astype(x.dtype) * gain


def rope_tables(seq):
    pos = jnp.arange(seq, dtype=jnp.float32)
    inv = ROPE_BASE ** (-jnp.arange(0, MLA_ROPE, 2, dtype=jnp.float32) / MLA_ROPE)
    ang = pos[:, None] * inv[None, :]
    return jnp.cos(ang), jnp.sin(ang)


def apply_rope(x, cos, sin):
    half = MLA_ROPE // 2
    x1, x2 = x[..., :half], x[..., half:]
    c = cos[None, :, None, :].astype(x.dtype)
    s = sin[None, :, None, :].astype(x.dtype)
    return jnp.concatenate([x1 * c - x2 * s, x2 * c + x1 * s], axis=-1)


def ssd_scan(x, dt, a, bm, cm):
    b, s = x.shape[0], x.shape[1]
    nc = s // CHUNK
    xc = x.reshape(b, nc, CHUNK, SSD_GROUPS, SSD_HEADS_PER_GROUP, SSD_HEAD_DIM)
    dtc = dt.reshape(b, nc, CHUNK, SSD_GROUPS, SSD_HEADS_PER_GROUP)
    xdt = xc * dtc[..., None]
    da = (dtc * a.reshape(SSD_GROUPS, SSD_HEADS_PER_GROUP)).transpose(0, 3, 4, 1, 2)
    bc = bm.reshape(b, nc, CHUNK, SSD_GROUPS, SSD_STATE)
    cc = cm.reshape(b, nc, CHUNK, SSD_GROUPS, SSD_STATE)
    a_cum = jnp.cumsum(da, axis=-1)
    seg = a_cum[..., :, None] - a_cum[..., None, :]
    tri = jnp.tril(jnp.ones((CHUNK, CHUNK), dtype=bool))
    lmat = jnp.exp(jnp.where(tri, seg, -jnp.inf))
    cb = jnp.einsum('bclgn,bcsgn->bgcls', cc, bc)
    y_diag = jnp.einsum('bgecls,bcsgep->bclgep', cb[:, :, None] * lmat, xdt)
    decay_states = jnp.exp(a_cum[..., -1:] - a_cum)
    states = jnp.einsum('bcsgn,bgecs,bcsgep->cbgepn', bc, decay_states, xdt)
    chunk_decay = jnp.moveaxis(jnp.exp(a_cum[..., -1]), -1, 0)

    def step(h, inp):
        st, dec = inp
        return dec[..., None, None] * h + st, h

    _, prev = lax.scan(step, jnp.zeros_like(states[0]), (states, chunk_decay))
    y_off = jnp.einsum('bclgn,cbgepn,bgecl->bclgep', cc, prev, jnp.exp(a_cum))
    return (y_diag + y_off).reshape(b, s, SSD_HEADS, SSD_HEAD_DIM)


def ssd_branch(z, xbc, dt_raw, conv_w, conv_b, dt_bias, a_log, d_skip, g_out):
    b, s, _ = xbc.shape
    xbc = lax.conv_general_dilated(
        xbc, conv_w[:, None, :].astype(xbc.dtype), window_strides=(1,),
        padding=[(SSD_CONV - 1, 0)], dimension_numbers=('NWC', 'WIO', 'NWC'),
        feature_group_count=SSD_CONV_DIM) + conv_b
    xbc = jax.nn.silu(xbc)
    xs = xbc[..., :SSD_D_INNER]
    bm = xbc[..., SSD_D_INNER:SSD_D_INNER + SSD_GROUPS * SSD_STATE]
    cm = xbc[..., SSD_D_INNER + SSD_GROUPS * SSD_STATE:]
    xh = xs.reshape(b, s, SSD_HEADS, SSD_HEAD_DIM).astype(jnp.float32)
    dt = jax.nn.softplus(dt_raw.astype(jnp.float32) + dt_bias.astype(jnp.float32))
    a = -jnp.exp(a_log.astype(jnp.float32))
    y = ssd_scan(xh, dt, a,
                 bm.reshape(b, s, SSD_GROUPS, SSD_STATE).astype(jnp.float32),
                 cm.reshape(b, s, SSD_GROUPS, SSD_STATE).astype(jnp.float32))
    y = y + d_skip.astype(jnp.float32)[:, None] * xh
    y = y.reshape(b, s, SSD_D_INNER).astype(z.dtype) * jax.nn.silu(z)
    y = rms_norm(y.reshape(b, s, SSD_GROUPS, SSD_D_INNER // SSD_GROUPS),
                 g_out.reshape(SSD_GROUPS, SSD_D_INNER // SSD_GROUPS))
    return y.reshape(b, s, SSD_D_INNER)


def mla_branch(q_lat, kv_lat, k_rope, g_q_lat, w_q_up, g_kv_lat, w_kv_up, g_qk_q, g_qk_k):
    b, s, _ = q_lat.shape
    q = (rms_norm(q_lat, g_q_lat) @ w_q_up).reshape(b, s, MLA_HEADS, MLA_QK_DIM)
    kv = (rms_norm(kv_lat, g_kv_lat) @ w_kv_up).reshape(b, s, MLA_HEADS, MLA_NOPE + MLA_V)
    k_nope, v = kv[..., :MLA_NOPE], kv[..., MLA_NOPE:]
    k = jnp.concatenate(
        [k_nope, jnp.broadcast_to(k_rope[:, :, None, :], (b, s, MLA_HEADS, MLA_ROPE))], axis=-1)
    q = rms_norm(q, g_qk_q)
    k = rms_norm(k, g_qk_k)
    cos, sin = rope_tables(s)
    q = jnp.concatenate([q[..., :MLA_NOPE], apply_rope(q[..., MLA_NOPE:], cos, sin)], axis=-1)
    k = jnp.concatenate([k[..., :MLA_NOPE], apply_rope(k[..., MLA_NOPE:], cos, sin)], axis=-1)
    q = q.transpose(0, 2, 1, 3)
    k = k.transpose(0, 2, 1, 3)
    v = v.transpose(0, 2, 1, 3)
    scale = MLA_QK_DIM ** -0.5
    chunk_id = jnp.arange(s) // CHUNK
    outs = []
    for j in range(s // Q_BLOCK):
        lo, hi = j * Q_BLOCK, (j + 1) * Q_BLOCK
        sc = jnp.einsum('bhqd,bhkd->bhqk', q[:, :, lo:hi], k[:, :, :hi]).astype(jnp.float32) * scale
        mask = chunk_id[:hi][None, :] <= chunk_id[lo:hi][:, None]
        p = jax.nn.softmax(jnp.where(mask, sc, -jnp.inf), axis=-1)
        outs.append(jnp.einsum('bhqk,bhkd->bhqd', p.astype(v.dtype), v[:, :, :hi]))
    o = jnp.concatenate(outs, axis=2)
    return o.transpose(0, 2, 1, 3).reshape(b, s, MLA_HEADS * MLA_V)


def moe(h, w_router, b_router, w_gate_up, b_gate_up, w_down, b_down):
    t, d = h.shape
    logits = (h @ w_router + b_router).astype(jnp.float32)
    top_vals, top_idx = lax.top_k(logits, TOP_K)
    gates = jax.nn.softmax(top_vals, axis=-1).astype(h.dtype)
    n_assign = t * TOP_K
    flat_e = top_idx.reshape(-1)
    order = jnp.argsort(flat_e)
    sorted_e = flat_e[order]
    tok = order // TOP_K
    gates_sorted = gates.reshape(-1)[order]
    counts = jnp.bincount(flat_e, length=N_EXPERTS)
    padded = ((counts + MOE_BLOCK - 1) // MOE_BLOCK) * MOE_BLOCK
    pad_end = jnp.cumsum(padded)
    pad_start = pad_end - padded
    start = jnp.cumsum(counts) - counts
    dest = pad_start[sorted_e] + (jnp.arange(n_assign) - start[sorted_e])
    n_blocks = -(-n_assign // MOE_BLOCK) + N_EXPERTS
    rows = n_blocks * MOE_BLOCK
    xs = jnp.zeros((rows, d), h.dtype).at[dest].set(h[tok])
    block_e = jnp.minimum(
        jnp.searchsorted(pad_end, jnp.arange(n_blocks) * MOE_BLOCK, side='right'), N_EXPERTS - 1)

    def expert_block(args):
        xb, e = args
        gu = xb @ w_gate_up[e] + b_gate_up[e]
        glu = jnp.minimum(gu[..., :EXPERT_FF], SWIGLU_LIMIT)
        lin = jnp.clip(gu[..., EXPERT_FF:], -SWIGLU_LIMIT, SWIGLU_LIMIT)
        act = glu * jax.nn.sigmoid(SWIGLU_ALPHA * glu) * (lin + 1.0)
        return act @ w_down[e] + b_down[e]

    ys = lax.map(expert_block, (xs.reshape(n_blocks, MOE_BLOCK, d), block_e)).reshape(rows, d)
    y_assign = ys[dest] * gates_sorted[:, None]
    return jax.ops.segment_sum(y_assign, tok, num_segments=t)


def setup_inputs(seed: int = 0) -> dict:
    key = jax.random.key(seed)
    ks = jax.random.split(key, 32)
    f32 = jnp.float32
    L = DEPTH

    def normal(k, shape, fan_in):
        return jax.random.normal(k, shape, f32) * fan_in ** -0.5

    def gain(k, shape):
        return 1.0 + 0.1 * jax.random.normal(k, shape, f32)

    def bias(k, shape):
        return 0.01 * jax.random.normal(k, shape, f32)

    dt0 = jnp.exp(jax.random.uniform(ks[5], (L, SSD_HEADS), f32, math.log(1e-3), math.log(1e-1)))
    return {
        'x': jax.random.normal(ks[0], (BATCH, SEQ, D_MODEL), f32),
        'g_mix': gain(ks[1], (L, D_MODEL)),
        'w_in': normal(ks[2], (L, D_MODEL, IN_DIM), D_MODEL),
        'conv_w': normal(ks[3], (L, SSD_CONV, SSD_CONV_DIM), SSD_CONV),
        'conv_b': bias(ks[4], (L, SSD_CONV_DIM)),
        'dt_bias': dt0 + jnp.log(-jnp.expm1(-dt0)),
        'a_log': jnp.log(jax.random.uniform(ks[6], (L, SSD_HEADS), f32, 1.0, 16.0)),
        'd_skip': gain(ks[7], (L, SSD_HEADS)),
        'g_ssd_out': gain(ks[8], (L, SSD_D_INNER)),
        'w_ssd_out': normal(ks[9], (L, SSD_D_INNER, D_MODEL), SSD_D_INNER),
        'g_q_lat': gain(ks[10], (L, MLA_Q_RANK)),
        'w_q_up': normal(ks[11], (L, MLA_Q_RANK, MLA_HEADS * MLA_QK_DIM), MLA_Q_RANK),
        'g_kv_lat': gain(ks[12], (L, MLA_KV_RANK)),
        'w_kv_up': normal(ks[13], (L, MLA_KV_RANK, MLA_HEADS * (MLA_NOPE + MLA_V)), MLA_KV_RANK),
        'g_qk_q': gain(ks[14], (L, MLA_QK_DIM)),
        'g_qk_k': gain(ks[15], (L, MLA_QK_DIM)),
        'w_mla_out': normal(ks[16], (L, MLA_HEADS * MLA_V, D_MODEL), MLA_HEADS * MLA_V),
        'w_o': normal(ks[17], (L, D_MODEL, D_MODEL), D_MODEL),
        'g_ffn': gain(ks[18], (L, D_MODEL)),
        'w_router': normal(ks[19], (L, D_MODEL, N_EXPERTS), D_MODEL),
        'b_router': bias(ks[20], (L, N_EXPERTS)),
        'w_gate_up': normal(ks[21], (L, N_EXPERTS, D_MODEL, 2 * EXPERT_FF), D_MODEL),
        'b_gate_up': bias(ks[22], (L, N_EXPERTS, 2 * EXPERT_FF)),
        'w_down': normal(ks[23], (L, N_EXPERTS, EXPERT_FF, D_MODEL), EXPERT_FF),
        'b_down': bias(ks[24], (L, N_EXPERTS, D_MODEL)),
    }


def reference(x, g_mix, w_in, conv_w, conv_b, dt_bias, a_log, d_skip, g_ssd_out, w_ssd_out,
              g_q_lat, w_q_up, g_kv_lat, w_kv_up, g_qk_q, g_qk_k, w_mla_out, w_o,
              g_ffn, w_router, b_router, w_gate_up, b_gate_up, w_down, b_down):
    b, s, d = x.shape
    for l in range(DEPTH):
        h = rms_norm(x, g_mix[l])
        proj = h @ w_in[l]
        z = proj[..., :OFF_XBC]
        xbc = proj[..., OFF_XBC:OFF_DT]
        dt_raw = proj[..., OFF_DT:OFF_QLAT]
        q_lat = proj[..., OFF_QLAT:OFF_KVLAT]
        kv_lat = proj[..., OFF_KVLAT:OFF_KROPE]
        k_rope = proj[..., OFF_KROPE:OFF_GATE]
        gate_logits = proj[..., OFF_GATE:]
        y_ssd = ssd_branch(z, xbc, dt_raw, conv_w[l], conv_b[l], dt_bias[l], a_log[l],
                           d_skip[l], g_ssd_out[l]) @ w_ssd_out[l]
        y_mla = mla_branch(q_lat, kv_lat, k_rope, g_q_lat[l], w_q_up[l], g_kv_lat[l],
                           w_kv_up[l], g_qk_q[l], g_qk_k[l]) @ w_mla_out[l]
        g = jax.nn.sigmoid(gate_logits.astype(jnp.float32)).astype(x.dtype)
        merged = g[..., :d] * y_ssd + g[..., d:] * y_mla
        x = x + merged @ w_o[l]
        h2 = rms_norm(x, g_ffn[l]).reshape(b * s, d)
        x = x + moe(h2, w_router[l], b_router[l], w_gate_up[l], b_gate_up[l],
                    w_down[l], b_down[l]).reshape(b, s, d)
    return x
```

```cpp
#include <hip/hip_runtime.h>
#include <cstdio>
#include <cstdint>
#include <cmath>
namespace pg8 {
#define PG8_LAS __attribute__((address_space(3)))
typedef unsigned short bf16_t;
typedef short bf16x8 __attribute__((ext_vector_type(8)));
typedef float f32x4 __attribute__((ext_vector_type(4)));
typedef unsigned u32x4 __attribute__((ext_vector_type(4)));
constexpr int BM = 256, BK = 64, HALF = 128, HTB = HALF * BK * 2  , STAGE_BYTES = 8 * HTB, NXCD = 8, WGM = 8;

__host__ __device__ __forceinline__ int lds_byte(int r, int c) { const int st = (r >> 4) * 2 + (c >> 5), rr = r & 15, cc = c & 31, ob = rr * 64 + cc * 2; return st * 1024 + (ob ^ (((ob >> 9) & 1) << 5)); }
__host__ __device__ __forceinline__ void stage_rc(int b, int& R, int& C) { const int st = b / 1024, sb = b % 1024, swz = sb ^ (((sb >> 9) & 1) << 5); R = (st >> 1) * 16 + swz / 64; C = (st & 1) * 32 + (swz % 64) / 2; }
__host__ __device__ __forceinline__ int perm32(int rho) { const int n = rho >> 4, i = rho & 15; return 8 * (i >> 2) + 4 * n + (i & 3); }

struct Unit { int pm, pn; };
struct Gemm { const bf16_t* A; const bf16_t* Bt; int M, N, K, lda; int sclA = 0x7f7f7f7f, sclB = 0x7f7f7f7f; };

struct StaticOrder {
    int nM, nN, nwg, G, c, wgm = WGM;
    __host__ __device__ void init(int M, int N, int G_, int c_) { nM = M / BM; nN = N / BM; nwg = nM * nN; G = G_; c = c_; }
    __host__ __device__ bool next(int i, Unit& u) const {
        const long L = (long)i * G + c; if (L >= nwg) return false;
        int wgid = (int)L; { const int q = nwg / NXCD, r = nwg % NXCD, xcd = wgid % NXCD, off = wgid / NXCD; wgid = (xcd < r ? xcd * (q + 1) : r * (q + 1) + (xcd - r) * q) + off; }
        const int nig = wgm * nN, gid = wgid / nig, fm = gid * wgm, gsz = (nM - fm) < wgm ? (nM - fm) : wgm;
        u.pm = fm + ((wgid % nig) % gsz); u.pn = (wgid % nig) / gsz; return true;
    }
    __device__ __forceinline__ void a_ready(const Unit&) const {}
    __device__ __forceinline__ void done(const Unit&) const {}
    __device__ __forceinline__ size_t b_off(const Unit&) const { return 0; }
    __device__ __forceinline__ int a_row(const Unit& u, int r) const { return u.pm * BM + r; }
};

__device__ __forceinline__ unsigned cvt_pk_bf16(float lo, float hi) { unsigned r; asm volatile("v_cvt_pk_bf16_f32 %0, %1, %2" : "=v"(r) : "v"(lo), "v"(hi)); return r; }
typedef float f32x2 __attribute__((ext_vector_type(2)));
__device__ __forceinline__ f32x2 gelu_pk(f32x2 v) {
    const f32x2 av = __builtin_elementwise_abs(v), d = av * 0.2316418882f + 1.0f;
    f32x2 t; t.x = __builtin_amdgcn_rcpf(d.x); t.y = __builtin_amdgcn_rcpf(d.y);
    f32x2 q = t * 0.5307027145f + (-0.7265760135f); q = q * t + 0.7107068705f; q = q * t + (-0.142248368f); q = q * t + 0.127414796f; q = q * t;
    const f32x2 s = (v * v) * (-0.72134752044f);
    f32x2 e; e.x = __builtin_amdgcn_exp2f(s.x); e.y = __builtin_amdgcn_exp2f(s.y);
    const f32x2 m = v * (q * e), r = v - m;
    f32x2 o; o.x = v.x < 0.f ? m.x : r.x; o.y = v.y < 0.f ? m.y : r.y; return o;
}

template <int ACT  > struct EpiBf16 {
    static constexpr bool PERM = true, AFTER_DRAIN = false; static_assert(ACT == 0 || ACT == 1, "EpiBf16: ACT is 0 (none) or 1 (gelu_pk)");
    bf16_t* O; int ldc; const float* bias; int split_cols; size_t split_stride; float scale0;
    __device__ __forceinline__ void operator()(const f32x4 (&acc)[2][2][4][2], const Unit& u, int wr, int wc, int fr, int fq) const {
        const int row0 = u.pm * BM + wr * 64 + fr; int colt = u.pn * BM; bf16_t* base = O;
        float sc = 1.f; if (split_cols) { const int t = colt / split_cols; base += (size_t)t * split_stride; colt -= t * split_cols; if (t == 0) sc = scale0; }
        const int col0 = colt + wc * 32 + 8 * fq, bcol0 = u.pn * BM + wc * 32 + 8 * fq;
        f32x4 bv[2][2];
#pragma unroll
        for (int bj = 0; bj < 2; ++bj)
#pragma unroll
            for (int n = 0; n < 2; ++n) bv[bj][n] = bias ? *(const f32x4*)(bias + bcol0 + bj * HALF + 4 * n) : (f32x4){0.f, 0.f, 0.f, 0.f};
#pragma unroll
        for (int ai = 0; ai < 2; ++ai)
#pragma unroll
            for (int m = 0; m < 4; ++m) { bf16_t* rowp = base + (size_t)(row0 + ai * HALF + m * 16) * ldc + col0;
#pragma unroll
                for (int bj = 0; bj < 2; ++bj) { f32x4 v0 = acc[ai][bj][m][0] + bv[bj][0], v1 = acc[ai][bj][m][1] + bv[bj][1];
                    if (ACT == 1) { f32x2 a = gelu_pk((f32x2){v0[0], v0[1]}), b = gelu_pk((f32x2){v0[2], v0[3]}), c = gelu_pk((f32x2){v1[0], v1[1]}), d = gelu_pk((f32x2){v1[2], v1[3]});
                        v0 = (f32x4){a.x, a.y, b.x, b.y}; v1 = (f32x4){c.x, c.y, d.x, d.y}; }
                    v0 = v0 * sc; v1 = v1 * sc; u32x4 w; w.x = cvt_pk_bf16(v0[0], v0[1]); w.y = cvt_pk_bf16(v0[2], v0[3]); w.z = cvt_pk_bf16(v1[0], v1[1]); w.w = cvt_pk_bf16(v1[2], v1[3]);
                    *(u32x4*)(rowp + bj * HALF) = w; } }
    }
};
__device__ __forceinline__ float bf_lo(unsigned w) { return __uint_as_float(w << 16); }
__device__ __forceinline__ float bf_hi(unsigned w) { return __uint_as_float(w & 0xffff0000u); }
__device__ __forceinline__ float sigmoidf_(float x) { return __builtin_amdgcn_rcpf(1.0f + __expf(-x)); }
template <class F> struct EpiPerm8 {
    static constexpr bool PERM = true, AFTER_DRAIN = false;
    F f;
    __device__ __forceinline__ void operator()(const f32x4 (&acc)[2][2][4][2], const Unit& u, int wr, int wc, int fr, int fq) const {
        const int row0 = u.pm * BM + wr * 64 + fr, col0 = u.pn * BM + wc * 32 + 8 * fq;
#pragma unroll
        for (int ai = 0; ai < 2; ++ai)
#pragma unroll
            for (int m = 0; m < 4; ++m)
#pragma unroll
                for (int bj = 0; bj < 2; ++bj) { float v[8]; const f32x4 v0 = acc[ai][bj][m][0], v1 = acc[ai][bj][m][1];
                    v[0] = v0[0]; v[1] = v0[1]; v[2] = v0[2]; v[3] = v0[3]; v[4] = v1[0]; v[5] = v1[1]; v[6] = v1[2]; v[7] = v1[3];
                    f(u, row0 + ai * HALF + m * 16, col0 + bj * HALF, v); }
    }
};
__device__ __forceinline__ u32x4 pack8bf(const float (&v)[8]) { u32x4 w; w.x = cvt_pk_bf16(v[0], v[1]); w.y = cvt_pk_bf16(v[2], v[3]); w.z = cvt_pk_bf16(v[4], v[5]); w.w = cvt_pk_bf16(v[6], v[7]); return w; }
struct FStoreBf16 { bf16_t* O; int ldc;
    __device__ __forceinline__ void operator()(const Unit&, int row, int col, float (&v)[8]) const { *(u32x4*)(O + (size_t)row * ldc + col) = pack8bf(v); } };
struct FStoreProj { bf16_t* O; int ldc; bf16_t* QL; bf16_t* KVL;
    __device__ __forceinline__ void operator()(const Unit& u, int row, int col, float (&v)[8]) const { const u32x4 w = pack8bf(v); *(u32x4*)(O + (size_t)row * ldc + col) = w;
        if (u.pn >= 10 && u.pn <= 12) { if (col >= 2576 && col < 2960) *(u32x4*)(QL + (size_t)row * 384 + (col - 2576)) = w; else if (col >= 2960 && col < 3216) *(u32x4*)(KVL + (size_t)row * 256 + (col - 2960)) = w; } } };
struct FGate1 { const bf16_t* gate; int ldg; bf16_t* O; int ldc;
    __device__ __forceinline__ void operator()(const Unit&, int row, int col, float (&v)[8]) const {
        const u32x4 g = *(const u32x4*)(gate + (size_t)row * ldg + col);
        v[0] *= sigmoidf_(bf_lo(g.x)); v[1] *= sigmoidf_(bf_hi(g.x)); v[2] *= sigmoidf_(bf_lo(g.y)); v[3] *= sigmoidf_(bf_hi(g.y));
        v[4] *= sigmoidf_(bf_lo(g.z)); v[5] *= sigmoidf_(bf_hi(g.z)); v[6] *= sigmoidf_(bf_lo(g.w)); v[7] *= sigmoidf_(bf_hi(g.w));
        *(u32x4*)(O + (size_t)row * ldc + col) = pack8bf(v); } };
struct FGate2 { const bf16_t* gate; int ldg; bf16_t* O; int ldc;
    __device__ __forceinline__ void operator()(const Unit&, int row, int col, float (&v)[8]) const {
        const u32x4 g = *(const u32x4*)(gate + (size_t)row * ldg + col); const u32x4 o = *(const u32x4*)(O + (size_t)row * ldc + col);
        v[0] = bf_lo(o.x) + v[0] * sigmoidf_(bf_lo(g.x)); v[1] = bf_hi(o.x) + v[1] * sigmoidf_(bf_hi(g.x)); v[2] = bf_lo(o.y) + v[2] * sigmoidf_(bf_lo(g.y)); v[3] = bf_hi(o.y) + v[3] * sigmoidf_(bf_hi(g.y));
        v[4] = bf_lo(o.z) + v[4] * sigmoidf_(bf_lo(g.z)); v[5] = bf_hi(o.z) + v[5] * sigmoidf_(bf_hi(g.z)); v[6] = bf_lo(o.w) + v[6] * sigmoidf_(bf_lo(g.w)); v[7] = bf_hi(o.w) + v[7] * sigmoidf_(bf_hi(g.w));
        *(u32x4*)(O + (size_t)row * ldc + col) = pack8bf(v); } };
struct FResF32 { const float* base; float* out; int ldc;
    __device__ __forceinline__ void operator()(const Unit&, int row, int col, float (&v)[8]) const {
        const f32x4 b0 = *(const f32x4*)(base + (size_t)row * ldc + col), b1 = *(const f32x4*)(base + (size_t)row * ldc + col + 4);
        *(f32x4*)(out + (size_t)row * ldc + col) = (f32x4){b0[0] + v[0], b0[1] + v[1], b0[2] + v[2], b0[3] + v[3]};
        *(f32x4*)(out + (size_t)row * ldc + col + 4) = (f32x4){b1[0] + v[4], b1[1] + v[5], b1[2] + v[6], b1[3] + v[7]}; } };
template <class G> struct EpiPipe8 {
    static constexpr bool PERM = true, AFTER_DRAIN = false;
    G f;
    __device__ __forceinline__ void operator()(const f32x4 (&acc)[2][2][4][2], const Unit& u, int wr, int wc, int fr, int fq) const {
        const int row0 = u.pm * BM + wr * 64 + fr, col0 = u.pn * BM + wc * 32 + 8 * fq;
        constexpr int D = G::DEPTH;
        typename G::L l[D];
#pragma unroll
        for (int g = 0; g < D; ++g) f.load(u, row0 + (g >> 3) * HALF + ((g >> 1) & 3) * 16, col0 + (g & 1) * HALF, l[g]);
#pragma unroll
        for (int g = 0; g < 16; ++g) { const int ai = g >> 3, m = (g >> 1) & 3, bj = g & 1; float v[8]; const f32x4 v0 = acc[ai][bj][m][0], v1 = acc[ai][bj][m][1];
            v[0] = v0[0]; v[1] = v0[1]; v[2] = v0[2]; v[3] = v0[3]; v[4] = v1[0]; v[5] = v1[1]; v[6] = v1[2]; v[7] = v1[3];
            f.apply(u, row0 + ai * HALF + m * 16, col0 + bj * HALF, v, l[g % D]);
            if (g + D < 16) { const int g2 = g + D; f.load(u, row0 + (g2 >> 3) * HALF + ((g2 >> 1) & 3) * 16, col0 + (g2 & 1) * HALF, l[g % D]); } }
    }
};
__device__ __forceinline__ f32x2 sig2_bf(unsigned w) { f32x2 t = (f32x2){bf_lo(w), bf_hi(w)} * (-1.4426950408889634f); t.x = __builtin_amdgcn_exp2f(t.x); t.y = __builtin_amdgcn_exp2f(t.y);
    const f32x2 d = t + 1.0f; f32x2 r; r.x = __builtin_amdgcn_rcpf(d.x); r.y = __builtin_amdgcn_rcpf(d.y); return r; }
struct GGate1 { const bf16_t* gate; int ldg; bf16_t* O; int ldc;
    typedef u32x4 L; static constexpr int DEPTH = 16;
    __device__ __forceinline__ void load(const Unit&, int row, int col, L& g) const { g = *(const u32x4*)(gate + (size_t)row * ldg + col); }
    __device__ __forceinline__ void apply(const Unit&, int row, int col, float (&v)[8], const L& g) const {
        const f32x2 a = (f32x2){v[0], v[1]} * sig2_bf(g.x), b = (f32x2){v[2], v[3]} * sig2_bf(g.y), c = (f32x2){v[4], v[5]} * sig2_bf(g.z), d = (f32x2){v[6], v[7]} * sig2_bf(g.w);
        u32x4 w; w.x = cvt_pk_bf16(a.x, a.y); w.y = cvt_pk_bf16(b.x, b.y); w.z = cvt_pk_bf16(c.x, c.y); w.w = cvt_pk_bf16(d.x, d.y);
        *(u32x4*)(O + (size_t)row * ldc + col) = w; } };
struct GGate2 { const bf16_t* gate; int ldg; bf16_t* O; int ldc;
    struct L { u32x4 g, o; }; static constexpr int DEPTH = 6;
    __device__ __forceinline__ void load(const Unit&, int row, int col, L& l) const { l.g = *(const u32x4*)(gate + (size_t)row * ldg + col); l.o = *(const u32x4*)(O + (size_t)row * ldc + col); }
    __device__ __forceinline__ void apply(const Unit&, int row, int col, float (&v)[8], const L& l) const { const u32x4 g = l.g, o = l.o;
        const f32x2 a = (f32x2){v[0], v[1]} * sig2_bf(g.x) + (f32x2){bf_lo(o.x), bf_hi(o.x)}, b = (f32x2){v[2], v[3]} * sig2_bf(g.y) + (f32x2){bf_lo(o.y), bf_hi(o.y)};
        const f32x2 c = (f32x2){v[4], v[5]} * sig2_bf(g.z) + (f32x2){bf_lo(o.z), bf_hi(o.z)}, d = (f32x2){v[6], v[7]} * sig2_bf(g.w) + (f32x2){bf_lo(o.w), bf_hi(o.w)};
        u32x4 w; w.x = cvt_pk_bf16(a.x, a.y); w.y = cvt_pk_bf16(b.x, b.y); w.z = cvt_pk_bf16(c.x, c.y); w.w = cvt_pk_bf16(d.x, d.y);
        *(u32x4*)(O + (size_t)row * ldc + col) = w; } };
struct GResF32 { const float* base; float* out; int ldc;
    struct L { f32x4 b0, b1; }; static constexpr int DEPTH = 6;
    __device__ __forceinline__ void load(const Unit&, int row, int col, L& l) const { l.b0 = *(const f32x4*)(base + (size_t)row * ldc + col); l.b1 = *(const f32x4*)(base + (size_t)row * ldc + col + 4); }
    __device__ __forceinline__ void apply(const Unit&, int row, int col, float (&v)[8], const L& l) const {
        *(f32x4*)(out + (size_t)row * ldc + col) = (f32x4){l.b0[0] + v[0], l.b0[1] + v[1], l.b0[2] + v[2], l.b0[3] + v[3]};
        *(f32x4*)(out + (size_t)row * ldc + col + 4) = (f32x4){l.b1[0] + v[4], l.b1[1] + v[5], l.b1[2] + v[6], l.b1[3] + v[7]}; } };
#ifndef MOE_WGM
#define MOE_WGM 2
#endif
struct MoeOrder {
    StaticOrder so; const int* rowtok; const int* mte; size_t bstride;
    __device__ void init(int nmt, int N, int G_, int c_, const int* rowtok_, const int* mte_, size_t bstride_) { so.init(nmt * BM, N, G_, c_); so.wgm = MOE_WGM; rowtok = rowtok_; mte = mte_; bstride = bstride_; }
    __device__ bool next(int i, Unit& u) const { return so.next(i, u); }
    __device__ __forceinline__ void a_ready(const Unit&) const {}
    __device__ __forceinline__ void done(const Unit&) const {}
    __device__ __forceinline__ size_t b_off(const Unit& u) const { return (size_t)mte[u.pm] * bstride; }
    __device__ __forceinline__ int a_row(const Unit& u, int r) const { return rowtok ? rowtok[u.pm * BM + r] : u.pm * BM + r; }
};
struct EpiGateUp {
    static constexpr bool PERM = true, AFTER_DRAIN = false;
    const float* bgu; const int* mte; unsigned char* ACT;
    static __device__ __forceinline__ f32x2 act2(f32x2 g, f32x2 l) {
        g.x = fminf(g.x, 7.0f); g.y = fminf(g.y, 7.0f); l.x = fminf(fmaxf(l.x, -7.0f), 7.0f); l.y = fminf(fmaxf(l.y, -7.0f), 7.0f);
        f32x2 t = g * (-1.702f * 1.4426950408889634f); t.x = __builtin_amdgcn_exp2f(t.x); t.y = __builtin_amdgcn_exp2f(t.y);
        const f32x2 d = t + 1.0f; f32x2 r; r.x = __builtin_amdgcn_rcpf(d.x); r.y = __builtin_amdgcn_rcpf(d.y);
        return (g * r) * (l * 4.0f + 4.0f);
    }
    __device__ __forceinline__ void operator()(const f32x4 (&acc)[2][2][4][2], const Unit& u, int wr, int wc, int fr, int fq) const {
        const int e = mte[u.pm], row0 = u.pm * BM + wr * 64 + fr, j0 = u.pn * HALF + wc * 32 + 8 * fq;
        const float* bg = bgu + (size_t)e * 2048 + j0; const float* bl = bg + 1024;
        const f32x4 bgv[2] = {*(const f32x4*)bg, *(const f32x4*)(bg + 4)}, blv[2] = {*(const f32x4*)bl, *(const f32x4*)(bl + 4)};
#pragma unroll
        for (int ai = 0; ai < 2; ++ai)
#pragma unroll
            for (int m = 0; m < 4; ++m) { int w[2];
#pragma unroll
                for (int h = 0; h < 2; ++h) { const f32x4 G = acc[ai][0][m][h] + bgv[h], L = acc[ai][1][m][h] + blv[h];
                    const f32x2 v01 = act2((f32x2){G[0], G[1]}, (f32x2){L[0], L[1]}), v23 = act2((f32x2){G[2], G[3]}, (f32x2){L[2], L[3]});
                    w[h] = __builtin_amdgcn_cvt_pk_fp8_f32(v01.x, v01.y, 0, false); w[h] = __builtin_amdgcn_cvt_pk_fp8_f32(v23.x, v23.y, w[h], true); }
                typedef unsigned u32x2_ __attribute__((ext_vector_type(2))); *(u32x2_*)(ACT + (size_t)(row0 + ai * HALF + m * 16) * 1024 + j0) = (u32x2_){(unsigned)w[0], (unsigned)w[1]}; }
    }
};
struct EpiDown {
    static constexpr bool PERM = true, AFTER_DRAIN = false;
    const float* bdn; const int* mte; bf16_t* YS;
    __device__ __forceinline__ void operator()(const f32x4 (&acc)[2][2][4][2], const Unit& u, int wr, int wc, int fr, int fq) const {
        const int row0 = u.pm * BM + wr * 64 + fr, col0 = u.pn * BM + wc * 32 + 8 * fq;
        const float* b = bdn + (size_t)mte[u.pm] * 1024 + col0;
        f32x4 bv[2][2];
#pragma unroll
        for (int bj = 0; bj < 2; ++bj) { bv[bj][0] = *(const f32x4*)(b + bj * HALF); bv[bj][1] = *(const f32x4*)(b + bj * HALF + 4); }
#pragma unroll
        for (int ai = 0; ai < 2; ++ai)
#pragma unroll
            for (int m = 0; m < 4; ++m)
#pragma unroll
                for (int bj = 0; bj < 2; ++bj) { const f32x4 v0 = acc[ai][bj][m][0] + bv[bj][0], v1 = acc[ai][bj][m][1] + bv[bj][1];
                    u32x4 w; w.x = cvt_pk_bf16(v0[0], v0[1]); w.y = cvt_pk_bf16(v0[2], v0[3]); w.z = cvt_pk_bf16(v1[0], v1[1]); w.w = cvt_pk_bf16(v1[2], v1[3]);
                    *(u32x4*)(YS + (size_t)(row0 + ai * HALF + m * 16) * 1024 + col0 + bj * HALF) = w; }
    }
};
typedef int v4i_t __attribute__((ext_vector_type(4)));
typedef int v8i_t __attribute__((ext_vector_type(8)));
typedef float f32x8_t __attribute__((ext_vector_type(8)));
template <class Epi, class Sched, bool ALIGN_EPI = false, bool SP2 = true, bool FP8 = false>
__device__ __forceinline__ void gemm_phase(PG8_LAS unsigned char* lds, const Gemm g, const Sched& S, const Epi& E) {
    static_assert(SP2, "only the two-super-phase loop is kept in this file");
    const int tid = threadIdx.x, wid = __builtin_amdgcn_readfirstlane(tid >> 6), lane = tid & 63, wr = wid >> 2, wc = wid & 3, fr = lane & 15, fq = lane >> 4;
    const int K = g.K, nt = K / BK;
    unsigned vA0[2], vA1[2], nA0[2], nA1[2], voffB[2]; int RA[2], CA[2];
#pragma unroll
    for (int i = 0; i < 2; ++i) { int R, C; stage_rc(tid * 16 + i * 8192, R, C); const int Rb = Epi::PERM ? ((R & ~31) + perm32(R & 31)) : R;
        RA[i] = R; CA[i] = C; voffB[i] = (unsigned)(Rb * K + C) * 2u; }
    const size_t kstep = (size_t)(BK * 2);
    const size_t hstepB = (size_t)HALF * K * 2;
    const size_t tstepB = 2 * hstepB;
    const unsigned ldsw = (unsigned)wid * 1024u;
    const int aoff = lds_byte(wr * 64 + fr, fq * 8), boff = lds_byte(wc * 32 + fr, fq * 8);
#define PG8_SA(b, h) (((b) * 2 + (h)) * HTB)
#define PG8_SB(b, h) ((4 + (b) * 2 + (h)) * HTB)
#define PG8_STAGE(bufoff, gbase, voff) do { _Pragma("unroll") for (int _i = 0; _i < 2; ++_i) \
        __builtin_amdgcn_global_load_lds((const unsigned*)((const char*)(gbase) + (voff)[_i]), (PG8_LAS unsigned*)(lds + (bufoff) + ldsw + _i * 8192), 16, 0, 0); } while (0)
#define PG8_LDA(dst, dst8, b, h) do { if constexpr (!FP8) { _Pragma("unroll") for (int m = 0; m < 4; ++m) _Pragma("unroll") for (int k = 0; k < 2; ++k) dst[m][k] = *(const PG8_LAS bf16x8*)(lds + PG8_SA(b, h) + aoff + m * 2048 + k * 1024); } \
      else { _Pragma("unroll") for (int m = 0; m < 4; ++m) { const v4i_t lo_ = *(const PG8_LAS v4i_t*)(lds + PG8_SA(b, h) + aoff + m * 2048), hi_ = *(const PG8_LAS v4i_t*)(lds + PG8_SA(b, h) + aoff + m * 2048 + 1024); dst8[m] = __builtin_shufflevector(lo_, hi_, 0, 1, 2, 3, 4, 5, 6, 7); } } } while (0)
#define PG8_LDB(dst, dst8, b, h) do { if constexpr (!FP8) { _Pragma("unroll") for (int n = 0; n < 2; ++n) _Pragma("unroll") for (int k = 0; k < 2; ++k) dst[n][k] = *(const PG8_LAS bf16x8*)(lds + PG8_SB(b, h) + boff + n * 2048 + k * 1024); } \
      else { _Pragma("unroll") for (int n = 0; n < 2; ++n) { const v4i_t lo_ = *(const PG8_LAS v4i_t*)(lds + PG8_SB(b, h) + boff + n * 2048), hi_ = *(const PG8_LAS v4i_t*)(lds + PG8_SB(b, h) + boff + n * 2048 + 1024); dst8[n] = __builtin_shufflevector(lo_, hi_, 0, 1, 2, 3, 4, 5, 6, 7); } } } while (0)
#define PG8_MMA(ai, bj, At, Bt, At8, Bt8) do { __builtin_amdgcn_s_setprio(1); if constexpr (!FP8) { _Pragma("unroll") for (int m = 0; m < 4; ++m) _Pragma("unroll") for (int n = 0; n < 2; ++n) _Pragma("unroll") for (int k = 0; k < 2; ++k) \
        acc[ai][bj][m][n] = __builtin_amdgcn_mfma_f32_16x16x32_bf16(Bt[n][k], At[m][k], acc[ai][bj][m][n], 0, 0, 0); } \
      else { _Pragma("unroll") for (int m = 0; m < 4; ++m) _Pragma("unroll") for (int n = 0; n < 2; ++n)   \
        asm volatile("v_mfma_scale_f32_16x16x128_f8f6f4 %0, %1, %2, %0, %3, %4 op_sel_hi:[0,0,0]" : "+v"(acc[ai][bj][m][n]) : "v"(Bt8[n]), "v"(At8[m]), "v"(sclB), "v"(sclA)); } \
      __builtin_amdgcn_s_setprio(0); } while (0)
#define PG8_WAIT_V(n) asm volatile("s_waitcnt vmcnt(" #n ")" ::: "memory")
#define PG8_WAIT_L(n) asm volatile("s_waitcnt lgkmcnt(" #n ")" ::: "memory")
#define PG8_BAR __builtin_amdgcn_s_barrier()
#define PG8_SCHED __builtin_amdgcn_sched_barrier(0)
#define PG8_AROWS(d0, d1, u) do { _Pragma("unroll") for (int _i = 0; _i < 2; ++_i) { d0[_i] = (unsigned)((size_t)S.a_row(u, RA[_i]) * g.lda + CA[_i]) * 2u; d1[_i] = (unsigned)((size_t)S.a_row(u, HALF + RA[_i]) * g.lda + CA[_i]) * 2u; } } while (0)
    Unit cur, nxt; int ui = 0;
    if (!S.next(0, cur)) return;
    f32x4 acc[2][2][4][2];
#pragma unroll
    for (int a = 0; a < 2; ++a)
#pragma unroll
        for (int b = 0; b < 2; ++b)
#pragma unroll
            for (int m = 0; m < 4; ++m)
#pragma unroll
                for (int n = 0; n < 2; ++n) acc[a][b][m][n] = (f32x4){0.f, 0.f, 0.f, 0.f};
    bf16x8 At[4][2], B0[2][2], B1[2][2]; v8i_t At8[4], B08[2], B18[2]; const int sclA = g.sclA, sclB = g.sclB; (void)At8; (void)B08; (void)B18; (void)sclA; (void)sclB;
    const char* const gA = (const char*)g.A;
    const char* cB = (const char*)g.Bt + (size_t)cur.pn * tstepB + S.b_off(cur);
    PG8_AROWS(vA0, vA1, cur);
    S.a_ready(cur);
    PG8_STAGE(PG8_SB(0, 0), cB, voffB); PG8_STAGE(PG8_SB(0, 1), cB + hstepB, voffB); PG8_STAGE(PG8_SA(0, 0), gA, vA0); PG8_STAGE(PG8_SA(0, 1), gA, vA1);
    if (wr == 1) PG8_BAR;
    PG8_WAIT_V(2); PG8_BAR;
    PG8_STAGE(PG8_SB(1, 0), cB + kstep, voffB); PG8_STAGE(PG8_SA(1, 0), gA + kstep, vA0); PG8_STAGE(PG8_SB(1, 1), cB + hstepB + kstep, voffB);
    PG8_WAIT_V(6); PG8_BAR;
    for (;;) {
        const bool has_next = S.next(ui + 1, nxt);
        const char* nB = has_next ? (const char*)g.Bt + (size_t)nxt.pn * tstepB + S.b_off(nxt) : cB;
        if (has_next) { PG8_AROWS(nA0, nA1, nxt); } else { nA0[0] = vA0[0]; nA0[1] = vA0[1]; nA1[0] = vA1[0]; nA1[1] = vA1[1]; }
#pragma unroll 1
        for (int t = 0; t < nt; t += 2) {
            const bool last = (t == nt - 2);
            const char* a1 = gA + (size_t)(t + 1) * kstep;
            const char* a2 = last ? gA : gA + (size_t)(t + 2) * kstep; const char* b2 = last ? nB : cB + (size_t)(t + 2) * kstep;
            const char* a3 = a2 + kstep; const char* b3 = b2 + kstep;
            unsigned x0[2], x1[2]; x0[0] = last ? nA0[0] : vA0[0]; x0[1] = last ? nA0[1] : vA0[1]; x1[0] = last ? nA1[0] : vA1[0]; x1[1] = last ? nA1[1] : vA1[1];
            if (last && has_next) S.a_ready(nxt);
            PG8_LDB(B0, B08, 0, 0); PG8_LDB(B1, B18, 0, 1); PG8_SCHED; PG8_LDA(At, At8, 0, 0); PG8_STAGE(PG8_SA(1, 1), a1, vA1);
            PG8_WAIT_V(8); PG8_WAIT_L(0); PG8_BAR; PG8_MMA(0, 0, At, B0, At8, B08); PG8_MMA(0, 1, At, B1, At8, B18); PG8_BAR; PG8_SCHED;
            PG8_LDA(At, At8, 0, 1); PG8_STAGE(PG8_SB(0, 0), b2, voffB); PG8_STAGE(PG8_SB(0, 1), b2 + hstepB, voffB); PG8_STAGE(PG8_SA(0, 0), a2, x0);
            PG8_WAIT_V(8); PG8_WAIT_L(0); PG8_BAR; PG8_MMA(1, 0, At, B0, At8, B08); PG8_MMA(1, 1, At, B1, At8, B18); PG8_BAR; PG8_SCHED;
            PG8_LDB(B0, B08, 1, 0); PG8_LDB(B1, B18, 1, 1); PG8_SCHED; PG8_LDA(At, At8, 1, 0); PG8_STAGE(PG8_SA(0, 1), a2, x1);
            PG8_WAIT_V(8); PG8_WAIT_L(0); PG8_BAR; PG8_MMA(0, 0, At, B0, At8, B08); PG8_MMA(0, 1, At, B1, At8, B18); PG8_BAR; PG8_SCHED;
            PG8_LDA(At, At8, 1, 1); PG8_STAGE(PG8_SB(1, 0), b3, voffB); PG8_STAGE(PG8_SB(1, 1), b3 + hstepB, voffB); PG8_STAGE(PG8_SA(1, 0), a3, x0);
            PG8_WAIT_V(8); PG8_WAIT_L(0); PG8_BAR; PG8_MMA(1, 0, At, B0, At8, B08); PG8_MMA(1, 1, At, B1, At8, B18); PG8_BAR; PG8_SCHED;
        }
        if constexpr (ALIGN_EPI) { if (wr == 0) PG8_BAR; }
        if constexpr (FP8) asm volatile("s_nop 15\n\ts_nop 7" ::: "memory");
        if constexpr (!Epi::AFTER_DRAIN) { E(acc, cur, wr, wc, fr, fq); S.done(cur); }
        if (!has_next) break;
#pragma unroll
        for (int a = 0; a < 2; ++a)
#pragma unroll
            for (int b = 0; b < 2; ++b)
#pragma unroll
                for (int m = 0; m < 4; ++m)
#pragma unroll
                    for (int n = 0; n < 2; ++n) acc[a][b][m][n] = (f32x4){0.f, 0.f, 0.f, 0.f};
        cur = nxt; cB = nB; ++ui; vA0[0] = nA0[0]; vA0[1] = nA0[1]; vA1[0] = nA1[0]; vA1[1] = nA1[1];
        if constexpr (ALIGN_EPI) { if (wr == 1) PG8_BAR; }
    }
    PG8_WAIT_V(0);
    if constexpr (!ALIGN_EPI) { if (wr == 0) PG8_BAR; }
    PG8_BAR;
    if constexpr (Epi::AFTER_DRAIN) { E.fused(acc, cur, wr, wc, fr, fq, lds, wid, lane); S.done(cur); }
#undef PG8_SA
#undef PG8_SB
#undef PG8_STAGE
#undef PG8_LDA
#undef PG8_LDB
#undef PG8_MMA
#undef PG8_WAIT_V
#undef PG8_WAIT_L
#undef PG8_BAR
#undef PG8_SCHED
#undef PG8_AROWS
}
}
constexpr int NWAVES = 8, NTHR = 512;
constexpr int BATCH = 2, SEQ = 8192, DM = 1024, T = BATCH * SEQ;
constexpr int CHUNK = 64, NCHUNK = SEQ / CHUNK;
constexpr int SSD_H = 16, SSD_P = 64, SSD_G = 2, SSD_HPG = 8, SSD_N = 128, CONV_DIM = 1536;
constexpr int MLA_H = 8, QRANK = 384, KVRANK = 256, NOPE = 128, ROPE = 64, QKD = 192, VD = 128;
constexpr int NE = 32, TOPK = 4, FF = 1024;
constexpr int OFF_XBC = 1024, OFF_DT = 2560, OFF_QLAT = 2576, OFF_KVLAT = 2960, OFF_KROPE = 3216, OFF_GATE = 3280, IN_DIM = 5328, IN_PAD = 5376;
constexpr float EPS = 1e-6f;
constexpr int MT_MAX = 288, NSLOT_MAX = MT_MAX * 256;
constexpr float WGU_SCALE = 512.f, H2_SCALE = 16.f;
constexpr float QSCALE = 0.07216878364870322f * 1.4426950408889634f;

constexpr size_t MiB = 1u << 20;
constexpr size_t WS_CTL = 0, CTL_ZERO_BYTES = 1 * MiB;
constexpr size_t WS_WIN = 1 * MiB, WS_WQ = 12 * MiB, WS_WKV = 14 * MiB, WS_WSSD = 16 * MiB, WS_WMLA = 18 * MiB, WS_WO = 20 * MiB, WS_WGU = 22 * MiB, WS_WDN = 150 * MiB;
constexpr size_t WS_XN = 214 * MiB, WS_YN = 246 * MiB, WS_OATT = 278 * MiB, WS_MRG = 310 * MiB;
constexpr size_t WS_ACUM = 342 * MiB, WS_TOPI = 343 * MiB, WS_TOPG = WS_TOPI + 256 * 1024, WS_SLOT = WS_TOPG + 256 * 1024, WS_CNT = WS_SLOT + 256 * 1024;
constexpr size_t WS_ROWTOK = 344 * MiB, WS_MTE = WS_ROWTOK + 512 * 1024, WS_CDEC = WS_MTE + 64 * 1024;
constexpr size_t WS_ROPE = 346 * MiB;
constexpr size_t WS_QLAT = 912 * MiB, WS_KVLAT = 924 * MiB;
constexpr size_t WS_CONVC = 352 * MiB;
constexpr size_t WS_PROJ = 360 * MiB, WS_QPRE = 528 * MiB, WS_KVPRE = 576 * MiB, WS_Q = 640 * MiB, WS_K = 688 * MiB, WS_V = 736 * MiB, WS_XC = 768 * MiB, WS_YDIAG = 816 * MiB, WS_STATES = 848 * MiB;
constexpr size_t WS_ACT = 360 * MiB, WS_YS = 504 * MiB;
constexpr size_t WS_SSQ = 932 * MiB, WS_RQ = 936 * MiB;
constexpr size_t WS_SMAX = WS_RQ + 512 * 1024;
constexpr size_t WS_END = 937 * MiB;
static_assert(WS_ACT + (size_t)NSLOT_MAX * FF * 2 <= WS_YS && WS_YS + (size_t)NSLOT_MAX * DM * 2 <= WS_END, "moe overlay");
static_assert(WS_PROJ + (size_t)T * IN_PAD * 2 <= WS_QPRE, "proj");
constexpr int CW_TMO = 0, CW_CODE = 1, CW_BAR = 4096;

constexpr int RING_OFF = 0, RING_BYTES = 131072;
constexpr int LDSCTL_OFF = RING_BYTES, MISC_OFF = LDSCTL_OFF + 320;
constexpr int LDS_BYTES = 147456;

#define GAS __attribute__((address_space(1)))
#define LAS __attribute__((address_space(3)))
typedef unsigned short bf16;
typedef unsigned v4u __attribute__((ext_vector_type(4)));
typedef unsigned v2u __attribute__((ext_vector_type(2)));
typedef float f32x4 __attribute__((ext_vector_type(4)));
typedef float f32x2 __attribute__((ext_vector_type(2)));
typedef short bf16x8 __attribute__((ext_vector_type(8)));
typedef GAS unsigned gu32;
typedef GAS unsigned long long gu64;
#define RLX_AGENT __ATOMIC_RELAXED, __HIP_MEMORY_SCOPE_AGENT
#define LDS_WAIT() asm volatile("s_waitcnt lgkmcnt(0)" ::: "memory")
#define VM_WAIT() asm volatile("s_waitcnt vmcnt(0)" ::: "memory")
__device__ __forceinline__ unsigned f2bf(float f) { unsigned u = __builtin_bit_cast(unsigned, f); return (u + 0x7fffu + ((u >> 16) & 1u)) >> 16; }
typedef float pkf32x2_ __attribute__((ext_vector_type(2))); typedef __bf16 pkbf16x2_ __attribute__((ext_vector_type(2)));
__device__ __forceinline__ unsigned pk2(float lo, float hi) { const pkbf16x2_ r = __builtin_convertvector((pkf32x2_){lo, hi}, pkbf16x2_); return __builtin_bit_cast(unsigned, r); }
__device__ __forceinline__ float bf2f(unsigned short b) { return __uint_as_float((unsigned)b << 16); }
__device__ __forceinline__ float blo(unsigned w) { return __uint_as_float(w << 16); }
__device__ __forceinline__ float bhi(unsigned w) { return __uint_as_float(w & 0xffff0000u); }
__device__ __forceinline__ void unpack8(const v4u w, float (&v)[8]) { v[0] = blo(w.x); v[1] = bhi(w.x); v[2] = blo(w.y); v[3] = bhi(w.y); v[4] = blo(w.z); v[5] = bhi(w.z); v[6] = blo(w.w); v[7] = bhi(w.w); }
__device__ __forceinline__ v4u pack8(const float (&v)[8]) { v4u w; w.x = pk2(v[0], v[1]); w.y = pk2(v[2], v[3]); w.z = pk2(v[4], v[5]); w.w = pk2(v[6], v[7]); return w; }
__device__ __forceinline__ float wave_sum(float v) {
#pragma unroll
    for (int o = 1; o < 64; o <<= 1) v += __shfl_xor(v, o);
    return v;
}
__device__ __forceinline__ float wave_max(float v) {
#pragma unroll
    for (int o = 1; o < 64; o <<= 1) v = fmaxf(v, __shfl_xor(v, o));
    return v;
}
__device__ __forceinline__ float siluf_(float x) { return x * __builtin_amdgcn_rcpf(1.0f + __expf(-x)); }
__device__ __forceinline__ float softplusf_(float x) { return x > 20.f ? x : log1pf(__expf(x)); }
#define XB_TMO      128
#define XB_XCNT(j)  (256  + 64 * (j))
#define XB_XSUB(j)  (1280 + 64 * (j))
#define XB_XGEN(j)  (2304 + 64 * (j))
#define XB_TOP      3328
#define XB_TOPGEN   3392
#define XCD_BAR_WORDS 3456
#define XB_SPIN_CAP (1u << 18)

__device__ __forceinline__ unsigned xb_ld(unsigned* p)              { return __hip_atomic_load(p, __ATOMIC_RELAXED, __HIP_MEMORY_SCOPE_AGENT); }
__device__ __forceinline__ unsigned xb_add(unsigned* p, unsigned v) { return __hip_atomic_fetch_add(p, v, __ATOMIC_RELAXED, __HIP_MEMORY_SCOPE_AGENT); }
__device__ __forceinline__ unsigned xb_xcc_id() { return (unsigned)__builtin_amdgcn_s_getreg((3 << 11) | 20) & 0xFu; }
#define XB_SPIN(cond, bar) do { unsigned _sp = 0; while (cond) { __builtin_amdgcn_s_sleep(1); \
    if ((++_sp & 255u) == 0u) { if (xb_ld(&(bar)[XB_TMO])) break; if (_sp > XB_SPIN_CAP) { atomicAdd(&(bar)[XB_TMO], 1u); break; } } } } while (0)

struct XcdBarrier {
    unsigned* bar; unsigned x;
    volatile LAS unsigned* st;
};

__device__ __forceinline__ XcdBarrier xcd_barrier_post(unsigned* bar, volatile LAS unsigned* st) {
    XcdBarrier b; b.bar = bar; b.x = xb_xcc_id(); b.st = st;
    if (threadIdx.x == 0) (void)xb_add(&bar[XB_XCNT(b.x)], 1u);
    return b;
}
__device__ __forceinline__ void xcd_barrier_complete(unsigned* bar, unsigned x, unsigned& nloc, unsigned& nx) {
    const unsigned G = gridDim.x * gridDim.y * gridDim.z;
    unsigned sum, cnt, mine, sp = 0u;
    for (;;) {
        sum = 0u; cnt = 0u; mine = 0u;
#pragma unroll
        for (unsigned j = 0; j < 16; ++j) { const unsigned c = xb_ld(&bar[XB_XCNT(j)]); sum += c; cnt += (c > 0u) ? 1u : 0u; mine = (j == x) ? c : mine; }
        if (sum == G) break;
        __builtin_amdgcn_s_sleep(1);
        if ((++sp & 255u) == 0u) { if (xb_ld(&bar[XB_TMO])) break; if (sp > XB_SPIN_CAP) { atomicAdd(&bar[XB_TMO], 1u); break; } }
    }
    nloc = mine > 0u ? mine : 1u; nx = cnt > 0u ? cnt : 1u;
}

__device__ __forceinline__ void xcd_barrier(const XcdBarrier& b) {
    asm volatile("s_waitcnt vmcnt(0)" ::: "memory");
    __syncthreads();
    if (threadIdx.x == 0) {
        unsigned* bar = b.bar;
        __builtin_amdgcn_s_waitcnt(0);
        unsigned nloc = b.st[0], nx = b.st[1];
        if (nloc == 0u) { xcd_barrier_complete(bar, b.x, nloc, nx); b.st[0] = nloc; b.st[1] = nx; }
        const unsigned old = xb_add(&bar[XB_XSUB(b.x)], 1u);
        const unsigned gen = old / nloc;
        if (old + 1u == (gen + 1u) * nloc) {
            __builtin_amdgcn_fence(__ATOMIC_RELEASE, "agent");
            asm volatile("s_waitcnt vmcnt(0)" ::: "memory");
            const unsigned og = xb_add(&bar[XB_TOP], 1u);
            const unsigned tg = og / nx;
            if (og + 1u == (tg + 1u) * nx) xb_add(&bar[XB_TOPGEN], 1u);
            else XB_SPIN(xb_ld(&bar[XB_TOPGEN]) == tg, bar);
            __builtin_amdgcn_fence(__ATOMIC_ACQUIRE, "agent");
            xb_add(&bar[XB_XGEN(b.x)], 1u);
            asm volatile("s_waitcnt vmcnt(0)" ::: "memory");
        } else {
            XB_SPIN(xb_ld(&bar[XB_XGEN(b.x)]) == gen, bar);
            __builtin_amdgcn_fence(__ATOMIC_ACQUIRE, "agent");
            asm volatile("s_waitcnt vmcnt(0)" ::: "memory");
        }
    }
    __syncthreads();
}
struct Frame {
    LAS unsigned char* lds;
    volatile LAS unsigned* MISC;
    gu32* ctl;
    int tid, lane, wave;
    int vcu, G;
    const float* in[25]; float* out; unsigned char* ws;
};
#define WSP(T_, off) ((T_*)(F.ws + (off)))
enum { I_X = 0, I_GMIX, I_WIN, I_CONVW, I_CONVB, I_DTB, I_ALOG, I_DSKIP, I_GSSD, I_WSSD, I_GQL, I_WQUP, I_GKVL, I_WKVUP, I_GQKQ, I_GQKK, I_WMLA, I_WO, I_GFFN, I_WR, I_BR, I_WGU, I_BGU, I_WDN, I_BDN };

__device__ __forceinline__ void p0_transpose_item(const float* W, int K, int N, bf16* WT, int n0dst, const float* kscale, LAS float* scr, int kb, int nb, int lane, int pmode = 0) {
    const int k0 = 64 * kb, n0 = 32 * nb;
#pragma unroll
    for (int i = 0; i < 8; ++i) { const int kk = 8 * i + (lane >> 3), n = n0 + 4 * (lane & 7);
        f32x4 v = (n < N) ? *(const f32x4*)(W + (size_t)(k0 + kk) * N + n) : (f32x4){0.f, 0.f, 0.f, 0.f}; if (kscale) v = v * kscale[k0 + kk];
        LAS float* d = scr + kk * 33 + 4 * (lane & 7); d[0] = v[0]; d[1] = v[1]; d[2] = v[2]; d[3] = v[3]; }
    LDS_WAIT(); asm volatile("" ::: "memory");
    const int c = lane & 7;
#pragma unroll
    for (int j = 0; j < 4; ++j) { const int n = (lane >> 3) + 8 * j; const LAS float* s = scr + (8 * c) * 33 + n;
        v4u o; o.x = pk2(s[0 * 33], s[1 * 33]); o.y = pk2(s[2 * 33], s[3 * 33]); o.z = pk2(s[4 * 33], s[5 * 33]); o.w = pk2(s[6 * 33], s[7 * 33]);
        const int nd = pmode ? 8 * (n >> 2) + (n & 3) + (pmode == 2 ? 4 : 0) : n;
        *(v4u*)(WT + (size_t)(n0dst + nd) * K + k0 + 8 * c) = o; }
    LDS_WAIT(); asm volatile("" ::: "memory");
}
__device__ __forceinline__ void rms_row_to_bf16(int lane, const float* xrow, const float* gain, bf16* orow) {
    const f32x4* xr = (const f32x4*)xrow + lane; const f32x4* gr = (const f32x4*)gain + lane;
    f32x4 v[4]; float s = 0.f;
#pragma unroll
    for (int j = 0; j < 4; ++j) { v[j] = xr[64 * j]; s += (v[j].x * v[j].x + v[j].y * v[j].y) + (v[j].z * v[j].z + v[j].w * v[j].w); }
    const float r = rsqrtf(wave_sum(s) * (1.f / DM) + EPS);
    unsigned long long* o8 = (unsigned long long*)orow + lane;
#pragma unroll
    for (int j = 0; j < 4; ++j) { const f32x4 g = gr[64 * j]; o8[64 * j] = (unsigned long long)pk2(v[j].x * r * g.x, v[j].y * r * g.y) | ((unsigned long long)pk2(v[j].z * r * g.z, v[j].w * r * g.w) << 32); }
}
__device__ __forceinline__ unsigned pk4_fp8(float a, float b, float c, float d) { int w = __builtin_amdgcn_cvt_pk_fp8_f32(a, b, 0, false); w = __builtin_amdgcn_cvt_pk_fp8_f32(c, d, w, true); return (unsigned)w; }
__device__ __forceinline__ void p0_transpose_item_fp8(const float* W, int K, int N, unsigned char* WT, int n0dst, float scale, LAS float* scr, int kb, int nb, int lane) {
    const int k0 = 64 * kb, n0 = 32 * nb;
#pragma unroll
    for (int i = 0; i < 8; ++i) { const int kk = 8 * i + (lane >> 3), n = n0 + 4 * (lane & 7);
        const f32x4 v = *(const f32x4*)(W + (size_t)(k0 + kk) * N + n) * scale;
        LAS float* d = scr + kk * 33 + 4 * (lane & 7); d[0] = fminf(fmaxf(v[0], -448.f), 448.f); d[1] = fminf(fmaxf(v[1], -448.f), 448.f); d[2] = fminf(fmaxf(v[2], -448.f), 448.f); d[3] = fminf(fmaxf(v[3], -448.f), 448.f); }
    LDS_WAIT(); asm volatile("" ::: "memory");
    const int c = lane & 7;
#pragma unroll
    for (int j = 0; j < 4; ++j) { const int n = (lane >> 3) + 8 * j; const LAS float* s = scr + (8 * c) * 33 + n;
        v2u o; o.x = pk4_fp8(s[0 * 33], s[1 * 33], s[2 * 33], s[3 * 33]); o.y = pk4_fp8(s[4 * 33], s[5 * 33], s[6 * 33], s[7 * 33]);
        *(v2u*)(WT + (size_t)(n0dst + n) * K + k0 + 8 * c) = o; }
    LDS_WAIT(); asm volatile("" ::: "memory");
}
constexpr int P0_I_IN = 16 * 168, P0_I_Q = 6 * 48, P0_I_KV = 4 * 64, P0_I_SQ = 16 * 32, P0_I_GU1 = 16 * 64, P0_I_DN1 = 16 * 32;
constexpr int P0_NITEMS = P0_I_IN + P0_I_Q + P0_I_KV + 3 * P0_I_SQ + NE * P0_I_GU1 + NE * P0_I_DN1;
constexpr int P0_DEFER = 12288;
__device__ __forceinline__ void p0_item(Frame& F, int it, LAS float* scr) {
    int r = it;
    if (r < P0_I_IN) { p0_transpose_item(F.in[I_WIN], DM, IN_DIM, WSP(bf16, WS_WIN), 32 * (r % 168), nullptr, scr, r / 168, r % 168, F.lane); return; } r -= P0_I_IN;
    if (r < P0_I_Q) { const int nb = r % 48, c0 = 32 * nb, hd = c0 / QKD, d0 = c0 % QKD, pm = d0 < NOPE ? 0 : d0 == NOPE ? 1 : 2;
        p0_transpose_item(F.in[I_WQUP], QRANK, MLA_H * QKD, WSP(bf16, WS_WQ), pm ? hd * QKD + NOPE : c0, F.in[I_GQL], scr, r / 48, nb, F.lane, pm); return; } r -= P0_I_Q;
    if (r < P0_I_KV) { p0_transpose_item(F.in[I_WKVUP], KVRANK, MLA_H * 256, WSP(bf16, WS_WKV), 32 * (r % 64), F.in[I_GKVL], scr, r / 64, r % 64, F.lane); return; } r -= P0_I_KV;
    if (r < P0_I_SQ) { p0_transpose_item(F.in[I_WSSD], DM, DM, WSP(bf16, WS_WSSD), 32 * (r % 32), nullptr, scr, r / 32, r % 32, F.lane); return; } r -= P0_I_SQ;
    if (r < P0_I_SQ) { p0_transpose_item(F.in[I_WMLA], DM, DM, WSP(bf16, WS_WMLA), 32 * (r % 32), nullptr, scr, r / 32, r % 32, F.lane); return; } r -= P0_I_SQ;
    if (r < P0_I_SQ) { p0_transpose_item(F.in[I_WO], DM, DM, WSP(bf16, WS_WO), 32 * (r % 32), nullptr, scr, r / 32, r % 32, F.lane); return; } r -= P0_I_SQ;
    if (r < NE * P0_I_GU1) { const int e = r / P0_I_GU1, q = r % P0_I_GU1, kb = q / 64, nb = q % 64; const int n0 = 32 * nb, j = n0 & 1023;
        const int n0dst = (j >> 7) * 256 + (n0 >= 1024 ? 128 : 0) + (j & 127);
        p0_transpose_item_fp8(F.in[I_WGU] + (size_t)e * DM * 2 * FF, DM, 2 * FF, WSP(unsigned char, WS_WGU) + (size_t)e * 2 * FF * DM, n0dst, WGU_SCALE, scr, kb, nb, F.lane); return; } r -= NE * P0_I_GU1;
    { const int e = r / P0_I_DN1, q = r % P0_I_DN1; p0_transpose_item_fp8(F.in[I_WDN] + (size_t)e * FF * DM, FF, DM, WSP(unsigned char, WS_WDN) + (size_t)e * DM * FF, 32 * (q % 32), WGU_SCALE, scr, q / 32, q % 32, F.lane); }
}
__device__ __forceinline__ void p0_deferred(Frame& F, int nfull) {
    LAS float* scr = (LAS float*)(F.lds + RING_OFF + F.wave * 16384);
    const int c = (int)blockIdx.x, e = nfull ? c - nfull : c, E = nfull ? F.G - nfull : F.G;
    if (e < 0) return;
    for (int it = P0_NITEMS - P0_DEFER + e * NWAVES + F.wave; it < P0_NITEMS; it += E * NWAVES) p0_item(F, it, scr);
}
__device__ __forceinline__ void p0_prologue(Frame& F) {
    LAS float* scr = (LAS float*)(F.lds + RING_OFF + F.wave * 16384);
    const int gw = F.vcu * NWAVES + F.wave, NGW = F.G * NWAVES;
    for (int it = gw; it < P0_NITEMS - P0_DEFER; it += NGW) p0_item(F, it, scr);
    for (int m = gw; m < T; m += NGW) rms_row_to_bf16(F.lane, F.in[I_X] + (size_t)m * DM, F.in[I_GMIX], WSP(bf16, WS_XN) + (size_t)m * DM);
    if (F.vcu == 0 && F.wave == 0) { const int lane = F.lane;
        float a = 0.f, b = 0.f;
#pragma unroll
        for (int j = 0; j < 3; ++j) { a = fmaxf(a, fabsf(F.in[I_GQKQ][lane + 64 * j])); b = fmaxf(b, fabsf(F.in[I_GQKK][lane + 64 * j])); }
        a = wave_max(a); b = wave_max(b);
        if (lane == 0) *WSP(float, WS_SMAX) = 13.856406460551018f * 1.4426950408889634f * a * b * 1.03f + 0.25f; }
    { float* RT = WSP(float, WS_ROPE);
      for (int i = F.vcu * NTHR + F.tid; i < SEQ * 32; i += F.G * NTHR) { const int pos = i >> 5, j = i & 31; const float inv = exp2f(-(float)(2 * j) * (1.0f / 64.0f) * 13.287712379549449f);
          float sv, cv; sincosf((float)pos * inv, &sv, &cv); RT[pos * 64 + j] = cv; RT[pos * 64 + 32 + j] = sv; } }
}

struct PrepIn { v4u ql, kl, kr; f32x4 c0, c1, s0, s1; v4u qv[4], kv[4], vv[4]; };
__device__ __forceinline__ void p3_mla_prep(Frame& F) {
    const int gw = F.vcu * NWAVES + F.wave, NGW = F.G * NWAVES, l = F.lane, hl = l & 31, half = l >> 5;
    const bf16* PROJ = WSP(bf16, WS_PROJ); const bf16* QPRE = WSP(bf16, WS_QPRE); const bf16* KVPRE = WSP(bf16, WS_KVPRE); const float* RT = WSP(float, WS_ROPE);
    bf16* Qo = WSP(bf16, WS_Q); bf16* Ko = WSP(bf16, WS_K); bf16* Vo = WSP(bf16, WS_V);
    const bool act = hl < 24, isrope = hl >= 16 && hl < 24, isx2 = hl >= 20;
    const int hlc = act ? hl : 0, jr = 8 * ((hl - 16) & 3);
    float gq[8], gk[8];
#pragma unroll
    for (int e = 0; e < 8; ++e) { gq[e] = act ? F.in[I_GQKQ][8 * hl + e] : 0.f; gk[e] = act ? F.in[I_GQKK][8 * hl + e] : 0.f; }
#define PREP_LOAD(P, tk_) do { const int s_ = (tk_) % SEQ; const bf16* prow = PROJ + (size_t)(tk_) * IN_PAD; \
        P.ql = *(const v4u*)(prow + OFF_QLAT + 8 * (l < 48 ? l : 0)); P.kl = *(const v4u*)(prow + OFF_KVLAT + 8 * (l & 31)); P.kr = *(const v4u*)(prow + OFF_KROPE + 8 * ((hl - 16) & 7)); \
        P.c0 = *(const f32x4*)(RT + s_ * 64 + jr); P.c1 = *(const f32x4*)(RT + s_ * 64 + jr + 4); P.s0 = *(const f32x4*)(RT + s_ * 64 + 32 + jr); P.s1 = *(const f32x4*)(RT + s_ * 64 + 32 + jr + 4); \
        _Pragma("unroll") for (int hp = 0; hp < 4; ++hp) { const int h = 2 * hp + half; \
            P.qv[hp] = *(const v4u*)(QPRE + (size_t)(tk_) * (MLA_H * QKD) + h * QKD + 8 * hlc); \
            P.kv[hp] = *(const v4u*)(KVPRE + (size_t)(tk_) * (MLA_H * 256) + h * 256 + 8 * (hl & 15)); \
            P.vv[hp] = *(const v4u*)(KVPRE + (size_t)(tk_) * (MLA_H * 256) + h * 256 + 128 + 8 * (hl & 15)); } } while (0)
    auto proc = [&](const PrepIn& P, int tk) {
        const int b = tk / SEQ, s = tk % SEQ;
        float v[8]; float ss = 0.f;
        unpack8(P.ql, v);
        if (l < 48) {
#pragma unroll
            for (int e = 0; e < 8; ++e) ss += v[e] * v[e]; }
        const float rq = rsqrtf(wave_sum(ss) * (1.f / QRANK) + EPS);
        ss = 0.f; unpack8(P.kl, v);
        if (l < 32) {
#pragma unroll
            for (int e = 0; e < 8; ++e) ss += v[e] * v[e]; }
        const float rkv = rsqrtf(wave_sum(ss) * (1.f / KVRANK) + EPS);
        const float cs[8] = {P.c0[0], P.c0[1], P.c0[2], P.c0[3], P.c1[0], P.c1[1], P.c1[2], P.c1[3]}, sn[8] = {P.s0[0], P.s0[1], P.s0[2], P.s0[3], P.s1[0], P.s1[1], P.s1[2], P.s1[3]};
        float krp[8]; unpack8(P.kr, krp);
#pragma unroll
        for (int hp = 0; hp < 4; ++hp) {
            const int h = 2 * hp + half;
            { float q[8]; unpack8(P.qv[hp], q);
#pragma unroll
              for (int e = 0; e < 8; ++e) q[e] = act ? q[e] * rq : 0.f;
              float s2 = 0.f;
#pragma unroll
              for (int e = 0; e < 8; ++e) s2 += q[e] * q[e];
#pragma unroll
              for (int o = 1; o < 32; o <<= 1) s2 += __shfl_xor(s2, o);
              const float rs = rsqrtf(s2 * (1.f / QKD) + EPS);
#pragma unroll
              for (int e = 0; e < 8; ++e) { q[e] = q[e] * rs * gq[e]; const float p = __shfl_xor(q[e], 4);
                  if (isrope) q[e] = isx2 ? (q[e] * cs[e] + p * sn[e]) : (q[e] * cs[e] - p * sn[e]);
                  q[e] *= QSCALE; }
              if (act) *(v4u*)(Qo + ((size_t)(b * MLA_H + h) * SEQ + s) * QKD + 8 * hl) = pack8(q); }
            { float k[8]; unpack8(P.kv[hp], k);
#pragma unroll
              for (int e = 0; e < 8; ++e) k[e] = (hl < 16) ? k[e] * rkv : (isrope ? krp[e] : 0.f);
              float s2 = 0.f;
#pragma unroll
              for (int e = 0; e < 8; ++e) s2 += k[e] * k[e];
#pragma unroll
              for (int o = 1; o < 32; o <<= 1) s2 += __shfl_xor(s2, o);
              const float rs = rsqrtf(s2 * (1.f / QKD) + EPS);
#pragma unroll
              for (int e = 0; e < 8; ++e) { k[e] = k[e] * rs * gk[e]; const float p = __shfl_xor(k[e], 4);
                  if (isrope) k[e] = isx2 ? (k[e] * cs[e] + p * sn[e]) : (k[e] * cs[e] - p * sn[e]); }
              if (act) *(v4u*)(Ko + ((size_t)(b * MLA_H + h) * SEQ + s) * QKD + 8 * hl) = pack8(k); }
            if (hl < 16) { float w[8]; unpack8(P.vv[hp], w);
#pragma unroll
                for (int e = 0; e < 8; ++e) w[e] *= rkv;
                *(v4u*)(Vo + ((size_t)(b * MLA_H + h) * SEQ + s) * VD + 8 * hl) = pack8(w); }
        }
    };
    int tk = gw; if (tk >= T) return;
    PrepIn A, B;
    PREP_LOAD(A, tk);
#pragma unroll 1
    for (;;) {
        const int t1 = tk + NGW; const bool h1 = t1 < T;
        PREP_LOAD(B, (h1 ? t1 : tk)); asm volatile("" : "+v"(A.ql.x), "+v"(A.kl.x) :: "memory");
        proc(A, tk);
        if (!h1) break;
        const int t2 = t1 + NGW; const bool h2 = t2 < T;
        PREP_LOAD(A, (h2 ? t2 : t1)); asm volatile("" : "+v"(B.ql.x), "+v"(B.kl.x) :: "memory");
        proc(B, t1);
        if (!h2) break;
        tk = t2;
    }
#undef PREP_LOAD
}

__device__ __forceinline__ void p4_attn_naive(Frame& F) {
    LAS float* qs = (LAS float*)(F.lds);
    LAS bf16* ks = (LAS bf16*)(F.lds + 49152);
    LAS bf16* vs = (LAS bf16*)(F.lds + 49152 + 25600);
    LAS float* ps = (LAS float*)(F.lds + 49152 + 25600 + 16384) + F.wave * 512;
    const bf16* Q = WSP(bf16, WS_Q); const bf16* K = WSP(bf16, WS_K); const bf16* V = WSP(bf16, WS_V); bf16* O = WSP(bf16, WS_OATT);
    const int tid = F.tid, lane = F.lane, w = F.wave;
    const int NIT = BATCH * MLA_H * NCHUNK;
    for (int it0 = 0; it0 < NIT; it0 += F.G) {
        const int it = it0 + (int)blockIdx.x; if (it >= NIT) break;
        const int rnd = it / 256, j = it % 256;
        const int bh = 2 * rnd + (j >> 7), c = (rnd & 1) ? (127 - (j & 127)) : (j & 127);
        const bf16* Qh = Q + ((size_t)bh * SEQ + (size_t)c * 64) * QKD; const bf16* Kh = K + (size_t)bh * SEQ * QKD; const bf16* Vh = V + (size_t)bh * SEQ * VD;
        __syncthreads();
        for (int i = tid; i < 64 * 24; i += NTHR) { float v[8]; unpack8(*(const v4u*)(Qh + (size_t)i * 8), v); const int r = i / 24, d = (i % 24) * 8;
#pragma unroll
            for (int e = 0; e < 8; ++e) qs[r * 192 + d + e] = v[e]; }
        float m[8], lsum[8], o0[8], o1[8];
#pragma unroll
        for (int r = 0; r < 8; ++r) { m[r] = -1e30f; lsum[r] = 0.f; o0[r] = 0.f; o1[r] = 0.f; }
        for (int kt = 0; kt <= c; ++kt) {
            __syncthreads();
            for (int i = tid; i < 64 * 24; i += NTHR) { const int r = i / 24, d = (i % 24) * 8; *(LAS v4u*)(ks + r * 200 + d) = *(const v4u*)(Kh + ((size_t)kt * 64 + r) * QKD + d); }
            for (int i = tid; i < 64 * 16; i += NTHR) { const int r = i / 16, d = (i % 16) * 8; *(LAS v4u*)(vs + r * 128 + d) = *(const v4u*)(Vh + ((size_t)kt * 64 + r) * VD + d); }
            __syncthreads();
            float sc[8];
#pragma unroll
            for (int r = 0; r < 8; ++r) sc[r] = 0.f;
#pragma unroll 2
            for (int d = 0; d < 192; d += 8) { float kv[8]; unpack8(*(const LAS v4u*)(ks + lane * 200 + d), kv);
#pragma unroll
                for (int r = 0; r < 8; ++r) { const f32x4 qa = *(const LAS f32x4*)(qs + (8 * w + r) * 192 + d), qb = *(const LAS f32x4*)(qs + (8 * w + r) * 192 + d + 4);
                    sc[r] += qa[0] * kv[0] + qa[1] * kv[1] + qa[2] * kv[2] + qa[3] * kv[3] + qb[0] * kv[4] + qb[1] * kv[5] + qb[2] * kv[6] + qb[3] * kv[7]; } }
#pragma unroll
            for (int r = 0; r < 8; ++r) { const float tm = wave_max(sc[r]); const float mn = fmaxf(m[r], tm); const float al = exp2f(m[r] - mn); const float p = exp2f(sc[r] - mn);
                lsum[r] = lsum[r] * al + wave_sum(p); o0[r] *= al; o1[r] *= al; m[r] = mn; sc[r] = p; }
            *(LAS f32x4*)(ps + lane * 8) = (f32x4){sc[0], sc[1], sc[2], sc[3]}; *(LAS f32x4*)(ps + lane * 8 + 4) = (f32x4){sc[4], sc[5], sc[6], sc[7]};
            LDS_WAIT(); asm volatile("" ::: "memory");
#pragma unroll 4
            for (int k = 0; k < 64; ++k) { const unsigned vv = *(const LAS unsigned*)(vs + k * 128 + 2 * lane); const float v0 = blo(vv), v1 = bhi(vv);
                const f32x4 pa = *(const LAS f32x4*)(ps + k * 8), pb = *(const LAS f32x4*)(ps + k * 8 + 4);
                o0[0] += pa[0] * v0; o1[0] += pa[0] * v1; o0[1] += pa[1] * v0; o1[1] += pa[1] * v1; o0[2] += pa[2] * v0; o1[2] += pa[2] * v1; o0[3] += pa[3] * v0; o1[3] += pa[3] * v1;
                o0[4] += pb[0] * v0; o1[4] += pb[0] * v1; o0[5] += pb[1] * v0; o1[5] += pb[1] * v1; o0[6] += pb[2] * v0; o1[6] += pb[2] * v1; o0[7] += pb[3] * v0; o1[7] += pb[3] * v1; }
            LDS_WAIT(); asm volatile("" ::: "memory");
        }
        const int b = bh / MLA_H, h = bh % MLA_H;
#pragma unroll
        for (int r = 0; r < 8; ++r) { const float il = 1.0f / lsum[r];
            *(unsigned*)(O + ((size_t)b * SEQ + (size_t)c * 64 + 8 * w + r) * DM + h * VD + 2 * lane) = pk2(o0[r] * il, o1[r] * il); }
    }
}

namespace attn {
typedef float f32x16 __attribute__((ext_vector_type(16)));
typedef short s16x4 __attribute__((ext_vector_type(4)));
constexpr int NW = 8, QBLK = 32, KVBLK = 64, QB = NW * QBLK, DQ = 192, DV = 128, KROW = DQ * 2;
constexpr int SHM_V = KVBLK * DV * 2, SHM_K = KVBLK * DQ * 2;
constexpr int NVB = 3;
constexpr int LDS_BYTES = NVB * SHM_V + 2 * SHM_K + NW * 64 * 4;
constexpr float THR = 8.f;
#define KSWZ(row, colB) ((row) * KROW + ((colB) ^ ((((row) >> 1) & 7) << 4)))
#define SBAR() __builtin_amdgcn_sched_barrier(0)
__device__ __forceinline__ int v_st(int k, int c) { const int kk = (k & ~0xC) | ((k & 4) << 1) | ((k & 8) >> 1); return ((kk >> 3) * 4 + (c >> 5)) * 512 + ((kk & 7) * 32 + (c & 31)) * 2; }
__device__ __forceinline__ int v_rd_base(int lane) { return ((lane & 3) << 3) | (((lane >> 2) & 3) << 6) | (((lane >> 4) & 1) << 5) | (((lane >> 5) & 1) << 8); }
constexpr int v_rd_off(int d0, int ks, int half) { return d0 * 512 + ks * 4096 + half * 2048; }
__device__ __forceinline__ int crow(int r, int hi) { return (r & 3) + 8 * (r >> 2) + 4 * hi; }
__device__ __forceinline__ unsigned cvtpk(float lo, float hi) { unsigned r; asm volatile("v_cvt_pk_bf16_f32 %0, %1, %2" : "=v"(r) : "v"(lo), "v"(hi)); return r; }
__device__ __forceinline__ void partialSM(f32x16& p0, f32x16& p1, float& m_reg, float& mn, float& alpha) {
    float pmax = p0[0];
#pragma unroll
    for (int r = 1; r < 16; ++r) pmax = fmaxf(pmax, p0[r]);
#pragma unroll
    for (int r = 0; r < 16; ++r) pmax = fmaxf(pmax, p1[r]);
    { auto rr = __builtin_amdgcn_permlane32_swap(__float_as_uint(pmax), __float_as_uint(pmax), false, false);
      pmax = fmaxf(__uint_as_float(rr[0]), __uint_as_float(rr[1])); }
    if (__builtin_expect(__all(pmax - m_reg <= THR), 1)) { mn = m_reg; alpha = 1.f; }
    else { mn = fmaxf(m_reg, pmax); alpha = __builtin_amdgcn_exp2f(m_reg - mn); m_reg = mn; }
#pragma unroll
    for (int r = 0; r < 16; ++r) { p0[r] -= mn; p1[r] -= mn; }
#pragma unroll
    for (int r = 0; r < 16; ++r) p0[r] = __builtin_amdgcn_exp2f(p0[r]);
}
__device__ __forceinline__ void finishSM(f32x16& p0, f32x16& p1, float alpha, float& l_reg, bf16x8& pa0, bf16x8& pa1, bf16x8& pa2, bf16x8& pa3) {
#pragma unroll
    for (int r = 0; r < 16; ++r) p1[r] = __builtin_amdgcn_exp2f(p1[r]);
    float ps = 0;
#pragma unroll
    for (int r = 0; r < 16; ++r) ps += p0[r];
#pragma unroll
    for (int r = 0; r < 16; ++r) ps += p1[r];
    { auto rr = __builtin_amdgcn_permlane32_swap(__float_as_uint(ps), __float_as_uint(ps), false, false);
      ps = __uint_as_float(rr[0]) + __uint_as_float(rr[1]); }
    l_reg = l_reg * alpha + ps;
#define PK4(P, B_, OUT) do { unsigned a0 = cvtpk(P[B_+0], P[B_+1]), a1 = cvtpk(P[B_+2], P[B_+3]);                          \
        unsigned b0 = cvtpk(P[B_+4], P[B_+5]), b1 = cvtpk(P[B_+6], P[B_+7]);                                             \
        auto r0 = __builtin_amdgcn_permlane32_swap(a0, b0, false, false); auto r1 = __builtin_amdgcn_permlane32_swap(a1, b1, false, false); \
        v4u w = {r0[0], r1[0], r0[1], r1[1]}; OUT = *reinterpret_cast<bf16x8*>(&w); } while (0)
    PK4(p0, 0, pa0); PK4(p0, 8, pa1); PK4(p1, 0, pa2); PK4(p1, 8, pa3);
#undef PK4
}
__device__ __forceinline__ void partialSMf(f32x16& p0, f32x16& p1, float C) {
    if (__builtin_amdgcn_readfirstlane(__float_as_int(C)) != 0) {
#pragma unroll
        for (int r = 0; r < 16; ++r) { p0[r] -= C; p1[r] -= C; } }
#pragma unroll
    for (int r = 0; r < 16; ++r) p0[r] = __builtin_amdgcn_exp2f(p0[r]);
}
__device__ __forceinline__ void finishSMf(f32x16& p0, f32x16& p1, float& l_reg, bf16x8& pa0, bf16x8& pa1, bf16x8& pa2, bf16x8& pa3) {
#pragma unroll
    for (int r = 0; r < 16; ++r) p1[r] = __builtin_amdgcn_exp2f(p1[r]);
    float ps = 0;
#pragma unroll
    for (int r = 0; r < 16; ++r) ps += p0[r];
#pragma unroll
    for (int r = 0; r < 16; ++r) ps += p1[r];
    { auto rr = __builtin_amdgcn_permlane32_swap(__float_as_uint(ps), __float_as_uint(ps), false, false);
      ps = __uint_as_float(rr[0]) + __uint_as_float(rr[1]); }
    l_reg += ps;
#define PK4(P, B_, OUT) do { unsigned a0 = cvtpk(P[B_+0], P[B_+1]), a1 = cvtpk(P[B_+2], P[B_+3]);                          \
        unsigned b0 = cvtpk(P[B_+4], P[B_+5]), b1 = cvtpk(P[B_+6], P[B_+7]);                                             \
        auto r0 = __builtin_amdgcn_permlane32_swap(a0, b0, false, false); auto r1 = __builtin_amdgcn_permlane32_swap(a1, b1, false, false); \
        v4u w = {r0[0], r1[0], r0[1], r1[1]}; OUT = *reinterpret_cast<bf16x8*>(&w); } while (0)
    PK4(p0, 0, pa0); PK4(p0, 8, pa1); PK4(p1, 0, pa2); PK4(p1, 8, pa3);
#undef PK4
}
template <int KB>
__device__ __forceinline__ void qkt(f32x16& p0, f32x16& p1, const char* K_lds, int lane_in, const bf16x8* qr, bool act) {
    int l_ = lane_in; asm volatile("" : "+v"(l_)); const int r32 = l_ & 31, hi = l_ >> 5;
    if (!act) { const float NEG = -__builtin_inff();
#pragma unroll
        for (int r = 0; r < 16; ++r) { p0[r] = NEG; p1[r] = NEG; } return; }
    const char* kb[4];
    __builtin_amdgcn_s_setprio(1);
#pragma unroll
    for (int dd = 0; dd < 4; ++dd) kb[dd] = K_lds + KB * SHM_K + KSWZ(r32, (dd * 16 + hi * 8) * 2);
    { const f32x16 z = f32x16{};
      const bf16x8 b0 = *reinterpret_cast<const bf16x8*>(kb[0]), b1 = *reinterpret_cast<const bf16x8*>(kb[0] + 32 * KROW);
      p0 = __builtin_amdgcn_mfma_f32_32x32x16_bf16(b0, qr[0], z, 0, 0, 0); p1 = __builtin_amdgcn_mfma_f32_32x32x16_bf16(b1, qr[0], z, 0, 0, 0); }
#pragma unroll
    for (int d0 = 1; d0 < 12; ++d0) { const char* a = kb[d0 & 3] + (d0 >> 2) * 128;
        bf16x8 b0 = *reinterpret_cast<const bf16x8*>(a);
        bf16x8 b1 = *reinterpret_cast<const bf16x8*>(a + 32 * KROW);
        p0 = __builtin_amdgcn_mfma_f32_32x32x16_bf16(b0, qr[d0], p0, 0, 0, 0);
        p1 = __builtin_amdgcn_mfma_f32_32x32x16_bf16(b1, qr[d0], p1, 0, 0, 0); }
    __builtin_amdgcn_s_setprio(0);
    __builtin_amdgcn_sched_group_barrier(0x100, 8, 0);
#pragma unroll
    for (int i = 0; i < 8; ++i) { __builtin_amdgcn_sched_group_barrier(0x8, 2, 0); __builtin_amdgcn_sched_group_barrier(0x100, 2, 0); }
    __builtin_amdgcn_sched_group_barrier(0x8, 8, 0);
}
__device__ __forceinline__ void pv_tile(f32x16* o, int vb0, bf16x8 pa0, bf16x8 pa1, bf16x8 pa2, bf16x8 pa3, bool act) {
    if (!act) return;
#define TRRD(dst, off) asm volatile("ds_read_b64_tr_b16 %0, %1 offset:%2" : "=&v"(dst) : "v"(vb0), "i"(off) : "memory")
#define PV_RD(S_, d0) do { constexpr int b_ = v_rd_off(d0, 0, 0); TRRD(S_##l0, b_); TRRD(S_##h0, b_ + 2048); TRRD(S_##l1, b_ + 4096); TRRD(S_##h1, b_ + 6144); TRRD(S_##l2, b_ + 8192); TRRD(S_##h2, b_ + 10240); TRRD(S_##l3, b_ + 12288); TRRD(S_##h3, b_ + 14336); } while (0)
#define PV_MM(S_, d0) do { \
        o[d0] = __builtin_amdgcn_mfma_f32_32x32x16_bf16(pa0, (bf16x8){S_##l0[0], S_##l0[1], S_##l0[2], S_##l0[3], S_##h0[0], S_##h0[1], S_##h0[2], S_##h0[3]}, o[d0], 0, 0, 0);   \
        o[d0] = __builtin_amdgcn_mfma_f32_32x32x16_bf16(pa1, (bf16x8){S_##l1[0], S_##l1[1], S_##l1[2], S_##l1[3], S_##h1[0], S_##h1[1], S_##h1[2], S_##h1[3]}, o[d0], 0, 0, 0);   \
        o[d0] = __builtin_amdgcn_mfma_f32_32x32x16_bf16(pa2, (bf16x8){S_##l2[0], S_##l2[1], S_##l2[2], S_##l2[3], S_##h2[0], S_##h2[1], S_##h2[2], S_##h2[3]}, o[d0], 0, 0, 0);   \
        o[d0] = __builtin_amdgcn_mfma_f32_32x32x16_bf16(pa3, (bf16x8){S_##l3[0], S_##l3[1], S_##l3[2], S_##l3[3], S_##h3[0], S_##h3[1], S_##h3[2], S_##h3[3]}, o[d0], 0, 0, 0); } while (0)
#define PV_WAIT(n) do { asm volatile("s_waitcnt lgkmcnt(" #n ")" ::: "memory"); SBAR(); } while (0)
    s16x4 Al0, Al1, Al2, Al3, Ah0, Ah1, Ah2, Ah3, Bl0, Bl1, Bl2, Bl3, Bh0, Bh1, Bh2, Bh3;
    PV_RD(A, 0); PV_RD(B, 1); PV_WAIT(8); PV_MM(A, 0); SBAR();
    PV_RD(A, 2); PV_WAIT(8); PV_MM(B, 1); SBAR();
    PV_RD(B, 3); PV_WAIT(8); PV_MM(A, 2); SBAR();
    PV_WAIT(0); PV_MM(B, 3);
#undef PV_RD
#undef PV_MM
#undef PV_WAIT
#undef TRRD
}
struct BlockRef { const bf16* Q; const bf16* K; const bf16* V; bf16* O; int qb; const float* ssq; const float* rq; float smax; };
struct Seam { bf16x8 qr[12]; bf16x8 st_v0, st_v1, st_k0, st_k1, st_k2; };
#define VMW() asm volatile("s_waitcnt vmcnt(0)" ::: "memory")
#define VMWN(n) asm volatile("s_waitcnt vmcnt(%0)" :: "i"(n) : "memory")
#define SLOAD_H(Kp, Vp, t) do { const __amdgpu_buffer_rsrc_t rk_ = __builtin_amdgcn_make_buffer_rsrc((void*)(Kp), 0, SEQ * DQ * 2, 0x00020000), rv_ = __builtin_amdgcn_make_buffer_rsrc((void*)(Vp), 0, SEQ * DV * 2, 0x00020000); \
        int t16_ = tid * 16; asm volatile("" : "+v"(t16_)); const int sk_ = (t) * SHM_K, sv_ = (t) * SHM_V;     \
        S.st_v0 = __builtin_bit_cast(bf16x8, __builtin_amdgcn_raw_buffer_load_b128(rv_, t16_, sv_, 0)); S.st_v1 = __builtin_bit_cast(bf16x8, __builtin_amdgcn_raw_buffer_load_b128(rv_, t16_, sv_ + 8192, 0)); \
        S.st_k0 = __builtin_bit_cast(bf16x8, __builtin_amdgcn_raw_buffer_load_b128(rk_, t16_, sk_, 0)); S.st_k1 = __builtin_bit_cast(bf16x8, __builtin_amdgcn_raw_buffer_load_b128(rk_, t16_, sk_ + 8192, 0)); \
        S.st_k2 = __builtin_bit_cast(bf16x8, __builtin_amdgcn_raw_buffer_load_b128(rk_, t16_, sk_ + 16384, 0)); } while (0)
#define SWRITE_HK(bf) do { int t_ = tid; asm volatile("" : "+v"(t_)); const int c0_ = t_, c1_ = t_ + 512, c2_ = t_ + 1024; char* kb_ = K_lds + (bf) * SHM_K;     \
        *(bf16x8*)(kb_ + KSWZ(c0_ / 24, (c0_ % 24) * 16)) = S.st_k0; *(bf16x8*)(kb_ + KSWZ(c1_ / 24, (c1_ % 24) * 16)) = S.st_k1; *(bf16x8*)(kb_ + KSWZ(c2_ / 24, (c2_ % 24) * 16)) = S.st_k2; } while (0)
#define SWRITE_HV(bf) do { int t_ = tid; asm volatile("" : "+v"(t_)); char* vb_ = V_lds + (bf) * SHM_V + v_st(t_ >> 4, (t_ & 15) * 8); *(bf16x8*)vb_ = S.st_v0; *(bf16x8*)(vb_ + 8192) = S.st_v1; } while (0)
#define SWRITE_H(bf) do { SWRITE_HV(bf); SWRITE_HK(bf); } while (0)
#define QLOAD(ref) do { _Pragma("unroll") for (int d0 = 0; d0 < 12; ++d0) S.qr[d0] = *(const bf16x8*)((ref).Q + (size_t)(wid * QBLK + r32) * DQ + d0 * 16 + hi * 8); } while (0)
#define KW_SETUP()
__device__ __forceinline__ int vbase_of(char* V_lds, int lane) { int l_ = lane; asm volatile("" : "+v"(l_)); return (int)(uintptr_t)V_lds + v_rd_base(l_); }
__device__ __forceinline__ void prime(const BlockRef& cur, char* lds, Seam& S) {
    const int tid = threadIdx.x, wid = __builtin_amdgcn_readfirstlane(tid >> 6), lane = tid & 63, r32 = lane & 31, hi = lane >> 5;
    char* K_lds = lds + NVB * SHM_V;
    QLOAD(cur);
    SLOAD_H(cur.K, cur.V, 0); VMW(); SWRITE_HK(0);
    __syncthreads();
}
__device__ __forceinline__ void block(const BlockRef& cur, const BlockRef& nxt, char* lds, Seam& S) {
    int tid = threadIdx.x; asm volatile("" : "+v"(tid));
    const int wid = __builtin_amdgcn_readfirstlane(tid >> 6), lane = tid & 63, r32 = lane & 31, hi = lane >> 5;
    const int NT = 4 * cur.qb + 4;
    const int tmax = 4 * cur.qb + (wid >> 1);
    char* V_lds = lds; char* K_lds = lds + NVB * SHM_V;
    float* ws = (float*)(lds + NVB * SHM_V + 2 * SHM_K) + wid * 64; float* li_l = ws, * al_l = ws + 32;
    float m_reg = -1e30f, l_reg = 0; f32x16 o[4] = {};
    const bf16* Kh = cur.K; const bf16* Vh = cur.V;
#define RESC(a) do { if (__any((a) < 1.f)) { int l_ = lane; asm volatile("" : "+v"(l_)); const int r32_ = l_ & 31, hi_ = l_ >> 5; if (hi_ == 0) al_l[r32_] = (a); asm volatile("s_waitcnt lgkmcnt(0)" ::: "memory");              \
                     _Pragma("unroll") for (int d_ = 0; d_ < 4; ++d_) _Pragma("unroll") for (int r = 0; r < 16; ++r) o[d_][r] *= al_l[crow(r, hi_)]; } } while (0)
#define ACT(t) ((t) <= tmax)
    f32x16 pA0, pA1, pB0, pB1; float mnA, mnB, alA, alB; bf16x8 pa0, pa1, pa2, pa3;
    SWRITE_HV(0); SBAR();
    SLOAD_H(Kh, Vh, 1);
    SBAR(); qkt<0>(pA0, pA1, K_lds, lane, S.qr, true);
    partialSM(pA0, pA1, m_reg, mnA, alA);
    VMW(); SWRITE_H(1);
    __syncthreads();
    int vr = 0, vw = 2;
#define VROT(x) ((x) == NVB - 1 ? 0 : (x) + 1)
#define HALF_STEP(PX0, PX1, mnX, alX, PY0, PY1, alY, t, KB, SB) do {                                                          \
        SBAR(); if ((t) + 1 < NT) { SLOAD_H(Kh, Vh, (t) + 1); SBAR(); }                 \
        qkt<KB>(PX0, PX1, K_lds, lane, S.qr, ACT(t));                                                                     \
        finishSM(PY0, PY1, alY, l_reg, pa0, pa1, pa2, pa3); SBAR();                                                           \
        pv_tile(o, vbase_of(V_lds, lane) + vr * SHM_V, pa0, pa1, pa2, pa3, ACT((t) - 1));                                                       \
        if ((t) + 1 < NT) { VMW(); SWRITE_HK(SB); SWRITE_HV(vw); SBAR(); }                                                   \
        partialSM(PX0, PX1, m_reg, mnX, alX);                                                                                 \
        RESC(alX); vr = VROT(vr); vw = VROT(vw); __syncthreads(); } while (0)
    for (int t = 1; t + 1 < NT; t += 2) {
        HALF_STEP(pB0, pB1, mnB, alB, pA0, pA1, alA, t, 1, 0);
        HALF_STEP(pA0, pA1, mnA, alA, pB0, pB1, alB, t + 1, 0, 1);
    }
    SBAR(); qkt<1>(pB0, pB1, K_lds, lane, S.qr, ACT(NT - 1)); SBAR();
    SLOAD_H(nxt.K, nxt.V, 0); SBAR();
    QLOAD(nxt);
    SBAR();
    finishSM(pA0, pA1, alA, l_reg, pa0, pa1, pa2, pa3); SBAR();
    pv_tile(o, vbase_of(V_lds, lane) + vr * SHM_V, pa0, pa1, pa2, pa3, ACT(NT - 2));
    partialSM(pB0, pB1, m_reg, mnB, alB); __syncthreads(); RESC(alB);
    finishSM(pB0, pB1, alB, l_reg, pa0, pa1, pa2, pa3); SBAR(); pv_tile(o, vbase_of(V_lds, lane) + VROT(vr) * SHM_V, pa0, pa1, pa2, pa3, ACT(NT - 1));
    SBAR(); VMWN(12); SWRITE_HK(0); SBAR();
    { int le = lane; asm volatile("" : "+v"(le)); const int r32e = le & 31, hie = le >> 5;
      if (hie == 0) li_l[r32e] = l_reg; asm volatile("s_waitcnt lgkmcnt(0)" ::: "memory");
      float rli[16];
#pragma unroll
      for (int r = 0; r < 16; ++r) rli[r] = __builtin_amdgcn_rcpf(li_l[crow(r, hie)]);
      bf16* Ow = cur.O + (size_t)(wid * QBLK) * DM;
#pragma unroll
      for (int r = 0; r < 16; ++r) { const int orow = crow(r, hie);
#pragma unroll
          for (int d0 = 0; d0 < 4; ++d0) { const float v = o[d0][r] * rli[r]; const float vn = __shfl_xor(v, 1);
              if ((r32e & 1) == 0) *(unsigned*)(Ow + (size_t)orow * DM + d0 * 32 + r32e) = cvtpk(v, vn); } } }
    __syncthreads();
#undef RESC
#undef ACT
#undef HALF_STEP
#undef VROT
}
#undef VMW
#undef VMWN
#undef SLOAD_H
#undef SWRITE_HK
#undef SWRITE_HV
#undef SWRITE_H
#undef QLOAD
#undef KW_SETUP
#undef KSWZ
#undef SBAR
}
__device__ __forceinline__ attn::BlockRef attn_ref(Frame& F, int bh, int qb) {
    attn::BlockRef r; const int b = bh / MLA_H, h = bh % MLA_H;
    r.Q = WSP(bf16, WS_Q) + ((size_t)bh * SEQ + (size_t)qb * 256) * QKD; r.K = WSP(bf16, WS_K) + (size_t)bh * SEQ * QKD; r.V = WSP(bf16, WS_V) + (size_t)bh * SEQ * VD;
    r.O = WSP(bf16, WS_OATT) + ((size_t)b * SEQ + (size_t)qb * 256) * DM + h * VD; r.qb = qb;
    r.ssq = WSP(float, WS_SSQ) + ((size_t)b * SEQ + (size_t)qb * 256) * 48 + 6 * h; r.rq = WSP(float, WS_RQ) + (size_t)b * SEQ + (size_t)qb * 256; r.smax = *WSP(float, WS_SMAX); return r;
}
__device__ __forceinline__ void p4_attn_mfma(Frame& F) {
    char* lds = (char*)(F.lds + RING_OFF);
    constexpr int NITEM = BATCH * MLA_H * 16;
    attn::Seam S;
    int it = F.vcu; if (it >= NITEM) return;
    int pass = 0;
    attn::BlockRef cur = attn_ref(F, it / 16, it % 16);
    __syncthreads();
    attn::prime(cur, lds, S);
    for (;;) {
        const bool more_pass = pass == 0, more_item = it + F.G < NITEM, last = !more_pass && !more_item;
        int itn = it, passn = pass + 1; if (!more_pass) { passn = 0; itn = more_item ? it + F.G : it; }
        const attn::BlockRef nxt = last ? cur : attn_ref(F, itn / 16, passn ? 31 - (itn % 16) : itn % 16);
        attn::block(cur, nxt, lds, S);
        if (last) break;
        cur = nxt; it = itn; pass = passn;
    }
}
namespace attn3 {
using namespace attn;
constexpr int NKB = 3, NVB3 = 3;
constexpr int LDS_BYTES3 = NVB3 * SHM_V + NKB * SHM_K + NW * 64 * 4;
#define KSWZ3(row, colB) ((row) * KROW + ((colB) ^ ((((row) >> 1) & 7) << 4)))
#define SBAR3() __builtin_amdgcn_sched_barrier(0)
typedef __attribute__((address_space(3))) unsigned las_u32;
__device__ __forceinline__ void qkt_rt3k(f32x16& p0, f32x16& p1, const char* Kb, const int (&kso)[4], const bf16x8* qr, bool act);
__device__ __forceinline__ void qkt_rt3(f32x16& p0, f32x16& p1, const char* Kb, int lane_in, const bf16x8* qr, bool act) {
    int l_ = lane_in; asm volatile("" : "+v"(l_)); const int r32 = l_ & 31, hi = l_ >> 5;
    if (!act) { const float NEG = -__builtin_inff();
#pragma unroll
        for (int r = 0; r < 16; ++r) { p0[r] = NEG; p1[r] = NEG; } return; }
    const char* kb[4];
#pragma unroll
    for (int dd = 0; dd < 4; ++dd) kb[dd] = Kb + KSWZ3(r32, (dd * 16 + hi * 8) * 2);
    { const f32x16 z = f32x16{};
      const bf16x8 b0 = *reinterpret_cast<const bf16x8*>(kb[0]), b1 = *reinterpret_cast<const bf16x8*>(kb[0] + 32 * KROW);
      p0 = __builtin_amdgcn_mfma_f32_32x32x16_bf16(b0, qr[0], z, 0, 0, 0); p1 = __builtin_amdgcn_mfma_f32_32x32x16_bf16(b1, qr[0], z, 0, 0, 0); }
#pragma unroll
    for (int d0 = 1; d0 < 12; ++d0) { const char* a = kb[d0 & 3] + (d0 >> 2) * 128;
        const bf16x8 b0 = *reinterpret_cast<const bf16x8*>(a), b1 = *reinterpret_cast<const bf16x8*>(a + 32 * KROW);
        p0 = __builtin_amdgcn_mfma_f32_32x32x16_bf16(b0, qr[d0], p0, 0, 0, 0);
        p1 = __builtin_amdgcn_mfma_f32_32x32x16_bf16(b1, qr[d0], p1, 0, 0, 0); }
    __builtin_amdgcn_sched_group_barrier(0x100, 8, 0);
#pragma unroll
    for (int i = 0; i < 8; ++i) { __builtin_amdgcn_sched_group_barrier(0x8, 2, 0); __builtin_amdgcn_sched_group_barrier(0x100, 2, 0); }
    __builtin_amdgcn_sched_group_barrier(0x8, 8, 0);
}
__device__ __forceinline__ void qkt_rt3k(f32x16& p0, f32x16& p1, const char* Kb, const int (&kso)[4], const bf16x8* qr, bool act) {
    if (!act) { const float NEG = -__builtin_inff();
#pragma unroll
        for (int r = 0; r < 16; ++r) { p0[r] = NEG; p1[r] = NEG; } return; }
    const char* kb[4];
#pragma unroll
    for (int dd = 0; dd < 4; ++dd) kb[dd] = Kb + kso[dd];
    { const f32x16 z = f32x16{};
      const bf16x8 b0 = *reinterpret_cast<const bf16x8*>(kb[0]), b1 = *reinterpret_cast<const bf16x8*>(kb[0] + 32 * KROW);
      p0 = __builtin_amdgcn_mfma_f32_32x32x16_bf16(b0, qr[0], z, 0, 0, 0); p1 = __builtin_amdgcn_mfma_f32_32x32x16_bf16(b1, qr[0], z, 0, 0, 0); }
#pragma unroll
    for (int d0 = 1; d0 < 12; ++d0) { const char* a = kb[d0 & 3] + (d0 >> 2) * 128;
        const bf16x8 b0 = *reinterpret_cast<const bf16x8*>(a), b1 = *reinterpret_cast<const bf16x8*>(a + 32 * KROW);
        p0 = __builtin_amdgcn_mfma_f32_32x32x16_bf16(b0, qr[d0], p0, 0, 0, 0);
        p1 = __builtin_amdgcn_mfma_f32_32x32x16_bf16(b1, qr[d0], p1, 0, 0, 0); }
    __builtin_amdgcn_sched_group_barrier(0x100, 8, 0);
#pragma unroll
    for (int i = 0; i < 8; ++i) { __builtin_amdgcn_sched_group_barrier(0x8, 2, 0); __builtin_amdgcn_sched_group_barrier(0x100, 2, 0); }
    __builtin_amdgcn_sched_group_barrier(0x8, 8, 0);
}
template <bool ALWAYS>
__device__ __forceinline__ void qkt_fsm(f32x16& p0, f32x16& p1, const char* Kb, int lane_in, const bf16x8* qr, bool act,
                                        f32x16& y0, f32x16& y1, float alpha, float& l_reg, bf16x8& pa0, bf16x8& pa1, bf16x8& pa2, bf16x8& pa3) {
    if (!ALWAYS && !act) { qkt_rt3(p0, p1, Kb, lane_in, qr, false); finishSM(y0, y1, alpha, l_reg, pa0, pa1, pa2, pa3); return; }
    int l_ = lane_in; asm volatile("" : "+v"(l_)); const int r32 = l_ & 31, hi = l_ >> 5;
    const char* kb[4];
#pragma unroll
    for (int dd = 0; dd < 4; ++dd) kb[dd] = Kb + KSWZ3(r32, (dd * 16 + hi * 8) * 2);
#define KF(d0, B0, B1) do { const char* a_ = kb[(d0) & 3] + ((d0) >> 2) * 128; B0 = *reinterpret_cast<const bf16x8*>(a_); B1 = *reinterpret_cast<const bf16x8*>(a_ + 32 * KROW); } while (0)
#define PK4(P, B_, OUT) do { unsigned a0 = cvtpk(P[B_+0], P[B_+1]), a1 = cvtpk(P[B_+2], P[B_+3]);                          \
        unsigned b0 = cvtpk(P[B_+4], P[B_+5]), b1 = cvtpk(P[B_+6], P[B_+7]);                                             \
        auto r0 = __builtin_amdgcn_permlane32_swap(a0, b0, false, false); auto r1 = __builtin_amdgcn_permlane32_swap(a1, b1, false, false); \
        v4u w = {r0[0], r1[0], r0[1], r1[1]}; OUT = *reinterpret_cast<bf16x8*>(&w); } while (0)
    bf16x8 fa0, fa1, fb0, fb1;
    const f32x16 z = f32x16{};
    float s0, s1, s2, s3;
    KF(0, fa0, fa1); SBAR3();
    KF(1, fb0, fb1); p0 = __builtin_amdgcn_mfma_f32_32x32x16_bf16(fa0, qr[0], z, 0, 0, 0); p1 = __builtin_amdgcn_mfma_f32_32x32x16_bf16(fa1, qr[0], z, 0, 0, 0); SBAR3();
#pragma unroll
    for (int r = 0; r < 4; ++r) y1[r] = __builtin_amdgcn_exp2f(y1[r]); SBAR3();
    KF(2, fa0, fa1); p0 = __builtin_amdgcn_mfma_f32_32x32x16_bf16(fb0, qr[1], p0, 0, 0, 0); p1 = __builtin_amdgcn_mfma_f32_32x32x16_bf16(fb1, qr[1], p1, 0, 0, 0); SBAR3();
#pragma unroll
    for (int r = 4; r < 8; ++r) y1[r] = __builtin_amdgcn_exp2f(y1[r]); SBAR3();
    KF(3, fb0, fb1); p0 = __builtin_amdgcn_mfma_f32_32x32x16_bf16(fa0, qr[2], p0, 0, 0, 0); p1 = __builtin_amdgcn_mfma_f32_32x32x16_bf16(fa1, qr[2], p1, 0, 0, 0); SBAR3();
#pragma unroll
    for (int r = 8; r < 12; ++r) y1[r] = __builtin_amdgcn_exp2f(y1[r]); SBAR3();
    KF(4, fa0, fa1); p0 = __builtin_amdgcn_mfma_f32_32x32x16_bf16(fb0, qr[3], p0, 0, 0, 0); p1 = __builtin_amdgcn_mfma_f32_32x32x16_bf16(fb1, qr[3], p1, 0, 0, 0); SBAR3();
#pragma unroll
    for (int r = 12; r < 16; ++r) y1[r] = __builtin_amdgcn_exp2f(y1[r]); SBAR3();
    KF(5, fb0, fb1); p0 = __builtin_amdgcn_mfma_f32_32x32x16_bf16(fa0, qr[4], p0, 0, 0, 0); p1 = __builtin_amdgcn_mfma_f32_32x32x16_bf16(fa1, qr[4], p1, 0, 0, 0); SBAR3();
    s0 = ((y0[0] + y0[1]) + (y0[2] + y0[3])) + ((y0[4] + y0[5]) + (y0[6] + y0[7])); SBAR3();
    KF(6, fa0, fa1); p0 = __builtin_amdgcn_mfma_f32_32x32x16_bf16(fb0, qr[5], p0, 0, 0, 0); p1 = __builtin_amdgcn_mfma_f32_32x32x16_bf16(fb1, qr[5], p1, 0, 0, 0); SBAR3();
    s1 = ((y0[8] + y0[9]) + (y0[10] + y0[11])) + ((y0[12] + y0[13]) + (y0[14] + y0[15])); SBAR3();
    KF(7, fb0, fb1); p0 = __builtin_amdgcn_mfma_f32_32x32x16_bf16(fa0, qr[6], p0, 0, 0, 0); p1 = __builtin_amdgcn_mfma_f32_32x32x16_bf16(fa1, qr[6], p1, 0, 0, 0); SBAR3();
    s2 = ((y1[0] + y1[1]) + (y1[2] + y1[3])) + ((y1[4] + y1[5]) + (y1[6] + y1[7])); SBAR3();
    KF(8, fa0, fa1); p0 = __builtin_amdgcn_mfma_f32_32x32x16_bf16(fb0, qr[7], p0, 0, 0, 0); p1 = __builtin_amdgcn_mfma_f32_32x32x16_bf16(fb1, qr[7], p1, 0, 0, 0); SBAR3();
    s3 = ((y1[8] + y1[9]) + (y1[10] + y1[11])) + ((y1[12] + y1[13]) + (y1[14] + y1[15])); SBAR3();
    KF(9, fb0, fb1); p0 = __builtin_amdgcn_mfma_f32_32x32x16_bf16(fa0, qr[8], p0, 0, 0, 0); p1 = __builtin_amdgcn_mfma_f32_32x32x16_bf16(fa1, qr[8], p1, 0, 0, 0); SBAR3();
    { float ps = (s0 + s1) + (s2 + s3);
      auto rr = __builtin_amdgcn_permlane32_swap(__float_as_uint(ps), __float_as_uint(ps), false, false); ps = __uint_as_float(rr[0]) + __uint_as_float(rr[1]);
      l_reg = l_reg * alpha + ps; }
    PK4(y0, 0, pa0); SBAR3();
    KF(10, fa0, fa1); p0 = __builtin_amdgcn_mfma_f32_32x32x16_bf16(fb0, qr[9], p0, 0, 0, 0); p1 = __builtin_amdgcn_mfma_f32_32x32x16_bf16(fb1, qr[9], p1, 0, 0, 0); SBAR3();
    PK4(y0, 8, pa1); SBAR3();
    KF(11, fb0, fb1); p0 = __builtin_amdgcn_mfma_f32_32x32x16_bf16(fa0, qr[10], p0, 0, 0, 0); p1 = __builtin_amdgcn_mfma_f32_32x32x16_bf16(fa1, qr[10], p1, 0, 0, 0); SBAR3();
    PK4(y1, 0, pa2); SBAR3();
    p0 = __builtin_amdgcn_mfma_f32_32x32x16_bf16(fb0, qr[11], p0, 0, 0, 0); p1 = __builtin_amdgcn_mfma_f32_32x32x16_bf16(fb1, qr[11], p1, 0, 0, 0); SBAR3();
    PK4(y1, 8, pa3);
#undef KF
#undef PK4
}
__device__ __forceinline__ void block3(const BlockRef& cur, char* lds) {
    int tid = threadIdx.x; asm volatile("" : "+v"(tid));
    const int wid = __builtin_amdgcn_readfirstlane(tid >> 6), lane = tid & 63, r32 = lane & 31, hi = lane >> 5;
    const int NT = 4 * cur.qb + 4;
    const int tmax = 4 * cur.qb + (wid >> 1);
    char* V_lds = lds; char* K_lds = lds + NVB3 * SHM_V;
    float* ws = (float*)(lds + NVB3 * SHM_V + NKB * SHM_K) + wid * 64; float* li_l = ws, * al_l = ws + 32;
    float l_reg = 0; f32x16 o[4] = {}; const float smax = cur.smax > 40.f ? cur.smax - 40.f : 0.f;
    const char* Kg = (const char*)cur.K; const char* Vg = (const char*)cur.V;
    const unsigned ldsK = (unsigned)(uintptr_t)K_lds, ldsV = (unsigned)(uintptr_t)V_lds;
    const int vbase = (int)(uintptr_t)V_lds + v_rd_base(lane);
    int kso[4];
#pragma unroll
    for (int dd = 0; dd < 4; ++dd) kso[dd] = KSWZ3(r32, (dd * 16 + hi * 8) * 2);
    unsigned koff[3], voff[2];
#pragma unroll
    for (int j_ = 0; j_ < 3; ++j_) { const int A_ = (wid * 3 + j_) * 1024 + lane * 16, row_ = A_ / KROW, pc_ = (A_ % KROW) >> 4, c_ = (pc_ & 24) | ((pc_ & 7) ^ ((row_ >> 1) & 7)); koff[j_] = (unsigned)(row_ * KROW + c_ * 16); }
#pragma unroll
    for (int j_ = 0; j_ < 2; ++j_) { const int a_ = (wid * 2 + j_) * 64 + lane, sub_ = a_ >> 5, kk_ = (sub_ >> 2) * 8 + ((a_ & 31) >> 2), k_ = (kk_ & ~0xC) | ((kk_ & 4) << 1) | ((kk_ & 8) >> 1), c_ = (sub_ & 3) * 32 + (a_ & 3) * 8; voff[j_] = (unsigned)(k_ * (DV * 2) + c_ * 2); }
#define DMA_K(t, slot) do { _Pragma("unroll") for (int j_ = 0; j_ < 3; ++j_) \
        __builtin_amdgcn_global_load_lds((const unsigned*)(Kg + (size_t)(t) * SHM_K + koff[j_]), (las_u32*)(uintptr_t)(ldsK + (slot) * SHM_K + (wid * 3 + j_) * 1024), 16, 0, 0); } while (0)
#define DMA_V(t, slot) do { _Pragma("unroll") for (int j_ = 0; j_ < 2; ++j_) \
        __builtin_amdgcn_global_load_lds((const unsigned*)(Vg + (size_t)(t) * SHM_V + voff[j_]), (las_u32*)(uintptr_t)(ldsV + (slot) * SHM_V + (wid * 2 + j_) * 1024), 16, 0, 0); } while (0)
#define WBAR(n) asm volatile("s_waitcnt vmcnt(" #n ") lgkmcnt(0)\n\ts_barrier" ::: "memory")
#define RESC3(a) do { if (__any((a) < 1.f)) { int l_ = lane; asm volatile("" : "+v"(l_)); const int r32_ = l_ & 31, hi_ = l_ >> 5; if (hi_ == 0) al_l[r32_] = (a); asm volatile("s_waitcnt lgkmcnt(0)" ::: "memory");              \
                     _Pragma("unroll") for (int d_ = 0; d_ < 4; ++d_) _Pragma("unroll") for (int r = 0; r < 16; ++r) o[d_][r] *= al_l[crow(r, hi_)]; } } while (0)
#define ACT3(t) ((t) <= tmax)
    if (wid >= 4) __builtin_amdgcn_s_setprio(2);
    WBAR(0);
    DMA_K(0, 0); DMA_V(0, 0); DMA_K(1, 1);
    bf16x8 qr[12];
#pragma unroll
    for (int d0 = 0; d0 < 12; ++d0) qr[d0] = *(const bf16x8*)(cur.Q + (size_t)(wid * QBLK + r32) * DQ + d0 * 16 + hi * 8);
    {
      const float* sp = cur.ssq + (size_t)(wid * QBLK + r32) * 48; const float rqv = cur.rq[wid * QBLK + r32];
      const float ssv = ((sp[0] + sp[1]) + (sp[2] + sp[3])) + (sp[4] + sp[5]);
      const float sc = rqv * rsqrtf(rqv * rqv * ssv * (1.f / 192.f) + 1e-6f) * QSCALE;
      asm volatile("s_waitcnt vmcnt(0)" ::: "memory");
#pragma unroll
      for (int d0 = 0; d0 < 12; ++d0) { v4u w = __builtin_bit_cast(v4u, qr[d0]); v4u o;
          o.x = cvtpk(blo(w.x) * sc, bhi(w.x) * sc); o.y = cvtpk(blo(w.y) * sc, bhi(w.y) * sc); o.z = cvtpk(blo(w.z) * sc, bhi(w.z) * sc); o.w = cvtpk(blo(w.w) * sc, bhi(w.w) * sc);
          qr[d0] = __builtin_bit_cast(bf16x8, o); } }
    asm volatile("s_waitcnt vmcnt(0)" ::: "memory");
#pragma unroll
    for (int d0 = 0; d0 < 12; ++d0) asm volatile("" : "+v"(qr[d0]));
    WBAR(0);
    f32x16 pA0, pA1, pB0, pB1; bf16x8 pa0, pa1, pa2, pa3;
    DMA_K(2, 2); DMA_V(1, 1);
    SBAR3(); qkt_rt3k(pA0, pA1, K_lds, kso, qr, true);
    partialSMf(pA0, pA1, smax);
    WBAR(5);
    int bt = 1;
#define WINDOW3(PX0, PX1, PY0, PY1, t, ALW) do { const int nx_ = bt == 2 ? 0 : bt + 1, pv_ = bt == 0 ? 2 : bt - 1;           \
        SBAR3(); if ((t) + 2 < NT) DMA_K((t) + 2, pv_); if ((t) + 1 < NT) DMA_V((t) + 1, nx_); SBAR3();                                     \
        qkt_rt3k(PX0, PX1, K_lds + bt * SHM_K, kso, qr, ALW || ACT3(t)); finishSMf(PY0, PY1, l_reg, pa0, pa1, pa2, pa3); SBAR3();            \
        pv_tile(o, vbase + pv_ * SHM_V, pa0, pa1, pa2, pa3, ALW || ACT3((t) - 1));                                           \
        partialSMf(PX0, PX1, smax);                                                                                    \
        bt = nx_; SBAR3(); if ((t) + 2 < NT) WBAR(5); else if ((t) + 1 < NT) WBAR(2); else WBAR(0); SBAR3(); } while (0)
    int t = 1;
    for (; t + 1 < NT - 3; t += 2) {
        WINDOW3(pB0, pB1, pA0, pA1, t, true);
        WINDOW3(pA0, pA1, pB0, pB1, t + 1, true);
    }
    for (; t + 1 < NT; t += 2) {
        WINDOW3(pB0, pB1, pA0, pA1, t, false);
        WINDOW3(pA0, pA1, pB0, pB1, t + 1, false);
    }
    WINDOW3(pB0, pB1, pA0, pA1, NT - 1, false);
    finishSMf(pB0, pB1, l_reg, pa0, pa1, pa2, pa3); SBAR3();
    pv_tile(o, vbase + (bt == 0 ? 2 : bt - 1) * SHM_V, pa0, pa1, pa2, pa3, ACT3(NT - 1));
    __builtin_amdgcn_s_setprio(0);
    { int le = lane; asm volatile("" : "+v"(le)); const int r32e = le & 31, hie = le >> 5;
      if (hie == 0) li_l[r32e] = l_reg; asm volatile("s_waitcnt lgkmcnt(0)" ::: "memory");
      float rli[16];
#pragma unroll
      for (int r = 0; r < 16; ++r) rli[r] = __builtin_amdgcn_rcpf(li_l[crow(r, hie)]);
      bf16* Ow = cur.O + (size_t)(wid * QBLK) * DM;
#pragma unroll
      for (int r = 0; r < 16; ++r) { const int orow = crow(r, hie);
#pragma unroll
          for (int d0 = 0; d0 < 4; ++d0) { const float v = o[d0][r] * rli[r]; const float vn = __shfl_xor(v, 1);
              if ((r32e & 1) == 0) *(unsigned*)(Ow + (size_t)orow * DM + d0 * 32 + r32e) = cvtpk(v, vn); } } }
#undef DMA_K
#undef DMA_V
#undef WBAR
#undef RESC3
#undef ACT3
#undef WINDOW3
}
#undef KSWZ3
#undef SBAR3
}
__device__ __forceinline__ void p4_attn_dma(Frame& F) {
    char* lds = (char*)(F.lds + RING_OFF);
    constexpr int NITEM = BATCH * MLA_H * 16;
    for (int it = F.vcu; it < NITEM; it += F.G) {
#pragma unroll 1
        for (int pass = 0; pass < 2; ++pass) { const attn::BlockRef cur = attn_ref(F, it / 16, pass ? 31 - (it % 16) : it % 16); attn3::block3(cur, lds); }
    }
    asm volatile("s_waitcnt vmcnt(0) lgkmcnt(0)" ::: "memory"); __syncthreads();
}
__device__ __forceinline__ void p2_rq(Frame& F) {
    const int gw = F.vcu * NWAVES + F.wave, NGW = F.G * NWAVES, l = F.lane; const bf16* QL = WSP(bf16, WS_QLAT); float* RQ = WSP(float, WS_RQ);
    for (int base = gw; base < T; base += 8 * NGW) {
        v4u w[8];
#pragma unroll
        for (int i = 0; i < 8; ++i) { const int t = base + i * NGW; w[i] = *(const v4u*)(QL + (size_t)(t < T ? t : base) * QRANK + 8 * (l < 48 ? l : 0)); }
#pragma unroll
        for (int i = 0; i < 8; ++i) { const int t = base + i * NGW; float v[8]; unpack8(w[i], v); float ss = 0.f;
            if (l < 48) {
#pragma unroll
                for (int e = 0; e < 8; ++e) ss += v[e] * v[e]; }
            ss = wave_sum(ss); if (l == 0 && t < T) RQ[t] = rsqrtf(ss * (1.f / QRANK) + EPS); }
    }
}
__device__ __forceinline__ void p5a_conv(Frame& F) {
    const bf16* PROJ = WSP(bf16, WS_PROJ); bf16* XC = WSP(bf16, WS_XC);
    const float* cw = F.in[I_CONVW]; const float* cb = F.in[I_CONVB];
    constexpr int TB = 8, NIT = (T / TB) * (CONV_DIM / 8);
    const bool skew = F.G == 256; const int bx = (int)blockIdx.x; const bool lowb = bx < 128;
    const int it0 = !skew ? F.vcu * NTHR + F.tid : lowb ? bx * NTHR + F.tid : NIT / 3 + (bx - 128) * NTHR + F.tid, itE = !skew ? NIT : lowb ? NIT / 3 : NIT, itS = !skew ? F.G * NTHR : 128 * NTHR;
    static_assert(NIT % 3 == 0 && (NIT / 3) % (128 * NTHR) == 0, "conv split");
    for (int it = it0; it < itE; it += itS) {
        const int c0 = (it % (CONV_DIM / 8)) * 8, tk0 = (it / (CONV_DIM / 8)) * TB, s0 = tk0 % SEQ;
        float w[4][8], bias[8];
#pragma unroll
        for (int k = 0; k < 4; ++k) { const f32x4 a = *(const f32x4*)(cw + k * CONV_DIM + c0), b = *(const f32x4*)(cw + k * CONV_DIM + c0 + 4);
            w[k][0] = a[0]; w[k][1] = a[1]; w[k][2] = a[2]; w[k][3] = a[3]; w[k][4] = b[0]; w[k][5] = b[1]; w[k][6] = b[2]; w[k][7] = b[3]; }
        { const f32x4 a = *(const f32x4*)(cb + c0), b = *(const f32x4*)(cb + c0 + 4); bias[0] = a[0]; bias[1] = a[1]; bias[2] = a[2]; bias[3] = a[3]; bias[4] = b[0]; bias[5] = b[1]; bias[6] = b[2]; bias[7] = b[3]; }
        const bf16* src = PROJ + (size_t)tk0 * IN_PAD + OFF_XBC + c0;
        v4u raw[TB + 3];
#pragma unroll
        for (int i = 0; i < TB + 3; ++i) raw[i] = (s0 + i - 3 >= 0) ? *(const v4u*)(src + (ptrdiff_t)(i - 3) * IN_PAD) : (v4u){0u, 0u, 0u, 0u};
#pragma unroll
        for (int i = 0; i < TB; ++i) { float acc[8];
#pragma unroll
            for (int e = 0; e < 8; ++e) acc[e] = bias[e];
#pragma unroll
            for (int k = 0; k < 4; ++k) { float v[8]; unpack8(raw[i + k], v);
#pragma unroll
                for (int e = 0; e < 8; ++e) acc[e] += v[e] * w[k][e]; }
#pragma unroll
            for (int e = 0; e < 8; ++e) acc[e] = siluf_(acc[e]);
            *(v4u*)(XC + (size_t)(tk0 + i) * CONV_DIM + c0) = pack8(acc); }
    }
}

__device__ __forceinline__ void p5_ssd_naive(Frame& F) {
    const bf16* PROJ = WSP(bf16, WS_PROJ); const bf16* XC = WSP(bf16, WS_XC); bf16* YN = WSP(bf16, WS_YN);
    LAS float* sB = (LAS float*)(F.lds); LAS float* sC = sB + 128; LAS float* part = sC + 128;
    const int tid = F.tid, e = tid >> 6, p = tid & 63;
    for (int it = (int)blockIdx.x; it < BATCH * SSD_G; it += F.G) {
        const int b = it / SSD_G, g = it % SSD_G, h = g * SSD_HPG + e, col = h * SSD_P + p;
        const float a = -__expf(F.in[I_ALOG][h]), dtb = F.in[I_DTB][h], dsk = F.in[I_DSKIP][h], gn = F.in[I_GSSD][col];
        float st[128];
#pragma unroll
        for (int n = 0; n < 128; ++n) st[n] = 0.f;
        for (int s = 0; s < SEQ; ++s) {
            const size_t row = (size_t)b * SEQ + s;
            __syncthreads();
            if (tid < 256) { const float v = bf2f(XC[row * CONV_DIM + 1024 + (tid >> 7) * 256 + g * 128 + (tid & 127)]); if (tid < 128) sB[tid] = v; else sC[tid - 128] = v; }
            const float dt = softplusf_(bf2f(PROJ[row * IN_PAD + OFF_DT + h]) + dtb), dA = __expf(dt * a);
            const float x = bf2f(XC[row * CONV_DIM + col]), z = bf2f(PROJ[row * IN_PAD + col]), dx = dt * x;
            __syncthreads();
            float y = 0.f;
#pragma unroll
            for (int n = 0; n < 128; n += 4) { const f32x4 bv = *(const LAS f32x4*)(sB + n), cv = *(const LAS f32x4*)(sC + n);
                st[n] = dA * st[n] + dx * bv[0]; st[n + 1] = dA * st[n + 1] + dx * bv[1]; st[n + 2] = dA * st[n + 2] + dx * bv[2]; st[n + 3] = dA * st[n + 3] + dx * bv[3];
                y += st[n] * cv[0] + st[n + 1] * cv[1] + st[n + 2] * cv[2] + st[n + 3] * cv[3]; }
            y = (y + dsk * x) * siluf_(z);
            const float q = wave_sum(y * y);
            if (p == 0) part[(s & 1) * 8 + e] = q;
            __syncthreads();
            float tot = 0.f;
#pragma unroll
            for (int i = 0; i < 8; ++i) tot += part[(s & 1) * 8 + i];
            YN[row * DM + col] = (bf16)f2bf(y * rsqrtf(tot * (1.f / 512.f) + EPS) * gn);
        }
    }
}
namespace ssd {
typedef float f32x16 __attribute__((ext_vector_type(16)));
constexpr int XT_OFF = 0, BT_OFF = 65536, BN_OFF = 81920, CN_OFF = 99328, SDT_OFF = 116736, SAC_OFF = 118784, SW_OFF = 120832, NP = 272;
__device__ __forceinline__ int xt_addr(int p, int s) { return p * 128 + ((2 * s) ^ (((p >> 1) & 7) << 4)); }
__device__ __forceinline__ int xt_frag(int p, int chunk) { return p * 128 + ((chunk ^ ((p >> 1) & 7)) << 4); }
__device__ __forceinline__ int crow(int r, int hi) { return (r & 3) + 8 * (r >> 2) + 4 * hi; }
}
__device__ __forceinline__ v4u widen_pair(v2u a, v2u b) {
    const auto r0 = __builtin_amdgcn_permlane32_swap(a.x, b.x, false, false); const auto r1 = __builtin_amdgcn_permlane32_swap(a.y, b.y, false, false);
    return (v4u){r0[0], r1[0], r0[1], r1[1]};
}
__device__ __forceinline__ void p5_ssd_c1(Frame& F) {
    using namespace ssd;
    const bf16* PROJ = WSP(bf16, WS_PROJ); const bf16* XC = WSP(bf16, WS_XC); bf16* YDIAG = WSP(bf16, WS_YDIAG); bf16* STATES = WSP(bf16, WS_STATES);
    float* ACUM = WSP(float, WS_ACUM); float* CDEC = WSP(float, WS_CDEC);
    LAS unsigned char* L = F.lds;
    const int lane = F.lane, w = F.wave, r32 = lane & 31, hi = lane >> 5;
    for (int it = (int)blockIdx.x; it < BATCH * NCHUNK * SSD_G; it += F.G) {
        const int g = it & 1, c = (it >> 1) & (NCHUNK - 1), b = it >> 8, h = g * SSD_HPG + w;
        const size_t t0 = (size_t)b * SEQ + (size_t)c * CHUNK;
        __syncthreads();
        { const bf16* xrow = XC + (t0 + lane) * CONV_DIM;
          LAS unsigned char* xb = L + XT_OFF + w * 8192; LAS unsigned char* bb = L + BT_OFF + w * 2048;
          int lx[8];
#pragma unroll
          for (int cc = 0; cc < 8; ++cc) lx[cc] = (2 * lane) ^ (cc << 4);
#pragma unroll
          for (int j = 0; j < 8; ++j) { const int cg = w * 8 + j; const v4u v = *(const v4u*)(xrow + g * 512 + cg * 8); const unsigned e[4] = {v.x, v.y, v.z, v.w};
#pragma unroll
              for (int i = 0; i < 8; ++i) *(LAS unsigned short*)(xb + lx[(4 * j + (i >> 1)) & 7] + (1024 * j + 128 * i)) = (unsigned short)((i & 1) ? (e[i >> 1] >> 16) : (e[i >> 1] & 0xffffu)); }
#pragma unroll
          for (int j = 0; j < 2; ++j) { const int cg = w * 2 + j; const v4u vb = *(const v4u*)(xrow + 1024 + g * 128 + cg * 8), vc = *(const v4u*)(xrow + 1280 + g * 128 + cg * 8);
              *(LAS v4u*)(L + BN_OFF + lane * NP + cg * 16) = vb; *(LAS v4u*)(L + CN_OFF + lane * NP + cg * 16) = vc; const unsigned e[4] = {vb.x, vb.y, vb.z, vb.w};
#pragma unroll
              for (int i = 0; i < 8; ++i) *(LAS unsigned short*)(bb + lx[(4 * j + (i >> 1)) & 7] + (1024 * j + 128 * i)) = (unsigned short)((i & 1) ? (e[i >> 1] >> 16) : (e[i >> 1] & 0xffffu)); } }
        { const float a = -__expf(F.in[I_ALOG][h]);
          const float dtv = softplusf_(bf2f(PROJ[(t0 + lane) * IN_PAD + OFF_DT + h]) + F.in[I_DTB][h]);
          float ac = dtv * a;
#pragma unroll
          for (int o = 1; o < 64; o <<= 1) { const float nb = __shfl_up(ac, o); if (lane >= o) ac += nb; }
          const float alast = __shfl(ac, 63);
          ((LAS float*)(L + SDT_OFF))[w * 64 + lane] = dtv; ((LAS float*)(L + SAC_OFF))[w * 64 + lane] = ac; ((LAS float*)(L + SW_OFF))[w * 64 + lane] = __expf(alast - ac) * dtv;
          ACUM[(t0 + lane) * SSD_H + h] = ac; if (lane == 63) CDEC[((size_t)b * NCHUNK + c) * SSD_H + h] = __expf(ac); }
        __syncthreads();
        f32x4 cacc[2];
#pragma unroll
        for (int j = 0; j < 2; ++j) { const int q = 2 * w + j, bi = q >> 2, bj = q & 3; cacc[j] = (f32x4){0.f, 0.f, 0.f, 0.f};
#pragma unroll
            for (int ks = 0; ks < 4; ++ks) { const bf16x8 af = *(const LAS bf16x8*)(L + CN_OFF + (16 * bi + (lane & 15)) * NP + (32 * ks + 8 * (lane >> 4)) * 2);
                const bf16x8 bfg = *(const LAS bf16x8*)(L + BN_OFF + (16 * bj + (lane & 15)) * NP + (32 * ks + 8 * (lane >> 4)) * 2);
                cacc[j] = __builtin_amdgcn_mfma_f32_16x16x32_bf16(af, bfg, cacc[j], 0, 0, 0); } }
        __syncthreads();
#pragma unroll
        for (int j = 0; j < 2; ++j) { const int q = 2 * w + j, bi = q >> 2, bj = q & 3;
#pragma unroll
            for (int r = 0; r < 4; ++r) *(LAS float*)(L + CN_OFF + (16 * bi + 4 * (lane >> 4) + r) * NP + (16 * bj + (lane & 15)) * 4) = cacc[j][r]; }
        __syncthreads();
        bf16x8 xf[2][4];
#pragma unroll
        for (int pb = 0; pb < 2; ++pb)
#pragma unroll
            for (int ks = 0; ks < 4; ++ks) xf[pb][ks] = *(const LAS bf16x8*)(L + XT_OFF + xt_frag(w * 64 + 32 * pb + r32, 2 * ks + hi));
        const LAS float* sdt = (const LAS float*)(L + SDT_OFF) + w * 64; const LAS float* sac = (const LAS float*)(L + SAC_OFF) + w * 64; const LAS float* sw = (const LAS float*)(L + SW_OFF) + w * 64;
        const float dsk = F.in[I_DSKIP][h];
        f32x16 yacc[2][2];
#pragma unroll
        for (int lb = 0; lb < 2; ++lb)
#pragma unroll
            for (int pb = 0; pb < 2; ++pb) yacc[lb][pb] = f32x16{};
#pragma unroll
        for (int lb = 0; lb < 2; ++lb) { const int l = 32 * lb + r32; const float acl = sac[l];
#pragma unroll
            for (int ks = 0; ks < 4; ++ks) { if (ks >= 2 * lb + 2) continue;
                const int s0 = 16 * ks + 8 * hi;
                const f32x4 c0 = *(const LAS f32x4*)(L + CN_OFF + l * NP + s0 * 4), c1 = *(const LAS f32x4*)(L + CN_OFF + l * NP + s0 * 4 + 16);
                const f32x4 a0 = *(const LAS f32x4*)(sac + s0), a1 = *(const LAS f32x4*)(sac + s0 + 4), d0 = *(const LAS f32x4*)(sdt + s0), d1 = *(const LAS f32x4*)(sdt + s0 + 4);
                float mv[8];
#pragma unroll
                for (int j = 0; j < 8; ++j) { const int s = s0 + j; const float cb = j < 4 ? c0[j & 3] : c1[j & 3], as = j < 4 ? a0[j & 3] : a1[j & 3], ds = j < 4 ? d0[j & 3] : d1[j & 3];
                    float v = (s <= l) ? cb * __expf(acl - as) * ds : 0.f; if (s == l) v += dsk; mv[j] = v; }
                const v4u mw = pack8(mv); const bf16x8 mf = __builtin_bit_cast(bf16x8, mw);
#pragma unroll
                for (int pb = 0; pb < 2; ++pb) yacc[lb][pb] = __builtin_amdgcn_mfma_f32_32x32x16_bf16(xf[pb][ks], mf, yacc[lb][pb], 0, 0, 0); } }
#pragma unroll
        for (int lb = 0; lb < 2; ++lb)
#pragma unroll
            for (int pb = 0; pb < 2; ++pb)
#pragma unroll
                for (int q = 0; q < 4; q += 2) { v2u oa, ob; oa.x = pk2(yacc[lb][pb][4 * q], yacc[lb][pb][4 * q + 1]); oa.y = pk2(yacc[lb][pb][4 * q + 2], yacc[lb][pb][4 * q + 3]);
                    ob.x = pk2(yacc[lb][pb][4 * q + 4], yacc[lb][pb][4 * q + 5]); ob.y = pk2(yacc[lb][pb][4 * q + 6], yacc[lb][pb][4 * q + 7]);
                    *(v4u*)(YDIAG + (t0 + 32 * lb + r32) * DM + h * SSD_P + 32 * pb + 8 * q + 8 * hi) = widen_pair(oa, ob); }
#pragma unroll
        for (int ks = 0; ks < 4; ++ks) { const int s0 = 16 * ks + 8 * hi; const f32x4 w0 = *(const LAS f32x4*)(sw + s0), w1 = *(const LAS f32x4*)(sw + s0 + 4);
#pragma unroll
            for (int pb = 0; pb < 2; ++pb) { float xv[8]; unpack8(__builtin_bit_cast(v4u, xf[pb][ks]), xv);
                xv[0] *= w0[0]; xv[1] *= w0[1]; xv[2] *= w0[2]; xv[3] *= w0[3]; xv[4] *= w1[0]; xv[5] *= w1[1]; xv[6] *= w1[2]; xv[7] *= w1[3];
                xf[pb][ks] = __builtin_bit_cast(bf16x8, pack8(xv)); } }
        bf16* stp = STATES + (((size_t)b * NCHUNK + c) * SSD_H + h) * (SSD_P * SSD_N);
#pragma unroll 1
        for (int nb = 0; nb < 4; ++nb) { bf16x8 bt[4];
#pragma unroll
            for (int ks = 0; ks < 4; ++ks) bt[ks] = *(const LAS bf16x8*)(L + BT_OFF + xt_frag(32 * nb + r32, 2 * ks + hi));
#pragma unroll
            for (int pb = 0; pb < 2; ++pb) { f32x16 sa = f32x16{};
#pragma unroll
                for (int ks = 0; ks < 4; ++ks) sa = __builtin_amdgcn_mfma_f32_32x32x16_bf16(bt[ks], xf[pb][ks], sa, 0, 0, 0);
#pragma unroll
                for (int q = 0; q < 4; q += 2) { v2u oa, ob; oa.x = pk2(sa[4 * q], sa[4 * q + 1]); oa.y = pk2(sa[4 * q + 2], sa[4 * q + 3]); ob.x = pk2(sa[4 * q + 4], sa[4 * q + 5]); ob.y = pk2(sa[4 * q + 6], sa[4 * q + 7]);
                    *(v4u*)(stp + (32 * pb + r32) * SSD_N + 32 * nb + 8 * q + 8 * hi) = widen_pair(oa, ob); } } }
    }
}
__device__ __forceinline__ void p6_ssd_scan(Frame& F) {
    bf16* STATES = WSP(bf16, WS_STATES); const float* CDEC = WSP(float, WS_CDEC);
    constexpr int NEL = BATCH * SSD_H * SSD_P * (SSD_N / 2);
    constexpr size_t CSTR = (size_t)SSD_H * SSD_P * SSD_N / 2;
    constexpr int SB = 16;
    static_assert(NCHUNK % (2 * SB) == 0, "scan batches");
    for (int idx = (int)blockIdx.x * NTHR + F.tid; idx < NEL; idx += F.G * NTHR) {
        const int n2 = idx & 63, p = (idx >> 6) & 63, h = (idx >> 12) & 15, b = idx >> 16;
        unsigned* ptr = (unsigned*)STATES + ((size_t)b * NCHUNK * SSD_H + h) * (SSD_P * SSD_N / 2) + p * (SSD_N / 2) + n2;
        const float* dec = CDEC + (size_t)b * NCHUNK * SSD_H + h;
        float h0 = 0.f, h1 = 0.f;
        unsigned uA[SB], uB[SB]; float dA[SB], dB[SB];
#define SC_LOAD(U, D, c0) do { _Pragma("unroll") for (int i = 0; i < SB; ++i) { U[i] = ptr[(size_t)((c0) + i) * CSTR]; D[i] = dec[((c0) + i) * SSD_H]; } } while (0)
#define SC_PROC(U, D, c0) do { _Pragma("unroll") for (int i = 0; i < SB; ++i) { const unsigned pv = pk2(h0, h1); h0 = D[i] * h0 + blo(U[i]); h1 = D[i] * h1 + bhi(U[i]); ptr[(size_t)((c0) + i) * CSTR] = pv; } } while (0)
        SC_LOAD(uA, dA, 0);
#pragma unroll 1
        for (int c = 0; c < NCHUNK; c += 2 * SB) {
            SC_LOAD(uB, dB, c + SB); asm volatile("" : "+v"(uA[0]) :: "memory");
            SC_PROC(uA, dA, c);
            const int cn = (c + 2 * SB < NCHUNK) ? c + 2 * SB : c + SB;
            SC_LOAD(uA, dA, cn); asm volatile("" : "+v"(uB[0]) :: "memory");
            SC_PROC(uB, dB, c + SB);
        }
#undef SC_LOAD
#undef SC_PROC
    }
}
__device__ __forceinline__ void p7_ssd_c3(Frame& F) {
    using namespace ssd;
    const bf16* PROJ = WSP(bf16, WS_PROJ); const bf16* XC = WSP(bf16, WS_XC); const bf16* YDIAG = WSP(bf16, WS_YDIAG); const bf16* STATES = WSP(bf16, WS_STATES);
    const float* ACUM = WSP(float, WS_ACUM); bf16* YN = WSP(bf16, WS_YN);
    LAS unsigned char* L = F.lds; LAS float* red = (LAS float*)(L + 64 * NP);
    const int tid = F.tid, lane = F.lane, w = F.wave, r32 = lane & 31, hi = lane >> 5;
    for (int it = (int)blockIdx.x; it < BATCH * NCHUNK * SSD_G; it += F.G) {
        const int g = it & 1, c = (it >> 1) & (NCHUNK - 1), b = it >> 8, h = g * SSD_HPG + w;
        const size_t t0 = (size_t)b * SEQ + (size_t)c * CHUNK;
        __syncthreads();
        { const int row = tid >> 3;
#pragma unroll
          for (int j = 0; j < 2; ++j) { const int ch = (tid & 7) * 2 + j; *(LAS v4u*)(L + row * NP + ch * 16) = *(const v4u*)(XC + (t0 + row) * CONV_DIM + 1280 + g * 128 + ch * 8); } }
        __syncthreads();
        const bf16* prev = STATES + (((size_t)b * NCHUNK + c) * SSD_H + h) * (SSD_P * SSD_N);
        bf16x8 bq[2][8];
#pragma unroll
        for (int pb = 0; pb < 2; ++pb)
#pragma unroll
            for (int ks = 0; ks < 8; ++ks) bq[pb][ks] = *(const bf16x8*)(prev + (32 * pb + r32) * SSD_N + 16 * ks + 8 * hi);
        float eac[2]; v2u yd[2][2][4], zz[2][2][4];
#pragma unroll
        for (int lb = 0; lb < 2; ++lb) { const size_t row = t0 + 32 * lb + r32; eac[lb] = ACUM[row * SSD_H + h];
#pragma unroll
            for (int pb = 0; pb < 2; ++pb)
#pragma unroll
                for (int q = 0; q < 4; ++q) { const int col = h * SSD_P + 32 * pb + 8 * q + 4 * hi; yd[lb][pb][q] = *(const v2u*)(YDIAG + row * DM + col); zz[lb][pb][q] = *(const v2u*)(PROJ + row * IN_PAD + col); } }
        f32x16 acc[2][2];
#pragma unroll
        for (int pb = 0; pb < 2; ++pb)
#pragma unroll
            for (int lb = 0; lb < 2; ++lb) acc[pb][lb] = f32x16{};
#pragma unroll
        for (int ks = 0; ks < 8; ++ks) { bf16x8 af[2];
#pragma unroll
            for (int lb = 0; lb < 2; ++lb) af[lb] = *(const LAS bf16x8*)(L + (32 * lb + r32) * NP + (16 * ks + 8 * hi) * 2);
#pragma unroll
            for (int pb = 0; pb < 2; ++pb)
#pragma unroll
                for (int lb = 0; lb < 2; ++lb) acc[pb][lb] = __builtin_amdgcn_mfma_f32_32x32x16_bf16(bq[pb][ks], af[lb], acc[pb][lb], 0, 0, 0); }
#pragma unroll
        for (int lb = 0; lb < 2; ++lb) { const float ea = __expf(eac[lb]); float ss = 0.f;
#pragma unroll
            for (int pb = 0; pb < 2; ++pb)
#pragma unroll
                for (int q = 0; q < 4; ++q) { const float y4[4] = {blo(yd[lb][pb][q].x), bhi(yd[lb][pb][q].x), blo(yd[lb][pb][q].y), bhi(yd[lb][pb][q].y)};
                    const float z4[4] = {blo(zz[lb][pb][q].x), bhi(zz[lb][pb][q].x), blo(zz[lb][pb][q].y), bhi(zz[lb][pb][q].y)};
#pragma unroll
                    for (int i = 0; i < 4; ++i) { const float y = (y4[i] + ea * acc[pb][lb][4 * q + i]) * siluf_(z4[i]); acc[pb][lb][4 * q + i] = y; ss += y * y; } }
            ss += __shfl_xor(ss, 32);
            if (hi == 0) red[w * 64 + 32 * lb + r32] = ss; }
        __syncthreads();
#pragma unroll
        for (int lb = 0; lb < 2; ++lb) { const size_t row = t0 + 32 * lb + r32; float tot = 0.f;
#pragma unroll
            for (int i = 0; i < 8; ++i) tot += red[i * 64 + 32 * lb + r32];
            const float rs = rsqrtf(tot * (1.f / 512.f) + EPS);
#pragma unroll
            for (int pb = 0; pb < 2; ++pb)
#pragma unroll
                for (int q = 0; q < 4; q += 2) { const int col = h * SSD_P + 32 * pb + 8 * q + 4 * hi; const f32x4 ga = *(const f32x4*)(F.in[I_GSSD] + col), gb = *(const f32x4*)(F.in[I_GSSD] + col + 8); v2u oa, ob;
                    oa.x = pk2(acc[pb][lb][4 * q] * rs * ga[0], acc[pb][lb][4 * q + 1] * rs * ga[1]); oa.y = pk2(acc[pb][lb][4 * q + 2] * rs * ga[2], acc[pb][lb][4 * q + 3] * rs * ga[3]);
                    ob.x = pk2(acc[pb][lb][4 * q + 4] * rs * gb[0], acc[pb][lb][4 * q + 5] * rs * gb[1]); ob.y = pk2(acc[pb][lb][4 * q + 6] * rs * gb[2], acc[pb][lb][4 * q + 7] * rs * gb[3]);
                    *(v4u*)(YN + row * DM + h * SSD_P + 32 * pb + 8 * q + 8 * hi) = widen_pair(oa, ob); } }
    }
}
__device__ __forceinline__ int wr_off(int k, int slot) { return (k >> 1) * 64 + (k & 1) * 32 + ((slot ^ ((k >> 1) & 7)) << 2); }
__device__ __forceinline__ void p11_router(Frame& F) {
    LAS float* wr = (LAS float*)(F.lds);
    LAS unsigned* cnt = (LAS unsigned*)(F.lds + LDSCTL_OFF);
    const float* x1 = F.out; unsigned char* H2 = WSP(unsigned char, WS_XN); int* TOPI = WSP(int, WS_TOPI); float* TOPG = WSP(float, WS_TOPG); int* CNT = WSP(int, WS_CNT);
    const int tid = F.tid, lane = F.lane, w = F.wave;
    typedef float f32x2_ __attribute__((ext_vector_type(2)));
    __syncthreads();
    { f32x4 tw[16];
#pragma unroll
      for (int it = 0; it < 16; ++it) tw[it] = *(const f32x4*)(F.in[I_WR] + (size_t)(tid + it * NTHR) * 4);
#pragma unroll
      for (int it = 0; it < 16; ++it) { const int i = tid + it * NTHR, k = i >> 3, sl = i & 7; *(LAS f32x4*)(wr + wr_off(k, sl)) = tw[it]; } }
    const int e = lane & 31, hf = lane >> 5;
    const float bre = F.in[I_BR][e];
    const LAS float* wb[8];
#pragma unroll
    for (int sl = 0; sl < 8; ++sl) wb[sl] = wr + (lane >> 1) * 64 + (lane & 1) * 32 + ((sl ^ ((lane >> 1) & 7)) << 2);
    LAS float* gfl = (LAS float*)(F.lds + LDSCTL_OFF + 4096);
    for (int i = tid; i < DM; i += NTHR) gfl[i] = F.in[I_GFFN][i];
    const LAS float* gfp = gfl + lane;
    for (int vb = (int)blockIdx.x; vb < T / 64; vb += F.G) {
        __syncthreads();
        if (tid < 32) cnt[tid] = 0u;
        __syncthreads();
        float hvA[16], hvB[16];
#pragma unroll
        for (int j = 0; j < 16; ++j) { hvA[j] = x1[(size_t)(vb * 64 + w * 8) * DM + lane + 64 * j]; hvB[j] = x1[(size_t)(vb * 64 + w * 8 + 1) * DM + lane + 64 * j]; }
#pragma unroll 1
        for (int tp = 0; tp < 4; ++tp) {
            const int tkA = vb * 64 + w * 8 + 2 * tp;
            float ssA = 0.f, ssB = 0.f;
#pragma unroll
            for (int j = 0; j < 16; ++j) { ssA += hvA[j] * hvA[j]; ssB += hvB[j] * hvB[j]; }
            const float* xn = x1 + (size_t)(tkA + (tp < 3 ? 2 : 0)) * DM;
            float rA, rB;
            { float s2 = (hf ? ssB : ssA) + __shfl_xor(hf ? ssA : ssB, 32);
#pragma unroll
              for (int o = 1; o < 32; o <<= 1) s2 += __shfl_xor(s2, o);
              const float r = rsqrtf(s2 * (1.f / DM) + EPS); rA = __shfl(r, 0); rB = __shfl(r, 32); }
            f32x2_ lgA[16], lgB[16];
#pragma unroll
            for (int i = 0; i < 16; ++i) { lgA[i] = (f32x2_){0.f, 0.f}; lgB[i] = (f32x2_){0.f, 0.f}; }
#pragma unroll
            for (int j = 0; j < 16; ++j) { const float gj = gfp[64 * j]; const float ha = hvA[j] * rA * gj, hb = hvB[j] * rB * gj;
                H2[(size_t)tkA * DM + lane + 64 * j] = (unsigned char)(__builtin_amdgcn_cvt_pk_fp8_f32(fminf(fmaxf(ha * H2_SCALE, -448.f), 448.f), 0.f, 0, false) & 0xff);
                H2[(size_t)(tkA + 1) * DM + lane + 64 * j] = (unsigned char)(__builtin_amdgcn_cvt_pk_fp8_f32(fminf(fmaxf(hb * H2_SCALE, -448.f), 448.f), 0.f, 0, false) & 0xff);
                hvA[j] = xn[lane + 64 * j]; hvB[j] = xn[DM + lane + 64 * j];
                const f32x2_ ha2 = (f32x2_){ha, ha}, hb2 = (f32x2_){hb, hb};
#pragma unroll
                for (int sl = 0; sl < 8; ++sl) { const f32x4 wv = *(const LAS f32x4*)(wb[sl] + j * 2048);
                    const f32x2_ w01 = (f32x2_){wv[0], wv[1]}, w23 = (f32x2_){wv[2], wv[3]};
                    lgA[2 * sl] = ha2 * w01 + lgA[2 * sl]; lgA[2 * sl + 1] = ha2 * w23 + lgA[2 * sl + 1];
                    lgB[2 * sl] = hb2 * w01 + lgB[2 * sl]; lgB[2 * sl + 1] = hb2 * w23 + lgB[2 * sl + 1]; }
                if (j & 1) __builtin_amdgcn_sched_barrier(0); }
            float lg[32];
#pragma unroll
            for (int i = 0; i < 32; ++i) { const float a = (i & 1) ? lgA[i >> 1].y : lgA[i >> 1].x, b = (i & 1) ? lgB[i >> 1].y : lgB[i >> 1].x; lg[i] = (hf ? b : a) + __shfl_xor(hf ? a : b, 32); }
#define RED_STEP(NV, MSK) { const bool up = (lane & (MSK)) != 0; _Pragma("unroll") for (int i = 0; i < (NV) / 2; ++i) { const float snd = up ? lg[i] : lg[i + (NV) / 2]; const float kp = up ? lg[i + (NV) / 2] : lg[i]; lg[i] = kp + __shfl_xor(snd, (MSK)); } }
            RED_STEP(32, 16) RED_STEP(16, 8) RED_STEP(8, 4) RED_STEP(4, 2) RED_STEP(2, 1)
#undef RED_STEP
            const float v = lg[0] + bre;
            float tv[4]; int tix[4];
            { const unsigned vb_ = __float_as_uint(v); float key = __uint_as_float((vb_ & ~31u) | (unsigned)((vb_ >> 31) ? e : 31 - e));
#pragma unroll
              for (int k = 0; k < 4; ++k) { float mx = key;
#pragma unroll
                  for (int o = 1; o < 32; o <<= 1) mx = fmaxf(mx, __shfl_xor(mx, o));
                  const unsigned mb = __float_as_uint(mx); const int es = (mb >> 31) ? (int)(mb & 31u) : 31 - (int)(mb & 31u);
                  tv[k] = mx; tix[k] = es; if (e == es) key = -INFINITY; } }
            const float e1 = __expf(tv[1] - tv[0]), e2 = __expf(tv[2] - tv[0]), e3 = __expf(tv[3] - tv[0]), inv = 1.0f / (1.0f + e1 + e2 + e3);
            if (e == 0) { const int tk = tkA + hf; *(int4*)(TOPI + (size_t)tk * 4) = make_int4(tix[0], tix[1], tix[2], tix[3]); *(f32x4*)(TOPG + (size_t)tk * 4) = (f32x4){inv, e1 * inv, e2 * inv, e3 * inv};
                __hip_atomic_fetch_add(&cnt[tix[0]], 1u, __ATOMIC_RELAXED, __HIP_MEMORY_SCOPE_WORKGROUP); __hip_atomic_fetch_add(&cnt[tix[1]], 1u, __ATOMIC_RELAXED, __HIP_MEMORY_SCOPE_WORKGROUP); __hip_atomic_fetch_add(&cnt[tix[2]], 1u, __ATOMIC_RELAXED, __HIP_MEMORY_SCOPE_WORKGROUP); __hip_atomic_fetch_add(&cnt[tix[3]], 1u, __ATOMIC_RELAXED, __HIP_MEMORY_SCOPE_WORKGROUP); }
        }
        __syncthreads();
        if (tid < 32) CNT[vb * 32 + tid] = (int)cnt[tid];
    }
}

__device__ __forceinline__ void p12_slots(Frame& F) {
    LAS int* tot = (LAS int*)(F.lds); LAS int* pre = tot + 32; LAS int* start = pre + 32; LAS int* cur = start + 32; LAS int* nmt_s = cur + 32; LAS int* psum = nmt_s + 32; LAS int* ppre = psum + 512;
    const int* CNT = WSP(int, WS_CNT); const int* TOPI = WSP(int, WS_TOPI); int* SLOT = WSP(int, WS_SLOT); int* ROWTOK = WSP(int, WS_ROWTOK); int* MTE = WSP(int, WS_MTE);
    const int tid = F.tid, lane = F.lane;
    for (int vb = (int)blockIdx.x; vb < T / 64; vb += F.G) {
        __syncthreads();
        const int4 ti = *(const int4*)(TOPI + (size_t)(vb * 64 + lane) * 4);
        { const int e = tid & 31, part = tid >> 5; int a = 0, p = 0;
#pragma unroll
          for (int i = 0; i < 16; ++i) { const int c = CNT[(part * 16 + i) * 32 + e]; if (part * 16 + i < vb) p += c; a += c; }
          psum[part * 32 + e] = a; ppre[part * 32 + e] = p; }
        __syncthreads();
        if (tid < 64) { const int e = lane & 31; int a = 0, p = 0;
#pragma unroll
            for (int i = 0; i < 16; ++i) { a += psum[i * 32 + e]; p += ppre[i * 32 + e]; }
            const int pd = ((a + 255) >> 8) << 8; int incl = pd;
#pragma unroll
            for (int o = 1; o < 32; o <<= 1) { const int nb = __shfl_up(incl, o); if ((lane & 31) >= o) incl += nb; }
            if (lane < 32) { tot[e] = a; start[e] = incl - pd; cur[e] = incl - pd + p; if (e == 31) nmt_s[0] = incl >> 8; } }
        __syncthreads();
        if (tid < 64) {
            const int tk = vb * 64 + lane; int ex[4] = {ti.x, ti.y, ti.z, ti.w}; int sl[4] = {0, 0, 0, 0};
#pragma unroll 4
            for (int ee = 0; ee < 32; ++ee) {
                const bool mine = (ex[0] == ee) | (ex[1] == ee) | (ex[2] == ee) | (ex[3] == ee);
                const unsigned long long mk = __ballot(mine);
                const int below = (int)__builtin_amdgcn_mbcnt_hi((unsigned)(mk >> 32), __builtin_amdgcn_mbcnt_lo((unsigned)mk, 0u));
                const int base = cur[ee] + below;
#pragma unroll
                for (int k = 0; k < 4; ++k) if (ex[k] == ee) sl[k] = base;
            }
            *(int4*)(SLOT + (size_t)tk * 4) = make_int4(sl[0], sl[1], sl[2], sl[3]);
#pragma unroll
            for (int k = 0; k < 4; ++k) ROWTOK[sl[k]] = tk;
        }
        if (vb < 32) {
            const int e = vb, n = tot[e], pd = ((n + 255) >> 8) << 8; for (int i = n + tid; i < pd; i += NTHR) ROWTOK[start[e] + i] = 0;
            for (int i = tid; i < (pd >> 8); i += NTHR) MTE[(start[e] >> 8) + i] = e;
            if (vb == 0 && tid == 0) MTE[MT_MAX] = nmt_s[0];
        }
    }
}

__device__ __forceinline__ void p13_gateup_naive(Frame& F) {
    LAS bf16* hs = (LAS bf16*)(F.lds);
    const bf16* H2 = WSP(bf16, WS_XN); const int* ROWTOK = WSP(int, WS_ROWTOK); const int* MTE = WSP(int, WS_MTE); bf16* ACT = WSP(bf16, WS_ACT);
    const int tid = F.tid, nmt = MTE[MT_MAX];
    for (int it = (int)blockIdx.x; it < nmt * 16; it += F.G) {
        const int mt = it >> 4, s0 = it * 16, e = MTE[mt];
        __syncthreads();
        for (int i = tid; i < 16 * 128; i += NTHR) { const int r = i >> 7, c = (i & 127) * 8; *(LAS v4u*)(hs + r * 1024 + c) = *(const v4u*)(H2 + (size_t)ROWTOK[s0 + r] * DM + c); }
        __syncthreads();
        const bf16* We = WSP(bf16, WS_WGU) + (size_t)e * 2 * FF * DM;
#pragma unroll 1
        for (int jj = 0; jj < 2; ++jj) {
            const int j = tid + 512 * jj, rowg = (j >> 7) * 256 + (j & 127), rowl = rowg + 128;
            float ag[16], al[16];
#pragma unroll
            for (int s = 0; s < 16; ++s) { ag[s] = 0.f; al[s] = 0.f; }
#pragma unroll 1
            for (int k = 0; k < DM; k += 8) { float wg[8], wl[8]; unpack8(*(const v4u*)(We + (size_t)rowg * DM + k), wg); unpack8(*(const v4u*)(We + (size_t)rowl * DM + k), wl);
#pragma unroll
                for (int s = 0; s < 16; ++s) { float hv[8]; unpack8(*(const LAS v4u*)(hs + s * 1024 + k), hv);
#pragma unroll
                    for (int q = 0; q < 8; ++q) { ag[s] += hv[q] * wg[q]; al[s] += hv[q] * wl[q]; } } }
            const float bg = F.in[I_BGU][(size_t)e * 2 * FF + j], bl = F.in[I_BGU][(size_t)e * 2 * FF + FF + j];
#pragma unroll
            for (int s = 0; s < 16; ++s) { const float glu = fminf(ag[s] + bg, 7.0f), lin = fminf(fmaxf(al[s] + bl, -7.0f), 7.0f);
                ACT[(size_t)(s0 + s) * FF + j] = (bf16)f2bf(glu * (1.0f / (1.0f + __expf(-1.702f * glu))) * (lin + 1.0f)); }
        }
    }
}
__device__ __forceinline__ void p14_down_naive(Frame& F) {
    LAS bf16* as = (LAS bf16*)(F.lds);
    const int* MTE = WSP(int, WS_MTE); const bf16* ACT = WSP(bf16, WS_ACT); bf16* YS = WSP(bf16, WS_YS);
    const int tid = F.tid, nmt = MTE[MT_MAX];
    for (int it = (int)blockIdx.x; it < nmt * 16; it += F.G) {
        const int mt = it >> 4, s0 = it * 16, e = MTE[mt];
        __syncthreads();
        for (int i = tid; i < 16 * 128; i += NTHR) { const int r = i >> 7, c = (i & 127) * 8; *(LAS v4u*)(as + r * 1024 + c) = *(const v4u*)(ACT + (size_t)(s0 + r) * FF + c); }
        __syncthreads();
        const bf16* We = WSP(bf16, WS_WDN) + (size_t)e * DM * FF;
#pragma unroll 1
        for (int jj = 0; jj < 2; ++jj) {
            const int j = tid + 512 * jj;
            float a[16];
#pragma unroll
            for (int s = 0; s < 16; ++s) a[s] = 0.f;
#pragma unroll 1
            for (int k = 0; k < FF; k += 8) { float wv[8]; unpack8(*(const v4u*)(We + (size_t)j * FF + k), wv);
#pragma unroll
                for (int s = 0; s < 16; ++s) { float hv[8]; unpack8(*(const LAS v4u*)(as + s * 1024 + k), hv);
#pragma unroll
                    for (int q = 0; q < 8; ++q) a[s] += hv[q] * wv[q]; } }
            const float bd = F.in[I_BDN][(size_t)e * DM + j];
#pragma unroll
            for (int s = 0; s < 16; ++s) YS[(size_t)(s0 + s) * DM + j] = (bf16)f2bf(a[s] + bd);
        }
    }
}
__device__ __forceinline__ void p15_combine(Frame& F) {
    const bf16* YS = WSP(bf16, WS_YS); const int* SLOT = WSP(int, WS_SLOT); const float* TOPG = WSP(float, WS_TOPG);
    const int gw = F.vcu * NWAVES + F.wave, NGW = F.G * NWAVES, lane = F.lane;
    for (int tk = gw; tk < T; tk += NGW) {
        const int4 sl = *(const int4*)(SLOT + (size_t)tk * 4); const f32x4 g = *(const f32x4*)(TOPG + (size_t)tk * 4);
        const int s4[4] = {sl.x, sl.y, sl.z, sl.w}; const float g4[4] = {g[0], g[1], g[2], g[3]};
        float* orow = F.out + (size_t)tk * DM;
#pragma unroll
        for (int j = 0; j < 4; ++j) { f32x4 o = *(const f32x4*)(orow + 4 * lane + 256 * j);
#pragma unroll
            for (int k = 0; k < 4; ++k) { const v2u y = *(const v2u*)(YS + (size_t)s4[k] * DM + 4 * lane + 256 * j);
                o[0] += g4[k] * blo(y.x); o[1] += g4[k] * bhi(y.x); o[2] += g4[k] * blo(y.y); o[3] += g4[k] * bhi(y.y); }
            *(f32x4*)(orow + 4 * lane + 256 * j) = o; }
    }
}
namespace pg8 {
__device__ __forceinline__ float xsum4(float v) { v += __shfl_xor(v, 16); v += __shfl_xor(v, 32); return v; }
struct EpiQUp {
    static constexpr bool PERM = true, AFTER_DRAIN = false;
    const float* gq; unsigned char* ws;
    __device__ __forceinline__ void operator()(const f32x4 (&acc)[2][2][4][2], const Unit& u, int wr, int wc, int fr, int fq) const {
        asm volatile("" : "+v"(fr), "+v"(fq));
        const int row0 = u.pm * BM + wr * 64 + fr; const float* RT = (const float*)(ws + WS_ROPE); bf16_t* Q = (bf16_t*)(ws + WS_Q); float* SSQ = (float*)(ws + WS_SSQ);
#pragma unroll
        for (int bj = 0; bj < 2; ++bj) {
            const int colg = u.pn * BM + bj * HALF + wc * 32, h = colg / 192, d0 = colg % 192, g32 = colg >> 5;
            const bool rope = d0 >= 128; const int i4 = rope ? ((d0 - 128) >> 3) + fq : 0;
            const float* gp = gq + (rope ? 128 + 4 * i4 : d0 + 8 * fq); const f32x4 g0 = *(const f32x4*)gp, g1 = *(const f32x4*)(gp + (rope ? 32 : 4));
            f32x4 cs[8], sn[8];
            if (rope) {
#pragma unroll
                for (int q = 0; q < 8; ++q) { const int s = (row0 + (q >> 2) * HALF + (q & 3) * 16) & (8192 - 1); cs[q] = *(const f32x4*)(RT + s * 64 + 4 * i4); sn[q] = *(const f32x4*)(RT + s * 64 + 32 + 4 * i4); } }
#pragma unroll
            for (int q = 0; q < 8; ++q) { const int ai = q >> 2, m = q & 3, row = row0 + ai * HALF + m * 16, b = row >> 13, s = row & (8192 - 1);
                const f32x4 v0 = acc[ai][bj][m][0], v1 = acc[ai][bj][m][1];
                const float ss = xsum4(((v0[0] * v0[0] + v0[1] * v0[1]) + (v0[2] * v0[2] + v0[3] * v0[3])) + ((v1[0] * v1[0] + v1[1] * v1[1]) + (v1[2] * v1[2] + v1[3] * v1[3])));
                if (fq == 0) SSQ[(size_t)row * 48 + g32] = ss;
                bf16_t* qrow = Q + ((size_t)(b * 8 + h) * 8192 + s) * 192;
                const f32x4 x1 = v0 * g0, x2 = v1 * g1;
                if (!rope) { u32x4 w; w.x = cvt_pk_bf16(x1[0], x1[1]); w.y = cvt_pk_bf16(x1[2], x1[3]); w.z = cvt_pk_bf16(x2[0], x2[1]); w.w = cvt_pk_bf16(x2[2], x2[3]); *(u32x4*)(qrow + d0 + 8 * fq) = w; }
                else { const f32x4 o1 = x1 * cs[q] - x2 * sn[q], o2 = x2 * cs[q] + x1 * sn[q]; typedef unsigned u32x2_ __attribute__((ext_vector_type(2)));
                    *(u32x2_*)(qrow + 128 + 4 * i4) = (u32x2_){cvt_pk_bf16(o1[0], o1[1]), cvt_pk_bf16(o1[2], o1[3])}; *(u32x2_*)(qrow + 160 + 4 * i4) = (u32x2_){cvt_pk_bf16(o2[0], o2[1]), cvt_pk_bf16(o2[2], o2[3])}; } }
        }
    }
};
struct EpiKVUp {
    static constexpr bool PERM = true, AFTER_DRAIN = false;
    const float* gk; unsigned char* ws; PG8_LAS float* lds;
    __device__ __forceinline__ void operator()(const f32x4 (&acc)[2][2][4][2], const Unit& u, int wr, int wc, int fr, int fq) const {
        asm volatile("" : "+v"(fr), "+v"(fq));
        PG8_LAS float* part = lds; PG8_LAS float* rkvl = lds + 1024; PG8_LAS float* sskl = lds + 1280;
        const float* RT = (const float*)(ws + WS_ROPE); const bf16_t* KVL = (const bf16_t*)(ws + WS_KVLAT); const bf16_t* KR = (const bf16_t*)(ws + WS_PROJ) + OFF_KROPE; constexpr int ldkr = IN_PAD;
        bf16_t* K = (bf16_t*)(ws + WS_K); bf16_t* V = (bf16_t*)(ws + WS_V);
        const int h = u.pn, rl0 = wr * 64 + fr;
#pragma unroll
        for (int aj = 0; aj < 2; ++aj) { const int rl = rl0 + aj * HALF + wc * 16, row = u.pm * BM + rl;
            const u32x4* lp = (const u32x4*)(KVL + (size_t)row * 256 + 64 * fq); u32x4 lw[8];
#pragma unroll
            for (int j = 0; j < 8; ++j) lw[j] = lp[j];
            const u32x4 k1 = *(const u32x4*)(KR + (size_t)row * ldkr + 8 * fq), k2 = *(const u32x4*)(KR + (size_t)row * ldkr + 32 + 8 * fq);
            float ss = 0.f;
#pragma unroll
            for (int j = 0; j < 8; ++j) { const unsigned ww[4] = {lw[j].x, lw[j].y, lw[j].z, lw[j].w};
#pragma unroll
                for (int e = 0; e < 4; ++e) { const float a = bf_lo(ww[e]), b2 = bf_hi(ww[e]); ss += a * a + b2 * b2; } }
            ss = xsum4(ss);
            float sk = 0.f; { const unsigned ww[8] = {k1.x, k1.y, k1.z, k1.w, k2.x, k2.y, k2.z, k2.w};
#pragma unroll
                for (int e = 0; e < 8; ++e) { const float a = bf_lo(ww[e]), b2 = bf_hi(ww[e]); sk += a * a + b2 * b2; } }
            sk = xsum4(sk);
            if (fq == 0) { rkvl[rl] = rsqrtf(ss * (1.f / 256.f) + 1e-6f); sskl[rl] = sk; }
            asm volatile("" ::: "memory"); }
#pragma unroll
        for (int q = 0; q < 8; ++q) { const int ai = q >> 2, m = q & 3; const f32x4 v0 = acc[ai][0][m][0], v1 = acc[ai][0][m][1];
            const float ss = xsum4(((v0[0] * v0[0] + v0[1] * v0[1]) + (v0[2] * v0[2] + v0[3] * v0[3])) + ((v1[0] * v1[0] + v1[1] * v1[1]) + (v1[2] * v1[2] + v1[3] * v1[3])));
            if (fq == 0) part[(rl0 + ai * HALF + m * 16) * 4 + wc] = ss; }
        const float* gp = gk + wc * 32 + 8 * fq; const f32x4 g0 = *(const f32x4*)gp, g1 = *(const f32x4*)(gp + 4);
        const f32x4 gr1a = *(const f32x4*)(gk + 128 + 8 * fq), gr1b = *(const f32x4*)(gk + 128 + 8 * fq + 4), gr2a = *(const f32x4*)(gk + 160 + 8 * fq), gr2b = *(const f32x4*)(gk + 160 + 8 * fq + 4);
        asm volatile("s_waitcnt lgkmcnt(0)" ::: "memory"); __builtin_amdgcn_s_barrier(); asm volatile("" ::: "memory");
        u32x4 kr1[2], kr2[2]; f32x4 c1[2], c2[2], s1[2], s2[2];
#pragma unroll
        for (int aj = 0; aj < 2; ++aj) { const int row = u.pm * BM + rl0 + aj * HALF + wc * 16, s = row & (8192 - 1);
            kr1[aj] = *(const u32x4*)(KR + (size_t)row * ldkr + 8 * fq); kr2[aj] = *(const u32x4*)(KR + (size_t)row * ldkr + 32 + 8 * fq);
            c1[aj] = *(const f32x4*)(RT + s * 64 + 8 * fq); c2[aj] = *(const f32x4*)(RT + s * 64 + 8 * fq + 4); s1[aj] = *(const f32x4*)(RT + s * 64 + 32 + 8 * fq); s2[aj] = *(const f32x4*)(RT + s * 64 + 32 + 8 * fq + 4); }
#pragma unroll
        for (int q = 0; q < 8; ++q) { const int ai = q >> 2, m = q & 3, rl = rl0 + ai * HALF + m * 16, row = u.pm * BM + rl, b = row >> 13, s = row & (8192 - 1);
            const f32x4 pp = *(const PG8_LAS f32x4*)(part + rl * 4); const float rkv = rkvl[rl], sk = sskl[rl];
            const float rs = rsqrtf((rkv * rkv * ((pp[0] + pp[1]) + (pp[2] + pp[3])) + sk) * (1.f / 192.f) + 1e-6f), kn = rkv * rs;
            const size_t tb = (size_t)(b * 8 + h) * 8192 + s;
            { const f32x4 x0 = acc[ai][0][m][0] * g0 * kn, x1 = acc[ai][0][m][1] * g1 * kn; u32x4 w; w.x = cvt_pk_bf16(x0[0], x0[1]); w.y = cvt_pk_bf16(x0[2], x0[3]); w.z = cvt_pk_bf16(x1[0], x1[1]); w.w = cvt_pk_bf16(x1[2], x1[3]);
              *(u32x4*)(K + tb * 192 + wc * 32 + 8 * fq) = w; }
            { const f32x4 x0 = acc[ai][1][m][0] * rkv, x1 = acc[ai][1][m][1] * rkv; u32x4 w; w.x = cvt_pk_bf16(x0[0], x0[1]); w.y = cvt_pk_bf16(x0[2], x0[3]); w.z = cvt_pk_bf16(x1[0], x1[1]); w.w = cvt_pk_bf16(x1[2], x1[3]);
              *(u32x4*)(V + tb * 128 + wc * 32 + 8 * fq) = w; } }
#pragma unroll
        for (int aj = 0; aj < 2; ++aj) { const int rl = rl0 + aj * HALF + wc * 16, row = u.pm * BM + rl, b = row >> 13, s = row & (8192 - 1);
            const f32x4 pp = *(const PG8_LAS f32x4*)(part + rl * 4); const float rkv = rkvl[rl], sk = sskl[rl];
            const float rs = rsqrtf((rkv * rkv * ((pp[0] + pp[1]) + (pp[2] + pp[3])) + sk) * (1.f / 192.f) + 1e-6f);
            const f32x4 a1 = (f32x4){bf_lo(kr1[aj].x), bf_hi(kr1[aj].x), bf_lo(kr1[aj].y), bf_hi(kr1[aj].y)} * gr1a * rs, b1 = (f32x4){bf_lo(kr1[aj].z), bf_hi(kr1[aj].z), bf_lo(kr1[aj].w), bf_hi(kr1[aj].w)} * gr1b * rs;
            const f32x4 a2 = (f32x4){bf_lo(kr2[aj].x), bf_hi(kr2[aj].x), bf_lo(kr2[aj].y), bf_hi(kr2[aj].y)} * gr2a * rs, b2 = (f32x4){bf_lo(kr2[aj].z), bf_hi(kr2[aj].z), bf_lo(kr2[aj].w), bf_hi(kr2[aj].w)} * gr2b * rs;
            const f32x4 oa1 = a1 * c1[aj] - a2 * s1[aj], ob1 = b1 * c2[aj] - b2 * s2[aj], oa2 = a2 * c1[aj] + a1 * s1[aj], ob2 = b2 * c2[aj] + b1 * s2[aj];
            bf16_t* kp = K + ((size_t)(b * 8 + h) * 8192 + s) * 192;
            u32x4 w; w.x = cvt_pk_bf16(oa1[0], oa1[1]); w.y = cvt_pk_bf16(oa1[2], oa1[3]); w.z = cvt_pk_bf16(ob1[0], ob1[1]); w.w = cvt_pk_bf16(ob1[2], ob1[3]); *(u32x4*)(kp + 128 + 8 * fq) = w;
            w.x = cvt_pk_bf16(oa2[0], oa2[1]); w.y = cvt_pk_bf16(oa2[2], oa2[3]); w.z = cvt_pk_bf16(ob2[0], ob2[1]); w.w = cvt_pk_bf16(ob2[2], ob2[3]); *(u32x4*)(kp + 160 + 8 * fq) = w; }
    }
};
}
struct Args { const float* in[25]; float* out; unsigned char* ws; int ph_lo, ph_hi; };
constexpr int NPHASE = 16;
__global__ void __launch_bounds__(NTHR, 2) mega_fwd(Args args) {
    extern __shared__ __attribute__((aligned(16))) unsigned char lds[];
    Frame F;
    F.lds = (LAS unsigned char*)lds;
    F.MISC = (volatile LAS unsigned*)(F.lds + MISC_OFF);
    F.tid = threadIdx.x; F.lane = F.tid & 63; F.wave = __builtin_amdgcn_readfirstlane(F.tid >> 6);
    F.G = gridDim.x; { const int bx = blockIdx.x; F.vcu = (F.G % 8 == 0) ? (bx % 8) * (F.G / 8) + bx / 8 : bx; }
#pragma unroll
    for (int i = 0; i < 25; ++i) F.in[i] = args.in[i];
    F.out = args.out; F.ws = args.ws;
    F.ctl = (gu32*)(F.ws + WS_CTL);
    for (int u = F.tid; u < (LDS_BYTES - LDSCTL_OFF) / 4; u += NTHR) ((LAS unsigned*)(F.lds + LDSCTL_OFF))[u] = 0u;
    __syncthreads();
    const int lo = args.ph_lo, hi = args.ph_hi;
    const bool multi = (hi - lo) > 1;
    XcdBarrier bar; bar.bar = (unsigned*)(F.ctl + CW_BAR); bar.x = 0; bar.st = nullptr;
    if (multi) bar = xcd_barrier_post((unsigned*)(F.ctl + CW_BAR), F.MISC + 8);
#ifndef PH_MASK
#define PH_MASK 0xFFFFFF
#endif
#define IN(k) (((PH_MASK >> (k)) & 1) && lo <= (k) && (k) < hi)
#define SEAM(k) do { if (IN(k) && IN((k) + 1)) xcd_barrier(bar); } while (0)
    using namespace pg8;
    bf16* PROJ = WSP(bf16, WS_PROJ);
    if (IN(0)) { p0_prologue(F); } SEAM(0);
    if (IN(1)) { Gemm g{WSP(bf16, WS_XN), WSP(bf16, WS_WIN), T, IN_PAD, DM, DM}; StaticOrder S; S.init(T, IN_PAD, F.G, (int)blockIdx.x);
        EpiPerm8<FStoreProj> E{{PROJ, IN_PAD, WSP(bf16, WS_QLAT), WSP(bf16, WS_KVLAT)}}; gemm_phase<EpiPerm8<FStoreProj>, StaticOrder, true, true>(F.lds + RING_OFF, g, S, E);
        p0_deferred(F, ((T / 256) * (IN_PAD / 256)) % F.G); } SEAM(1);
    if (IN(2)) {
        { Gemm g{WSP(bf16, WS_QLAT), WSP(bf16, WS_WQ), T, MLA_H * QKD, QRANK, QRANK}; StaticOrder S; S.init(T, MLA_H * QKD, F.G, (int)blockIdx.x);
          EpiQUp E{F.in[I_GQKQ], F.ws}; gemm_phase<EpiQUp, StaticOrder, true, true>(F.lds + RING_OFF, g, S, E); }
        { Gemm g{WSP(bf16, WS_KVLAT), WSP(bf16, WS_WKV), T, MLA_H * 256, KVRANK, KVRANK}; StaticOrder S; S.init(T, MLA_H * 256, F.G, (int)blockIdx.x);
          EpiKVUp E{F.in[I_GQKK], F.ws, (LAS float*)(F.lds + LDSCTL_OFF + 1024)};
          gemm_phase<EpiKVUp, StaticOrder, true, true>(F.lds + RING_OFF, g, S, E); }
        p2_rq(F);
        p5a_conv(F); } SEAM(2);
    if (IN(4)) { p5_ssd_c1(F); } SEAM(4);
    if (IN(5)) { p4_attn_dma(F); }
    if (IN(6)) { p6_ssd_scan(F); } SEAM(6);
    if (IN(7)) { p7_ssd_c3(F); } SEAM(7);
    if (IN(8)) { Gemm g{WSP(bf16, WS_YN), WSP(bf16, WS_WSSD), T, DM, DM, DM}; StaticOrder S; S.init(T, DM, F.G, (int)blockIdx.x);
        EpiPipe8<GGate1> E{{PROJ + OFF_GATE, IN_PAD, WSP(bf16, WS_MRG), DM}}; gemm_phase<EpiPipe8<GGate1>, StaticOrder, true, true>(F.lds + RING_OFF, g, S, E); }
    if (IN(9)) { Gemm g{WSP(bf16, WS_OATT), WSP(bf16, WS_WMLA), T, DM, DM, DM}; StaticOrder S; S.init(T, DM, F.G, (int)blockIdx.x);
        EpiPipe8<GGate2> E{{PROJ + OFF_GATE + DM, IN_PAD, WSP(bf16, WS_MRG), DM}}; gemm_phase<EpiPipe8<GGate2>, StaticOrder, true, true>(F.lds + RING_OFF, g, S, E); } SEAM(9);
    if (IN(10)) { Gemm g{WSP(bf16, WS_MRG), WSP(bf16, WS_WO), T, DM, DM, DM}; StaticOrder S; S.init(T, DM, F.G, (int)blockIdx.x);
        EpiPipe8<GResF32> E{{F.in[I_X], F.out, DM}}; gemm_phase<EpiPipe8<GResF32>, StaticOrder, true, true>(F.lds + RING_OFF, g, S, E); } SEAM(10);
    if (IN(11)) { p11_router(F); } SEAM(11);
    if (IN(12)) { p12_slots(F); } SEAM(12);
    if (IN(13)) { const int* MTE = WSP(int, WS_MTE); const int nmt = MTE[MT_MAX]; Gemm g{WSP(bf16, WS_XN), WSP(bf16, WS_WGU), nmt * 256, 2 * FF, DM / 2, DM / 2, 0x7b7b7b7b, 0x76767676};
        MoeOrder S; S.init(nmt, 2 * FF, F.G, (int)blockIdx.x, WSP(int, WS_ROWTOK), MTE, (size_t)2 * FF * DM);
        EpiGateUp E{F.in[I_BGU], MTE, WSP(unsigned char, WS_ACT)}; gemm_phase<EpiGateUp, MoeOrder, true, true, true>(F.lds + RING_OFF, g, S, E); } SEAM(13);
    if (IN(14)) { const int* MTE = WSP(int, WS_MTE); const int nmt = MTE[MT_MAX]; Gemm g{WSP(bf16, WS_ACT), WSP(bf16, WS_WDN), nmt * 256, DM, FF / 2, FF / 2, 0x7d7d7d7d, 0x76767676};
        MoeOrder S; S.init(nmt, DM, F.G, (int)blockIdx.x, nullptr, MTE, (size_t)DM * FF);
        EpiDown E{F.in[I_BDN], MTE, WSP(bf16, WS_YS)}; gemm_phase<EpiDown, MoeOrder, true, true, true>(F.lds + RING_OFF, g, S, E); } SEAM(14);
    if (IN(15)) { p15_combine(F); }
#undef IN
#undef SEAM
}

#ifndef MK_SINGLE
#define MK_SINGLE 1
#endif
extern "C" void kernel_launch(void* const* d_in, const int* in_sizes, int n_in, void* d_out, int out_size, void* d_ws, size_t ws_size, hipStream_t stream) {
    static int grid = 0;
    if (grid == 0) {
        if (n_in != 25 || in_sizes[0] != T * DM || out_size != T * DM || ws_size < WS_END) { fprintf(stderr, "kernel_launch: unexpected shapes (n_in %d, in0 %d, out %d, ws %zu); nothing launched\n", n_in, n_in > 0 ? in_sizes[0] : -1, out_size, ws_size); grid = -1; return; }
        int dev = 0, cus = 0;
        if (hipGetDevice(&dev) != hipSuccess || hipDeviceGetAttribute(&cus, hipDeviceAttributeMultiprocessorCount, dev) != hipSuccess) { grid = -1; return; }
        if (hipFuncSetAttribute((const void*)mega_fwd, hipFuncAttributeMaxDynamicSharedMemorySize, LDS_BYTES) != hipSuccess) { fprintf(stderr, "kernel_launch: hipFuncSetAttribute failed\n"); grid = -1; return; }
        (void)hipGetLastError();
        int per_cu = 0;
        if (hipOccupancyMaxActiveBlocksPerMultiprocessor(&per_cu, (const void*)mega_fwd, NTHR, LDS_BYTES) != hipSuccess || per_cu < 1) { fprintf(stderr, "kernel_launch: occupancy query says the workgroup does not fit a CU\n"); grid = -1; return; }
        grid = cus;
    }
    if (grid < 0) return;
    if (hipMemsetAsync((char*)d_ws + WS_CTL, 0, CTL_ZERO_BYTES, stream) != hipSuccess) return;
    Args a{};
    for (int i = 0; i < 25; ++i) a.in[i] = (const float*)d_in[i];
    a.out = (float*)d_out; a.ws = (unsigned char*)d_ws;
    if (MK_SINGLE) { a.ph_lo = 0; a.ph_hi = NPHASE; hipLaunchKernelGGL(mega_fwd, dim3(grid), dim3(NTHR), LDS_BYTES, stream, a);
#ifdef PROBE_PHASE
        a.ph_lo = PROBE_PHASE; a.ph_hi = PROBE_PHASE + 1; hipLaunchKernelGGL(mega_fwd, dim3(grid), dim3(NTHR), LDS_BYTES, stream, a);
#endif
    }
    else for (int p = 0; p < NPHASE; ++p) { a.ph_lo = p; a.ph_hi = p + 1; hipLaunchKernelGGL(mega_fwd, dim3(grid), dim3(NTHR), LDS_BYTES, stream, a); }
}
```

```cpp
#include <hip/hip_runtime.h>
#include <cstdio>
#include <cstdint>
#include <cmath>
namespace pg8 {
#define PG8_LAS __attribute__((address_space(3)))
typedef unsigned short bf16_t;
typedef short bf16x8 __attribute__((ext_vector_type(8)));
typedef float f32x4 __attribute__((ext_vector_type(4)));
typedef unsigned u32x4 __attribute__((ext_vector_type(4)));
constexpr int BM = 256, BK = 64, HALF = 128, HTB = HALF * BK * 2  , STAGE_BYTES = 8 * HTB, NXCD = 8, WGM = 8;

__host__ __device__ __forceinline__ int lds_byte(int r, int c) { const int st = (r >> 4) * 2 + (c >> 5), rr = r & 15, cc = c & 31, ob = rr * 64 + cc * 2; return st * 1024 + (ob ^ (((ob >> 9) & 1) << 5)); }
__host__ __device__ __forceinline__ void stage_rc(int b, int& R, int& C) { const int st = b / 1024, sb = b % 1024, swz = sb ^ (((sb >> 9) & 1) << 5); R = (st >> 1) * 16 + swz / 64; C = (st & 1) * 32 + (swz % 64) / 2; }
__host__ __device__ __forceinline__ int perm32(int rho) { const int n = rho >> 4, i = rho & 15; return 8 * (i >> 2) + 4 * n + (i & 3); }

struct Unit { int pm, pn; };
struct Gemm { const bf16_t* A; const bf16_t* Bt; int M, N, K, lda; int sclA = 0x7f7f7f7f, sclB = 0x7f7f7f7f; };

struct StaticOrder {
    int nM, nN, nwg, G, c, wgm = WGM;
    __host__ __device__ void init(int M, int N, int G_, int c_) { nM = M / BM; nN = N / BM; nwg = nM * nN; G = G_; c = c_; }
    __host__ __device__ bool next(int i, Unit& u) const {
        const long L = (long)i * G + c; if (L >= nwg) return false;
        int wgid = (int)L; { const int q = nwg / NXCD, r = nwg % NXCD, xcd = wgid % NXCD, off = wgid / NXCD; wgid = (xcd < r ? xcd * (q + 1) : r * (q + 1) + (xcd - r) * q) + off; }
        const int nig = wgm * nN, gid = wgid / nig, fm = gid * wgm, gsz = (nM - fm) < wgm ? (nM - fm) : wgm;
        u.pm = fm + ((wgid % nig) % gsz); u.pn = (wgid % nig) / gsz; return true;
    }
    __device__ __forceinline__ void a_ready(const Unit&) const {}
    __device__ __forceinline__ void done(const Unit&) const {}
    __device__ __forceinline__ size_t b_off(const Unit&) const { return 0; }
    __device__ __forceinline__ int a_row(const Unit& u, int r) const { return u.pm * BM + r; }
};

__device__ __forceinline__ unsigned cvt_pk_bf16(float lo, float hi) { unsigned r; asm volatile("v_cvt_pk_bf16_f32 %0, %1, %2" : "=v"(r) : "v"(lo), "v"(hi)); return r; }
typedef float f32x2 __attribute__((ext_vector_type(2)));
__device__ __forceinline__ f32x2 gelu_pk(f32x2 v) {
    const f32x2 av = __builtin_elementwise_abs(v), d = av * 0.2316418882f + 1.0f;
    f32x2 t; t.x = __builtin_amdgcn_rcpf(d.x); t.y = __builtin_amdgcn_rcpf(d.y);
    f32x2 q = t * 0.5307027145f + (-0.7265760135f); q = q * t + 0.7107068705f; q = q * t + (-0.142248368f); q = q * t + 0.127414796f; q = q * t;
    const f32x2 s = (v * v) * (-0.72134752044f);
    f32x2 e; e.x = __builtin_amdgcn_exp2f(s.x); e.y = __builtin_amdgcn_exp2f(s.y);
    const f32x2 m = v * (q * e), r = v - m;
    f32x2 o; o.x = v.x < 0.f ? m.x : r.x; o.y = v.y < 0.f ? m.y : r.y; return o;
}

template <int ACT  > struct EpiBf16 {
    static constexpr bool PERM = true, AFTER_DRAIN = false; static_assert(ACT == 0 || ACT == 1, "EpiBf16: ACT is 0 (none) or 1 (gelu_pk)");
    bf16_t* O; int ldc; const float* bias; int split_cols; size_t split_stride; float scale0;
    __device__ __forceinline__ void operator()(const f32x4 (&acc)[2][2][4][2], const Unit& u, int wr, int wc, int fr, int fq) const {
        const int row0 = u.pm * BM + wr * 64 + fr; int colt = u.pn * BM; bf16_t* base = O;
        float sc = 1.f; if (split_cols) { const int t = colt / split_cols; base += (size_t)t * split_stride; colt -= t * split_cols; if (t == 0) sc = scale0; }
        const int col0 = colt + wc * 32 + 8 * fq, bcol0 = u.pn * BM + wc * 32 + 8 * fq;
        f32x4 bv[2][2];
#pragma unroll
        for (int bj = 0; bj < 2; ++bj)
#pragma unroll
            for (int n = 0; n < 2; ++n) bv[bj][n] = bias ? *(const f32x4*)(bias + bcol0 + bj * HALF + 4 * n) : (f32x4){0.f, 0.f, 0.f, 0.f};
#pragma unroll
        for (int ai = 0; ai < 2; ++ai)
#pragma unroll
            for (int m = 0; m < 4; ++m) { bf16_t* rowp = base + (size_t)(row0 + ai * HALF + m * 16) * ldc + col0;
#pragma unroll
                for (int bj = 0; bj < 2; ++bj) { f32x4 v0 = acc[ai][bj][m][0] + bv[bj][0], v1 = acc[ai][bj][m][1] + bv[bj][1];
                    if (ACT == 1) { f32x2 a = gelu_pk((f32x2){v0[0], v0[1]}), b = gelu_pk((f32x2){v0[2], v0[3]}), c = gelu_pk((f32x2){v1[0], v1[1]}), d = gelu_pk((f32x2){v1[2], v1[3]});
                        v0 = (f32x4){a.x, a.y, b.x, b.y}; v1 = (f32x4){c.x, c.y, d.x, d.y}; }
                    v0 = v0 * sc; v1 = v1 * sc; u32x4 w; w.x = cvt_pk_bf16(v0[0], v0[1]); w.y = cvt_pk_bf16(v0[2], v0[3]); w.z = cvt_pk_bf16(v1[0], v1[1]); w.w = cvt_pk_bf16(v1[2], v1[3]);
                    *(u32x4*)(rowp + bj * HALF) = w; } }
    }
};
__device__ __forceinline__ float bf_lo(unsigned w) { return __uint_as_float(w << 16); }
__device__ __forceinline__ float bf_hi(unsigned w) { return __uint_as_float(w & 0xffff0000u); }
__device__ __forceinline__ float sigmoidf_(float x) { return __builtin_amdgcn_rcpf(1.0f + __expf(-x)); }
template <class F> struct EpiPerm8 {
    static constexpr bool PERM = true, AFTER_DRAIN = false;
    F f;
    __device__ __forceinline__ void operator()(const f32x4 (&acc)[2][2][4][2], const Unit& u, int wr, int wc, int fr, int fq) const {
        const int row0 = u.pm * BM + wr * 64 + fr, col0 = u.pn * BM + wc * 32 + 8 * fq;
#pragma unroll
        for (int ai = 0; ai < 2; ++ai)
#pragma unroll
            for (int m = 0; m < 4; ++m)
#pragma unroll
                for (int bj = 0; bj < 2; ++bj) { float v[8]; const f32x4 v0 = acc[ai][bj][m][0], v1 = acc[ai][bj][m][1];
                    v[0] = v0[0]; v[1] = v0[1]; v[2] = v0[2]; v[3] = v0[3]; v[4] = v1[0]; v[5] = v1[1]; v[6] = v1[2]; v[7] = v1[3];
                    f(u, row0 + ai * HALF + m * 16, col0 + bj * HALF, v); }
    }
};
__device__ __forceinline__ u32x4 pack8bf(const float (&v)[8]) { u32x4 w; w.x = cvt_pk_bf16(v[0], v[1]); w.y = cvt_pk_bf16(v[2], v[3]); w.z = cvt_pk_bf16(v[4], v[5]); w.w = cvt_pk_bf16(v[6], v[7]); return w; }
struct FStoreBf16 { bf16_t* O; int ldc;
    __device__ __forceinline__ void operator()(const Unit&, int row, int col, float (&v)[8]) const { *(u32x4*)(O + (size_t)row * ldc + col) = pack8bf(v); } };
struct FStoreProj { bf16_t* O; int ldc; bf16_t* QL; bf16_t* KVL;
    __device__ __forceinline__ void operator()(const Unit& u, int row, int col, float (&v)[8]) const { const u32x4 w = pack8bf(v); *(u32x4*)(O + (size_t)row * ldc + col) = w;
        if (u.pn >= 10 && u.pn <= 12) { if (col >= 2576 && col < 2960) *(u32x4*)(QL + (size_t)row * 384 + (col - 2576)) = w; else if (col >= 2960 && col < 3216) *(u32x4*)(KVL + (size_t)row * 256 + (col - 2960)) = w; } } };
struct FGate1 { const bf16_t* gate; int ldg; bf16_t* O; int ldc;
    __device__ __forceinline__ void operator()(const Unit&, int row, int col, float (&v)[8]) const {
        const u32x4 g = *(const u32x4*)(gate + (size_t)row * ldg + col);
        v[0] *= sigmoidf_(bf_lo(g.x)); v[1] *= sigmoidf_(bf_hi(g.x)); v[2] *= sigmoidf_(bf_lo(g.y)); v[3] *= sigmoidf_(bf_hi(g.y));
        v[4] *= sigmoidf_(bf_lo(g.z)); v[5] *= sigmoidf_(bf_hi(g.z)); v[6] *= sigmoidf_(bf_lo(g.w)); v[7] *= sigmoidf_(bf_hi(g.w));
        *(u32x4*)(O + (size_t)row * ldc + col) = pack8bf(v); } };
struct FGate2 { const bf16_t* gate; int ldg; bf16_t* O; int ldc;
    __device__ __forceinline__ void operator()(const Unit&, int row, int col, float (&v)[8]) const {
        const u32x4 g = *(const u32x4*)(gate + (size_t)row * ldg + col); const u32x4 o = *(const u32x4*)(O + (size_t)row * ldc + col);
        v[0] = bf_lo(o.x) + v[0] * sigmoidf_(bf_lo(g.x)); v[1] = bf_hi(o.x) + v[1] * sigmoidf_(bf_hi(g.x)); v[2] = bf_lo(o.y) + v[2] * sigmoidf_(bf_lo(g.y)); v[3] = bf_hi(o.y) + v[3] * sigmoidf_(bf_hi(g.y));
        v[4] = bf_lo(o.z) + v[4] * sigmoidf_(bf_lo(g.z)); v[5] = bf_hi(o.z) + v[5] * sigmoidf_(bf_hi(g.z)); v[6] = bf_lo(o.w) + v[6] * sigmoidf_(bf_lo(g.w)); v[7] = bf_hi(o.w) + v[7] * sigmoidf_(bf_hi(g.w));
        *(u32x4*)(O + (size_t)row * ldc + col) = pack8bf(v); } };
struct FResF32 { const float* base; float* out; int ldc;
    __device__ __forceinline__ void operator()(const Unit&, int row, int col, float (&v)[8]) const {
        const f32x4 b0 = *(const f32x4*)(base + (size_t)row * ldc + col), b1 = *(const f32x4*)(base + (size_t)row * ldc + col + 4);
        *(f32x4*)(out + (size_t)row * ldc + col) = (f32x4){b0[0] + v[0], b0[1] + v[1], b0[2] + v[2], b0[3] + v[3]};
        *(f32x4*)(out + (size_t)row * ldc + col + 4) = (f32x4){b1[0] + v[4], b1[1] + v[5], b1[2] + v[6], b1[3] + v[7]}; } };
template <class G> struct EpiPipe8 {
    static constexpr bool PERM = true, AFTER_DRAIN = false;
    G f;
    __device__ __forceinline__ void operator()(const f32x4 (&acc)[2][2][4][2], const Unit& u, int wr, int wc, int fr, int fq) const {
        const int row0 = u.pm * BM + wr * 64 + fr, col0 = u.pn * BM + wc * 32 + 8 * fq;
        constexpr int D = G::DEPTH;
        typename G::L l[D];
#pragma unroll
        for (int g = 0; g < D; ++g) f.load(u, row0 + (g >> 3) * HALF + ((g >> 1) & 3) * 16, col0 + (g & 1) * HALF, l[g]);
#pragma unroll
        for (int g = 0; g < 16; ++g) { const int ai = g >> 3, m = (g >> 1) & 3, bj = g & 1; float v[8]; const f32x4 v0 = acc[ai][bj][m][0], v1 = acc[ai][bj][m][1];
            v[0] = v0[0]; v[1] = v0[1]; v[2] = v0[2]; v[3] = v0[3]; v[4] = v1[0]; v[5] = v1[1]; v[6] = v1[2]; v[7] = v1[3];
            f.apply(u, row0 + ai * HALF + m * 16, col0 + bj * HALF, v, l[g % D]);
            if (g + D < 16) { const int g2 = g + D; f.load(u, row0 + (g2 >> 3) * HALF + ((g2 >> 1) & 3) * 16, col0 + (g2 & 1) * HALF, l[g % D]); } }
    }
};
__device__ __forceinline__ f32x2 sig2_bf(unsigned w) { f32x2 t = (f32x2){bf_lo(w), bf_hi(w)} * (-1.4426950408889634f); t.x = __builtin_amdgcn_exp2f(t.x); t.y = __builtin_amdgcn_exp2f(t.y);
    const f32x2 d = t + 1.0f; f32x2 r; r.x = __builtin_amdgcn_rcpf(d.x); r.y = __builtin_amdgcn_rcpf(d.y); return r; }
struct GGate1 { const bf16_t* gate; int ldg; bf16_t* O; int ldc;
    typedef u32x4 L; static constexpr int DEPTH = 16;
    __device__ __forceinline__ void load(const Unit&, int row, int col, L& g) const { g = *(const u32x4*)(gate + (size_t)row * ldg + col); }
    __device__ __forceinline__ void apply(const Unit&, int row, int col, float (&v)[8], const L& g) const {
        const f32x2 a = (f32x2){v[0], v[1]} * sig2_bf(g.x), b = (f32x2){v[2], v[3]} * sig2_bf(g.y), c = (f32x2){v[4], v[5]} * sig2_bf(g.z), d = (f32x2){v[6], v[7]} * sig2_bf(g.w);
        u32x4 w; w.x = cvt_pk_bf16(a.x, a.y); w.y = cvt_pk_bf16(b.x, b.y); w.z = cvt_pk_bf16(c.x, c.y); w.w = cvt_pk_bf16(d.x, d.y);
        *(u32x4*)(O + (size_t)row * ldc + col) = w; } };
struct GGate2 { const bf16_t* gate; int ldg; bf16_t* O; int ldc;
    struct L { u32x4 g, o; }; static constexpr int DEPTH = 6;
    __device__ __forceinline__ void load(const Unit&, int row, int col, L& l) const { l.g = *(const u32x4*)(gate + (size_t)row * ldg + col); l.o = *(const u32x4*)(O + (size_t)row * ldc + col); }
    __device__ __forceinline__ void apply(const Unit&, int row, int col, float (&v)[8], const L& l) const { const u32x4 g = l.g, o = l.o;
        const f32x2 a = (f32x2){v[0], v[1]} * sig2_bf(g.x) + (f32x2){bf_lo(o.x), bf_hi(o.x)}, b = (f32x2){v[2], v[3]} * sig2_bf(g.y) + (f32x2){bf_lo(o.y), bf_hi(o.y)};
        const f32x2 c = (f32x2){v[4], v[5]} * sig2_bf(g.z) + (f32x2){bf_lo(o.z), bf_hi(o.z)}, d = (f32x2){v[6], v[7]} * sig2_bf(g.w) + (f32x2){bf_lo(o.w), bf_hi(o.w)};
        u32x4 w; w.x = cvt_pk_bf16(a.x, a.y); w.y = cvt_pk_bf16(b.x, b.y); w.z = cvt_pk_bf16(c.x, c.y); w.w = cvt_pk_bf16(d.x, d.y);
        *(u32x4*)(O + (size_t)row * ldc + col) = w; } };
struct GResF32 { const float* base; float* out; int ldc;
    struct L { f32x4 b0, b1; }; static constexpr int DEPTH = 6;
    __device__ __forceinline__ void load(const Unit&, int row, int col, L& l) const { l.b0 = *(const f32x4*)(base + (size_t)row * ldc + col); l.b1 = *(const f32x4*)(base + (size_t)row * ldc + col + 4); }
    __device__ __forceinline__ void apply(const Unit&, int row, int col, float (&v)[8], const L& l) const {
        *(f32x4*)(out + (size_t)row * ldc + col) = (f32x4){l.b0[0] + v[0], l.b0[1] + v[1], l.b0[2] + v[2], l.b0[3] + v[3]};
        *(f32x4*)(out + (size_t)row * ldc + col + 4) = (f32x4){l.b1[0] + v[4], l.b1[1] + v[5], l.b1[2] + v[6], l.b1[3] + v[7]}; } };
#ifndef MOE_WGM
#define MOE_WGM 2
#endif
struct MoeOrder {
    StaticOrder so; const int* rowtok; const int* mte; size_t bstride;
    __device__ void init(int nmt, int N, int G_, int c_, const int* rowtok_, const int* mte_, size_t bstride_) { so.init(nmt * BM, N, G_, c_); so.wgm = MOE_WGM; rowtok = rowtok_; mte = mte_; bstride = bstride_; }
    __device__ bool next(int i, Unit& u) const { return so.next(i, u); }
    __device__ __forceinline__ void a_ready(const Unit&) const {}
    __device__ __forceinline__ void done(const Unit&) const {}
    __device__ __forceinline__ size_t b_off(const Unit& u) const { return (size_t)mte[u.pm] * bstride; }
    __device__ __forceinline__ int a_row(const Unit& u, int r) const { return rowtok ? rowtok[u.pm * BM + r] : u.pm * BM + r; }
};
struct EpiGateUp {
    static constexpr bool PERM = true, AFTER_DRAIN = false;
    const float* bgu; const int* mte; unsigned char* ACT;
    static __device__ __forceinline__ f32x2 act2(f32x2 g, f32x2 l) {
        g.x = fminf(g.x, 7.0f); g.y = fminf(g.y, 7.0f); l.x = fminf(fmaxf(l.x, -7.0f), 7.0f); l.y = fminf(fmaxf(l.y, -7.0f), 7.0f);
        f32x2 t = g * (-1.702f * 1.4426950408889634f); t.x = __builtin_amdgcn_exp2f(t.x); t.y = __builtin_amdgcn_exp2f(t.y);
        const f32x2 d = t + 1.0f; f32x2 r; r.x = __builtin_amdgcn_rcpf(d.x); r.y = __builtin_amdgcn_rcpf(d.y);
        return (g * r) * (l * 4.0f + 4.0f);
    }
    __device__ __forceinline__ void operator()(const f32x4 (&acc)[2][2][4][2], const Unit& u, int wr, int wc, int fr, int fq) const {
        const int e = mte[u.pm], row0 = u.pm * BM + wr * 64 + fr, j0 = u.pn * HALF + wc * 32 + 8 * fq;
        const float* bg = bgu + (size_t)e * 2048 + j0; const float* bl = bg + 1024;
        const f32x4 bgv[2] = {*(const f32x4*)bg, *(const f32x4*)(bg + 4)}, blv[2] = {*(const f32x4*)bl, *(const f32x4*)(bl + 4)};
#pragma unroll
        for (int ai = 0; ai < 2; ++ai)
#pragma unroll
            for (int m = 0; m < 4; ++m) { int w[2];
#pragma unroll
                for (int h = 0; h < 2; ++h) { const f32x4 G = acc[ai][0][m][h] + bgv[h], L = acc[ai][1][m][h] + blv[h];
                    const f32x2 v01 = act2((f32x2){G[0], G[1]}, (f32x2){L[0], L[1]}), v23 = act2((f32x2){G[2], G[3]}, (f32x2){L[2], L[3]});
                    w[h] = __builtin_amdgcn_cvt_pk_fp8_f32(v01.x, v01.y, 0, false); w[h] = __builtin_amdgcn_cvt_pk_fp8_f32(v23.x, v23.y, w[h], true); }
                typedef unsigned u32x2_ __attribute__((ext_vector_type(2))); *(u32x2_*)(ACT + (size_t)(row0 + ai * HALF + m * 16) * 1024 + j0) = (u32x2_){(unsigned)w[0], (unsigned)w[1]}; }
    }
};
struct EpiDown {
    static constexpr bool PERM = true, AFTER_DRAIN = false;
    const float* bdn; const int* mte; bf16_t* YS;
    __device__ __forceinline__ void operator()(const f32x4 (&acc)[2][2][4][2], const Unit& u, int wr, int wc, int fr, int fq) const {
        const int row0 = u.pm * BM + wr * 64 + fr, col0 = u.pn * BM + wc * 32 + 8 * fq;
        const float* b = bdn + (size_t)mte[u.pm] * 1024 + col0;
        f32x4 bv[2][2];
#pragma unroll
        for (int bj = 0; bj < 2; ++bj) { bv[bj][0] = *(const f32x4*)(b + bj * HALF); bv[bj][1] = *(const f32x4*)(b + bj * HALF + 4); }
#pragma unroll
        for (int ai = 0; ai < 2; ++ai)
#pragma unroll
            for (int m = 0; m < 4; ++m)
#pragma unroll
                for (int bj = 0; bj < 2; ++bj) { const f32x4 v0 = acc[ai][bj][m][0] + bv[bj][0], v1 = acc[ai][bj][m][1] + bv[bj][1];
                    u32x4 w; w.x = cvt_pk_bf16(v0[0], v0[1]); w.y = cvt_pk_bf16(v0[2], v0[3]); w.z = cvt_pk_bf16(v1[0], v1[1]); w.w = cvt_pk_bf16(v1[2], v1[3]);
                    *(u32x4*)(YS + (size_t)(row0 + ai * HALF + m * 16) * 1024 + col0 + bj * HALF) = w; }
    }
};
typedef int v4i_t __attribute__((ext_vector_type(4)));
typedef int v8i_t __attribute__((ext_vector_type(8)));
typedef float f32x8_t __attribute__((ext_vector_type(8)));
template <class Epi, class Sched, bool ALIGN_EPI = false, bool SP2 = true, bool FP8 = false>
__device__ __forceinline__ void gemm_phase(PG8_LAS unsigned char* lds, const Gemm g, const Sched& S, const Epi& E) {
    static_assert(SP2, "only the two-super-phase loop is kept in this file");
    const int tid = threadIdx.x, wid = __builtin_amdgcn_readfirstlane(tid >> 6), lane = tid & 63, wr = wid >> 2, wc = wid & 3, fr = lane & 15, fq = lane >> 4;
    const int K = g.K, nt = K / BK;
    unsigned vA0[2], vA1[2], nA0[2], nA1[2], voffB[2]; int RA[2], CA[2];
#pragma unroll
    for (int i = 0; i < 2; ++i) { int R, C; stage_rc(tid * 16 + i * 8192, R, C); const int Rb = Epi::PERM ? ((R & ~31) + perm32(R & 31)) : R;
        RA[i] = R; CA[i] = C; voffB[i] = (unsigned)(Rb * K + C) * 2u; }
    const size_t kstep = (size_t)(BK * 2);
    const size_t hstepB = (size_t)HALF * K * 2;
    const size_t tstepB = 2 * hstepB;
    const unsigned ldsw = (unsigned)wid * 1024u;
    const int aoff = lds_byte(wr * 64 + fr, fq * 8), boff = lds_byte(wc * 32 + fr, fq * 8);
#define PG8_SA(b, h) (((b) * 2 + (h)) * HTB)
#define PG8_SB(b, h) ((4 + (b) * 2 + (h)) * HTB)
#define PG8_STAGE(bufoff, gbase, voff) do { _Pragma("unroll") for (int _i = 0; _i < 2; ++_i) \
        __builtin_amdgcn_global_load_lds((const unsigned*)((const char*)(gbase) + (voff)[_i]), (PG8_LAS unsigned*)(lds + (bufoff) + ldsw + _i * 8192), 16, 0, 0); } while (0)
#define PG8_LDA(dst, dst8, b, h) do { if constexpr (!FP8) { _Pragma("unroll") for (int m = 0; m < 4; ++m) _Pragma("unroll") for (int k = 0; k < 2; ++k) dst[m][k] = *(const PG8_LAS bf16x8*)(lds + PG8_SA(b, h) + aoff + m * 2048 + k * 1024); } \
      else { _Pragma("unroll") for (int m = 0; m < 4; ++m) { const v4i_t lo_ = *(const PG8_LAS v4i_t*)(lds + PG8_SA(b, h) + aoff + m * 2048), hi_ = *(const PG8_LAS v4i_t*)(lds + PG8_SA(b, h) + aoff + m * 2048 + 1024); dst8[m] = __builtin_shufflevector(lo_, hi_, 0, 1, 2, 3, 4, 5, 6, 7); } } } while (0)
#define PG8_LDB(dst, dst8, b, h) do { if constexpr (!FP8) { _Pragma("unroll") for (int n = 0; n < 2; ++n) _Pragma("unroll") for (int k = 0; k < 2; ++k) dst[n][k] = *(const PG8_LAS bf16x8*)(lds + PG8_SB(b, h) + boff + n * 2048 + k * 1024); } \
      else { _Pragma("unroll") for (int n = 0; n < 2; ++n) { const v4i_t lo_ = *(const PG8_LAS v4i_t*)(lds + PG8_SB(b, h) + boff + n * 2048), hi_ = *(const PG8_LAS v4i_t*)(lds + PG8_SB(b, h) + boff + n * 2048 + 1024); dst8[n] = __builtin_shufflevector(lo_, hi_, 0, 1, 2, 3, 4, 5, 6, 7); } } } while (0)
#define PG8_MMA(ai, bj, At, Bt, At8, Bt8) do { __builtin_amdgcn_s_setprio(1); if constexpr (!FP8) { _Pragma("unroll") for (int m = 0; m < 4; ++m) _Pragma("unroll") for (int n = 0; n < 2; ++n) _Pragma("unroll") for (int k = 0; k < 2; ++k) \
        acc[ai][bj][m][n] = __builtin_amdgcn_mfma_f32_16x16x32_bf16(Bt[n][k], At[m][k], acc[ai][bj][m][n], 0, 0, 0); } \
      else { _Pragma("unroll") for (int m = 0; m < 4; ++m) _Pragma("unroll") for (int n = 0; n < 2; ++n)   \
        asm volatile("v_mfma_scale_f32_16x16x128_f8f6f4 %0, %1, %2, %0, %3, %4 op_sel_hi:[0,0,0]" : "+v"(acc[ai][bj][m][n]) : "v"(Bt8[n]), "v"(At8[m]), "v"(sclB), "v"(sclA)); } \
      __builtin_amdgcn_s_setprio(0); } while (0)
#define PG8_WAIT_V(n) asm volatile("s_waitcnt vmcnt(" #n ")" ::: "memory")
#define PG8_WAIT_L(n) asm volatile("s_waitcnt lgkmcnt(" #n ")" ::: "memory")
#define PG8_BAR __builtin_amdgcn_s_barrier()
#define PG8_SCHED __builtin_amdgcn_sched_barrier(0)
#define PG8_AROWS(d0, d1, u) do { _Pragma("unroll") for (int _i = 0; _i < 2; ++_i) { d0[_i] = (unsigned)((size_t)S.a_row(u, RA[_i]) * g.lda + CA[_i]) * 2u; d1[_i] = (unsigned)((size_t)S.a_row(u, HALF + RA[_i]) * g.lda + CA[_i]) * 2u; } } while (0)
    Unit cur, nxt; int ui = 0;
    if (!S.next(0, cur)) return;
    f32x4 acc[2][2][4][2];
#pragma unroll
    for (int a = 0; a < 2; ++a)
#pragma unroll
        for (int b = 0; b < 2; ++b)
#pragma unroll
            for (int m = 0; m < 4; ++m)
#pragma unroll
                for (int n = 0; n < 2; ++n) acc[a][b][m][n] = (f32x4){0.f, 0.f, 0.f, 0.f};
    bf16x8 At[4][2], B0[2][2], B1[2][2]; v8i_t At8[4], B08[2], B18[2]; const int sclA = g.sclA, sclB = g.sclB; (void)At8; (void)B08; (void)B18; (void)sclA; (void)sclB;
    const char* const gA = (const char*)g.A;
    const char* cB = (const char*)g.Bt + (size_t)cur.pn * tstepB + S.b_off(cur);
    PG8_AROWS(vA0, vA1, cur);
    S.a_ready(cur);
    PG8_STAGE(PG8_SB(0, 0), cB, voffB); PG8_STAGE(PG8_SB(0, 1), cB + hstepB, voffB); PG8_STAGE(PG8_SA(0, 0), gA, vA0); PG8_STAGE(PG8_SA(0, 1), gA, vA1);
    if (wr == 1) PG8_BAR;
    PG8_WAIT_V(2); PG8_BAR;
    PG8_STAGE(PG8_SB(1, 0), cB + kstep, voffB); PG8_STAGE(PG8_SA(1, 0), gA + kstep, vA0); PG8_STAGE(PG8_SB(1, 1), cB + hstepB + kstep, voffB);
    PG8_WAIT_V(6); PG8_BAR;
    for (;;) {
        const bool has_next = S.next(ui + 1, nxt);
        const char* nB = has_next ? (const char*)g.Bt + (size_t)nxt.pn * tstepB + S.b_off(nxt) : cB;
        if (has_next) { PG8_AROWS(nA0, nA1, nxt); } else { nA0[0] = vA0[0]; nA0[1] = vA0[1]; nA1[0] = vA1[0]; nA1[1] = vA1[1]; }
#pragma unroll 1
        for (int t = 0; t < nt; t += 2) {
            const bool last = (t == nt - 2);
            const char* a1 = gA + (size_t)(t + 1) * kstep;
            const char* a2 = last ? gA : gA + (size_t)(t + 2) * kstep; const char* b2 = last ? nB : cB + (size_t)(t + 2) * kstep;
            const char* a3 = a2 + kstep; const char* b3 = b2 + kstep;
            unsigned x0[2], x1[2]; x0[0] = last ? nA0[0] : vA0[0]; x0[1] = last ? nA0[1] : vA0[1]; x1[0] = last ? nA1[0] : vA1[0]; x1[1] = last ? nA1[1] : vA1[1];
            if (last && has_next) S.a_ready(nxt);
            PG8_LDB(B0, B08, 0, 0); PG8_LDB(B1, B18, 0, 1); PG8_SCHED; PG8_LDA(At, At8, 0, 0); PG8_STAGE(PG8_SA(1, 1), a1, vA1);
            PG8_WAIT_V(8); PG8_WAIT_L(0); PG8_BAR; PG8_MMA(0, 0, At, B0, At8, B08); PG8_MMA(0, 1, At, B1, At8, B18); PG8_BAR; PG8_SCHED;
            PG8_LDA(At, At8, 0, 1); PG8_STAGE(PG8_SB(0, 0), b2, voffB); PG8_STAGE(PG8_SB(0, 1), b2 + hstepB, voffB); PG8_STAGE(PG8_SA(0, 0), a2, x0);
            PG8_WAIT_V(8); PG8_WAIT_L(0); PG8_BAR; PG8_MMA(1, 0, At, B0, At8, B08); PG8_MMA(1, 1, At, B1, At8, B18); PG8_BAR; PG8_SCHED;
            PG8_LDB(B0, B08, 1, 0); PG8_LDB(B1, B18, 1, 1); PG8_SCHED; PG8_LDA(At, At8, 1, 0); PG8_STAGE(PG8_SA(0, 1), a2, x1);
            PG8_WAIT_V(8); PG8_WAIT_L(0); PG8_BAR; PG8_MMA(0, 0, At, B0, At8, B08); PG8_MMA(0, 1, At, B1, At8, B18); PG8_BAR; PG8_SCHED;
            PG8_LDA(At, At8, 1, 1); PG8_STAGE(PG8_SB(1, 0), b3, voffB); PG8_STAGE(PG8_SB(1, 1), b3 + hstepB, voffB); PG8_STAGE(PG8_SA(1, 0), a3, x0);
            PG8_WAIT_V(8); PG8_WAIT_L(0); PG8_BAR; PG8_MMA(1, 0, At, B0, At8, B08); PG8_MMA(1, 1, At, B1, At8, B18); PG8_BAR; PG8_SCHED;
        }
        if constexpr (ALIGN_EPI) { if (wr == 0) PG8_BAR; }
        if constexpr (FP8) asm volatile("s_nop 15\n\ts_nop 7" ::: "memory");
        if constexpr (!Epi::AFTER_DRAIN) { E(acc, cur, wr, wc, fr, fq); S.done(cur); }
        if (!has_next) break;
#pragma unroll
        for (int a = 0; a < 2; ++a)
#pragma unroll
            for (int b = 0; b < 2; ++b)
#pragma unroll
                for (int m = 0; m < 4; ++m)
#pragma unroll
                    for (int n = 0; n < 2; ++n) acc[a][b][m][n] = (f32x4){0.f, 0.f, 0.f, 0.f};
        cur = nxt; cB = nB; ++ui; vA0[0] = nA0[0]; vA0[1] = nA0[1]; vA1[0] = nA1[0]; vA1[1] = nA1[1];
        if constexpr (ALIGN_EPI) { if (wr == 1) PG8_BAR; }
    }
    PG8_WAIT_V(0);
    if constexpr (!ALIGN_EPI) { if (wr == 0) PG8_BAR; }
    PG8_BAR;
    if constexpr (Epi::AFTER_DRAIN) { E.fused(acc, cur, wr, wc, fr, fq, lds, wid, lane); S.done(cur); }
#undef PG8_SA
#undef PG8_SB
#undef PG8_STAGE
#undef PG8_LDA
#undef PG8_LDB
#undef PG8_MMA
#undef PG8_WAIT_V
#undef PG8_WAIT_L
#undef PG8_BAR
#undef PG8_SCHED
#undef PG8_AROWS
}
}
constexpr int NWAVES = 8, NTHR = 512;
constexpr int BATCH = 2, SEQ = 8192, DM = 1024, T = BATCH * SEQ;
constexpr int CHUNK = 64, NCHUNK = SEQ / CHUNK;
constexpr int SSD_H = 16, SSD_P = 64, SSD_G = 2, SSD_HPG = 8, SSD_N = 128, CONV_DIM = 1536;
constexpr int MLA_H = 8, QRANK = 384, KVRANK = 256, NOPE = 128, ROPE = 64, QKD = 192, VD = 128;
constexpr int NE = 32, TOPK = 4, FF = 1024;
constexpr int OFF_XBC = 1024, OFF_DT = 2560, OFF_QLAT = 2576, OFF_KVLAT = 2960, OFF_KROPE = 3216, OFF_GATE = 3280, IN_DIM = 5328, IN_PAD = 5376;
constexpr float EPS = 1e-6f;
constexpr int MT_MAX = 288, NSLOT_MAX = MT_MAX * 256;
constexpr float WGU_SCALE = 512.f, H2_SCALE = 16.f;
constexpr float QSCALE = 0.07216878364870322f * 1.4426950408889634f;

constexpr size_t MiB = 1u << 20;
constexpr size_t WS_CTL = 0, CTL_ZERO_BYTES = 1 * MiB;
constexpr size_t WS_WIN = 1 * MiB, WS_WQ = 12 * MiB, WS_WKV = 14 * MiB, WS_WSSD = 16 * MiB, WS_WMLA = 18 * MiB, WS_WO = 20 * MiB, WS_WGU = 22 * MiB, WS_WDN = 150 * MiB;
constexpr size_t WS_XN = 214 * MiB, WS_YN = 246 * MiB, WS_OATT = 278 * MiB, WS_MRG = 310 * MiB;
constexpr size_t WS_ACUM = 342 * MiB, WS_TOPI = 343 * MiB, WS_TOPG = WS_TOPI + 256 * 1024, WS_SLOT = WS_TOPG + 256 * 1024, WS_CNT = WS_SLOT + 256 * 1024;
constexpr size_t WS_ROWTOK = 344 * MiB, WS_MTE = WS_ROWTOK + 512 * 1024, WS_CDEC = WS_MTE + 64 * 1024;
constexpr size_t WS_ROPE = 346 * MiB;
constexpr size_t WS_QLAT = 912 * MiB, WS_KVLAT = 924 * MiB;
constexpr size_t WS_CONVC = 352 * MiB;
constexpr size_t WS_PROJ = 360 * MiB, WS_QPRE = 528 * MiB, WS_KVPRE = 576 * MiB, WS_Q = 640 * MiB, WS_K = 688 * MiB, WS_V = 736 * MiB, WS_XC = 768 * MiB, WS_YDIAG = 816 * MiB, WS_STATES = 848 * MiB;
constexpr size_t WS_ACT = 360 * MiB, WS_YS = 504 * MiB;
constexpr size_t WS_SSQ = 932 * MiB, WS_RQ = 936 * MiB;
constexpr size_t WS_SMAX = WS_RQ + 512 * 1024;
constexpr size_t WS_END = 937 * MiB;
static_assert(WS_ACT + (size_t)NSLOT_MAX * FF * 2 <= WS_YS && WS_YS + (size_t)NSLOT_MAX * DM * 2 <= WS_END, "moe overlay");
static_assert(WS_PROJ + (size_t)T * IN_PAD * 2 <= WS_QPRE, "proj");
constexpr int CW_TMO = 0, CW_CODE = 1, CW_BAR = 4096;

constexpr int RING_OFF = 0, RING_BYTES = 131072;
constexpr int LDSCTL_OFF = RING_BYTES, MISC_OFF = LDSCTL_OFF + 320;
constexpr int LDS_BYTES = 147456;

#define GAS __attribute__((address_space(1)))
#define LAS __attribute__((address_space(3)))
typedef unsigned short bf16;
typedef unsigned v4u __attribute__((ext_vector_type(4)));
typedef unsigned v2u __attribute__((ext_vector_type(2)));
typedef float f32x4 __attribute__((ext_vector_type(4)));
typedef float f32x2 __attribute__((ext_vector_type(2)));
typedef short bf16x8 __attribute__((ext_vector_type(8)));
typedef GAS unsigned gu32;
typedef GAS unsigned long long gu64;
#define RLX_AGENT __ATOMIC_RELAXED, __HIP_MEMORY_SCOPE_AGENT
#define LDS_WAIT() asm volatile("s_waitcnt lgkmcnt(0)" ::: "memory")
#define VM_WAIT() asm volatile("s_waitcnt vmcnt(0)" ::: "memory")
__device__ __forceinline__ unsigned f2bf(float f) { unsigned u = __builtin_bit_cast(unsigned, f); return (u + 0x7fffu + ((u >> 16) & 1u)) >> 16; }
typedef float pkf32x2_ __attribute__((ext_vector_type(2))); typedef __bf16 pkbf16x2_ __attribute__((ext_vector_type(2)));
__device__ __forceinline__ unsigned pk2(float lo, float hi) { const pkbf16x2_ r = __builtin_convertvector((pkf32x2_){lo, hi}, pkbf16x2_); return __builtin_bit_cast(unsigned, r); }
__device__ __forceinline__ float bf2f(unsigned short b) { return __uint_as_float((unsigned)b << 16); }
__device__ __forceinline__ float blo(unsigned w) { return __uint_as_float(w << 16); }
__device__ __forceinline__ float bhi(unsigned w) { return __uint_as_float(w & 0xffff0000u); }
__device__ __forceinline__ void unpack8(const v4u w, float (&v)[8]) { v[0] = blo(w.x); v[1] = bhi(w.x); v[2] = blo(w.y); v[3] = bhi(w.y); v[4] = blo(w.z); v[5] = bhi(w.z); v[6] = blo(w.w); v[7] = bhi(w.w); }
__device__ __forceinline__ v4u pack8(const float (&v)[8]) { v4u w; w.x = pk2(v[0], v[1]); w.y = pk2(v[2], v[3]); w.z = pk2(v[4], v[5]); w.w = pk2(v[6], v[7]); return w; }
__device__ __forceinline__ float wave_sum(float v) {
#pragma unroll
    for (int o = 1; o < 64; o <<= 1) v += __shfl_xor(v, o);
    return v;
}
__device__ __forceinline__ float wave_max(float v) {
#pragma unroll
    for (int o = 1; o < 64; o <<= 1) v = fmaxf(v, __shfl_xor(v, o));
    return v;
}
__device__ __forceinline__ float siluf_(float x) { return x * __builtin_amdgcn_rcpf(1.0f + __expf(-x)); }
__device__ __forceinline__ float softplusf_(float x) { return x > 20.f ? x : log1pf(__expf(x)); }
#define XB_TMO      128
#define XB_XCNT(j)  (256  + 64 * (j))
#define XB_XSUB(j)  (1280 + 64 * (j))
#define XB_XGEN(j)  (2304 + 64 * (j))
#define XB_TOP      3328
#define XB_TOPGEN   3392
#define XCD_BAR_WORDS 3456
#define XB_SPIN_CAP (1u << 18)

__device__ __forceinline__ unsigned xb_ld(unsigned* p)              { return __hip_atomic_load(p, __ATOMIC_RELAXED, __HIP_MEMORY_SCOPE_AGENT); }
__device__ __forceinline__ unsigned xb_add(unsigned* p, unsigned v) { return __hip_atomic_fetch_add(p, v, __ATOMIC_RELAXED, __HIP_MEMORY_SCOPE_AGENT); }
__device__ __forceinline__ unsigned xb_xcc_id() { return (unsigned)__builtin_amdgcn_s_getreg((3 << 11) | 20) & 0xFu; }
#define XB_SPIN(cond, bar) do { unsigned _sp = 0; while (cond) { __builtin_amdgcn_s_sleep(1); \
    if ((++_sp & 255u) == 0u) { if (xb_ld(&(bar)[XB_TMO])) break; if (_sp > XB_SPIN_CAP) { atomicAdd(&(bar)[XB_TMO], 1u); break; } } } } while (0)

struct XcdBarrier {
    unsigned* bar; unsigned x;
    volatile LAS unsigned* st;
};

__device__ __forceinline__ XcdBarrier xcd_barrier_post(unsigned* bar, volatile LAS unsigned* st) {
    XcdBarrier b; b.bar = bar; b.x = xb_xcc_id(); b.st = st;
    if (threadIdx.x == 0) (void)xb_add(&bar[XB_XCNT(b.x)], 1u);
    return b;
}
__device__ __forceinline__ void xcd_barrier_complete(unsigned* bar, unsigned x, unsigned& nloc, unsigned& nx) {
    const unsigned G = gridDim.x * gridDim.y * gridDim.z;
    unsigned sum, cnt, mine, sp = 0u;
    for (;;) {
        sum = 0u; cnt = 0u; mine = 0u;
#pragma unroll
        for (unsigned j = 0; j < 16; ++j) { const unsigned c = xb_ld(&bar[XB_XCNT(j)]); sum += c; cnt += (c > 0u) ? 1u : 0u; mine = (j == x) ? c : mine; }
        if (sum == G) break;
        __builtin_amdgcn_s_sleep(1);
        if ((++sp & 255u) == 0u) { if (xb_ld(&bar[XB_TMO])) break; if (sp > XB_SPIN_CAP) { atomicAdd(&bar[XB_TMO], 1u); break; } }
    }
    nloc = mine > 0u ? mine : 1u; nx = cnt > 0u ? cnt : 1u;
}

__device__ __forceinline__ void xcd_barrier(const XcdBarrier& b) {
    asm volatile("s_waitcnt vmcnt(0)" ::: "memory");
    __syncthreads();
    if (threadIdx.x == 0) {
        unsigned* bar = b.bar;
        __builtin_amdgcn_s_waitcnt(0);
        unsigned nloc = b.st[0], nx = b.st[1];
        if (nloc == 0u) { xcd_barrier_complete(bar, b.x, nloc, nx); b.st[0] = nloc; b.st[1] = nx; }
        const unsigned old = xb_add(&bar[XB_XSUB(b.x)], 1u);
        const unsigned gen = old / nloc;
        if (old + 1u == (gen + 1u) * nloc) {
            __builtin_amdgcn_fence(__ATOMIC_RELEASE, "agent");
            asm volatile("s_waitcnt vmcnt(0)" ::: "memory");
            const unsigned og = xb_add(&bar[XB_TOP], 1u);
            const unsigned tg = og / nx;
            asm volatile("buffer_inv sc1" ::: "memory");
            if (og + 1u == (tg + 1u) * nx) xb_add(&bar[XB_TOPGEN], 1u);
            else XB_SPIN(xb_ld(&bar[XB_TOPGEN]) == tg, bar);
            asm volatile("s_waitcnt vmcnt(0)" ::: "memory");
            xb_add(&bar[XB_XGEN(b.x)], 1u);
            asm volatile("s_waitcnt vmcnt(0)" ::: "memory");
        } else {
            asm volatile("buffer_inv sc1" ::: "memory");
            XB_SPIN(xb_ld(&bar[XB_XGEN(b.x)]) == gen, bar);
            asm volatile("s_waitcnt vmcnt(0)" ::: "memory");
        }
        asm volatile("" ::: "memory");
    }
    __syncthreads();
}
struct Frame {
    LAS unsigned char* lds;
    volatile LAS unsigned* MISC;
    gu32* ctl;
    int tid, lane, wave;
    int vcu, G;
    const float* in[25]; float* out; unsigned char* ws;
};
#define WSP(T_, off) ((T_*)(F.ws + (off)))
enum { I_X = 0, I_GMIX, I_WIN, I_CONVW, I_CONVB, I_DTB, I_ALOG, I_DSKIP, I_GSSD, I_WSSD, I_GQL, I_WQUP, I_GKVL, I_WKVUP, I_GQKQ, I_GQKK, I_WMLA, I_WO, I_GFFN, I_WR, I_BR, I_WGU, I_BGU, I_WDN, I_BDN };

__device__ __forceinline__ void p0_transpose_item(const float* W, int K, int N, bf16* WT, int n0dst, const float* kscale, LAS float* scr, int kb, int nb, int lane, int pmode = 0) {
    const int k0 = 64 * kb, n0 = 32 * nb;
#pragma unroll
    for (int i = 0; i < 8; ++i) { const int kk = 8 * i + (lane >> 3), n = n0 + 4 * (lane & 7);
        f32x4 v = (n < N) ? *(const f32x4*)(W + (size_t)(k0 + kk) * N + n) : (f32x4){0.f, 0.f, 0.f, 0.f}; if (kscale) v = v * kscale[k0 + kk];
        LAS float* d = scr + kk * 33 + 4 * (lane & 7); d[0] = v[0]; d[1] = v[1]; d[2] = v[2]; d[3] = v[3]; }
    LDS_WAIT(); asm volatile("" ::: "memory");
    const int c = lane & 7;
#pragma unroll
    for (int j = 0; j < 4; ++j) { const int n = (lane >> 3) + 8 * j; const LAS float* s = scr + (8 * c) * 33 + n;
        v4u o; o.x = pk2(s[0 * 33], s[1 * 33]); o.y = pk2(s[2 * 33], s[3 * 33]); o.z = pk2(s[4 * 33], s[5 * 33]); o.w = pk2(s[6 * 33], s[7 * 33]);
        const int nd = pmode ? 8 * (n >> 2) + (n & 3) + (pmode == 2 ? 4 : 0) : n;
        *(v4u*)(WT + (size_t)(n0dst + nd) * K + k0 + 8 * c) = o; }
    LDS_WAIT(); asm volatile("" ::: "memory");
}
__device__ __forceinline__ void rms_row_to_bf16(int lane, const float* xrow, const float* gain, bf16* orow) {
    const f32x4* xr = (const f32x4*)xrow + lane; const f32x4* gr = (const f32x4*)gain + lane;
    f32x4 v[4]; float s = 0.f;
#pragma unroll
    for (int j = 0; j < 4; ++j) { v[j] = xr[64 * j]; s += (v[j].x * v[j].x + v[j].y * v[j].y) + (v[j].z * v[j].z + v[j].w * v[j].w); }
    const float r = rsqrtf(wave_sum(s) * (1.f / DM) + EPS);
    unsigned long long* o8 = (unsigned long long*)orow + lane;
#pragma unroll
    for (int j = 0; j < 4; ++j) { const f32x4 g = gr[64 * j]; o8[64 * j] = (unsigned long long)pk2(v[j].x * r * g.x, v[j].y * r * g.y) | ((unsigned long long)pk2(v[j].z * r * g.z, v[j].w * r * g.w) << 32); }
}
__device__ __forceinline__ unsigned pk4_fp8(float a, float b, float c, float d) { int w = __builtin_amdgcn_cvt_pk_fp8_f32(a, b, 0, false); w = __builtin_amdgcn_cvt_pk_fp8_f32(c, d, w, true); return (unsigned)w; }
__device__ __forceinline__ void p0_transpose_item_fp8(const float* W, int K, int N, unsigned char* WT, int n0dst, float scale, LAS float* scr, int kb, int nb, int lane) {
    const int k0 = 64 * kb, n0 = 32 * nb;
#pragma unroll
    for (int i = 0; i < 8; ++i) { const int kk = 8 * i + (lane >> 3), n = n0 + 4 * (lane & 7);
        const f32x4 v = *(const f32x4*)(W + (size_t)(k0 + kk) * N + n) * scale;
        LAS float* d = scr + kk * 33 + 4 * (lane & 7); d[0] = fminf(fmaxf(v[0], -448.f), 448.f); d[1] = fminf(fmaxf(v[1], -448.f), 448.f); d[2] = fminf(fmaxf(v[2], -448.f), 448.f); d[3] = fminf(fmaxf(v[3], -448.f), 448.f); }
    LDS_WAIT(); asm volatile("" ::: "memory");
    const int c = lane & 7;
#pragma unroll
    for (int j = 0; j < 4; ++j) { const int n = (lane >> 3) + 8 * j; const LAS float* s = scr + (8 * c) * 33 + n;
        v2u o; o.x = pk4_fp8(s[0 * 33], s[1 * 33], s[2 * 33], s[3 * 33]); o.y = pk4_fp8(s[4 * 33], s[5 * 33], s[6 * 33], s[7 * 33]);
        *(v2u*)(WT + (size_t)(n0dst + n) * K + k0 + 8 * c) = o; }
    LDS_WAIT(); asm volatile("" ::: "memory");
}
constexpr int P0_I_IN = 16 * 168, P0_I_Q = 6 * 48, P0_I_KV = 4 * 64, P0_I_SQ = 16 * 32, P0_I_GU1 = 16 * 64, P0_I_DN1 = 16 * 32;
constexpr int P0_NITEMS = P0_I_IN + P0_I_Q + P0_I_KV + 3 * P0_I_SQ + NE * P0_I_GU1 + NE * P0_I_DN1;
constexpr int P0_DEFER = 12288;
__device__ __forceinline__ void p0_item(Frame& F, int it, LAS float* scr) {
    int r = it;
    if (r < P0_I_IN) { p0_transpose_item(F.in[I_WIN], DM, IN_DIM, WSP(bf16, WS_WIN), 32 * (r % 168), nullptr, scr, r / 168, r % 168, F.lane); return; } r -= P0_I_IN;
    if (r < P0_I_Q) { const int nb = r % 48, c0 = 32 * nb, hd = c0 / QKD, d0 = c0 % QKD, pm = d0 < NOPE ? 0 : d0 == NOPE ? 1 : 2;
        p0_transpose_item(F.in[I_WQUP], QRANK, MLA_H * QKD, WSP(bf16, WS_WQ), pm ? hd * QKD + NOPE : c0, F.in[I_GQL], scr, r / 48, nb, F.lane, pm); return; } r -= P0_I_Q;
    if (r < P0_I_KV) { p0_transpose_item(F.in[I_WKVUP], KVRANK, MLA_H * 256, WSP(bf16, WS_WKV), 32 * (r % 64), F.in[I_GKVL], scr, r / 64, r % 64, F.lane); return; } r -= P0_I_KV;
    if (r < P0_I_SQ) { p0_transpose_item(F.in[I_WSSD], DM, DM, WSP(bf16, WS_WSSD), 32 * (r % 32), nullptr, scr, r / 32, r % 32, F.lane); return; } r -= P0_I_SQ;
    if (r < P0_I_SQ) { p0_transpose_item(F.in[I_WMLA], DM, DM, WSP(bf16, WS_WMLA), 32 * (r % 32), nullptr, scr, r / 32, r % 32, F.lane); return; } r -= P0_I_SQ;
    if (r < P0_I_SQ) { p0_transpose_item(F.in[I_WO], DM, DM, WSP(bf16, WS_WO), 32 * (r % 32), nullptr, scr, r / 32, r % 32, F.lane); return; } r -= P0_I_SQ;
    if (r < NE * P0_I_GU1) { const int e = r / P0_I_GU1, q = r % P0_I_GU1, kb = q / 64, nb = q % 64; const int n0 = 32 * nb, j = n0 & 1023;
        const int n0dst = (j >> 7) * 256 + (n0 >= 1024 ? 128 : 0) + (j & 127);
        p0_transpose_item_fp8(F.in[I_WGU] + (size_t)e * DM * 2 * FF, DM, 2 * FF, WSP(unsigned char, WS_WGU) + (size_t)e * 2 * FF * DM, n0dst, WGU_SCALE, scr, kb, nb, F.lane); return; } r -= NE * P0_I_GU1;
    { const int e = r / P0_I_DN1, q = r % P0_I_DN1; p0_transpose_item_fp8(F.in[I_WDN] + (size_t)e * FF * DM, FF, DM, WSP(unsigned char, WS_WDN) + (size_t)e * DM * FF, 32 * (q % 32), WGU_SCALE, scr, q / 32, q % 32, F.lane); }
}
__device__ __forceinline__ void p0_deferred(Frame& F, int nfull) {
    LAS float* scr = (LAS float*)(F.lds + RING_OFF + F.wave * 16384);
    const int c = (int)blockIdx.x, e = nfull ? c - nfull : c, E = nfull ? F.G - nfull : F.G;
    if (e < 0) return;
    for (int it = P0_NITEMS - P0_DEFER + e * NWAVES + F.wave; it < P0_NITEMS; it += E * NWAVES) p0_item(F, it, scr);
}
__device__ __forceinline__ void p0_prologue(Frame& F) {
    LAS float* scr = (LAS float*)(F.lds + RING_OFF + F.wave * 16384);
    const int gw = F.vcu * NWAVES + F.wave, NGW = F.G * NWAVES;
    for (int it = gw; it < P0_NITEMS - P0_DEFER; it += NGW) p0_item(F, it, scr);
    for (int m = gw; m < T; m += NGW) rms_row_to_bf16(F.lane, F.in[I_X] + (size_t)m * DM, F.in[I_GMIX], WSP(bf16, WS_XN) + (size_t)m * DM);
    if (F.vcu == 0 && F.wave == 0) { const int lane = F.lane;
        float a = 0.f, b = 0.f;
#pragma unroll
        for (int j = 0; j < 3; ++j) { a = fmaxf(a, fabsf(F.in[I_GQKQ][lane + 64 * j])); b = fmaxf(b, fabsf(F.in[I_GQKK][lane + 64 * j])); }
        a = wave_max(a); b = wave_max(b);
        if (lane == 0) *WSP(float, WS_SMAX) = 13.856406460551018f * 1.4426950408889634f * a * b * 1.03f + 0.25f; }
    { float* RT = WSP(float, WS_ROPE);
      for (int i = F.vcu * NTHR + F.tid; i < SEQ * 32; i += F.G * NTHR) { const int pos = i >> 5, j = i & 31; const float inv = exp2f(-(float)(2 * j) * (1.0f / 64.0f) * 13.287712379549449f);
          float sv, cv; sincosf((float)pos * inv, &sv, &cv); RT[pos * 64 + j] = cv; RT[pos * 64 + 32 + j] = sv; } }
}

struct PrepIn { v4u ql, kl, kr; f32x4 c0, c1, s0, s1; v4u qv[4], kv[4], vv[4]; };
__device__ __forceinline__ void p3_mla_prep(Frame& F) {
    const int gw = F.vcu * NWAVES + F.wave, NGW = F.G * NWAVES, l = F.lane, hl = l & 31, half = l >> 5;
    const bf16* PROJ = WSP(bf16, WS_PROJ); const bf16* QPRE = WSP(bf16, WS_QPRE); const bf16* KVPRE = WSP(bf16, WS_KVPRE); const float* RT = WSP(float, WS_ROPE);
    bf16* Qo = WSP(bf16, WS_Q); bf16* Ko = WSP(bf16, WS_K); bf16* Vo = WSP(bf16, WS_V);
    const bool act = hl < 24, isrope = hl >= 16 && hl < 24, isx2 = hl >= 20;
    const int hlc = act ? hl : 0, jr = 8 * ((hl - 16) & 3);
    float gq[8], gk[8];
#pragma unroll
    for (int e = 0; e < 8; ++e) { gq[e] = act ? F.in[I_GQKQ][8 * hl + e] : 0.f; gk[e] = act ? F.in[I_GQKK][8 * hl + e] : 0.f; }
#define PREP_LOAD(P, tk_) do { const int s_ = (tk_) % SEQ; const bf16* prow = PROJ + (size_t)(tk_) * IN_PAD; \
        P.ql = *(const v4u*)(prow + OFF_QLAT + 8 * (l < 48 ? l : 0)); P.kl = *(const v4u*)(prow + OFF_KVLAT + 8 * (l & 31)); P.kr = *(const v4u*)(prow + OFF_KROPE + 8 * ((hl - 16) & 7)); \
        P.c0 = *(const f32x4*)(RT + s_ * 64 + jr); P.c1 = *(const f32x4*)(RT + s_ * 64 + jr + 4); P.s0 = *(const f32x4*)(RT + s_ * 64 + 32 + jr); P.s1 = *(const f32x4*)(RT + s_ * 64 + 32 + jr + 4); \
        _Pragma("unroll") for (int hp = 0; hp < 4; ++hp) { const int h = 2 * hp + half; \
            P.qv[hp] = *(const v4u*)(QPRE + (size_t)(tk_) * (MLA_H * QKD) + h * QKD + 8 * hlc); \
            P.kv[hp] = *(const v4u*)(KVPRE + (size_t)(tk_) * (MLA_H * 256) + h * 256 + 8 * (hl & 15)); \
            P.vv[hp] = *(const v4u*)(KVPRE + (size_t)(tk_) * (MLA_H * 256) + h * 256 + 128 + 8 * (hl & 15)); } } while (0)
    auto proc = [&](const PrepIn& P, int tk) {
        const int b = tk / SEQ, s = tk % SEQ;
        float v[8]; float ss = 0.f;
        unpack8(P.ql, v);
        if (l < 48) {
#pragma unroll
            for (int e = 0; e < 8; ++e) ss += v[e] * v[e]; }
        const float rq = rsqrtf(wave_sum(ss) * (1.f / QRANK) + EPS);
        ss = 0.f; unpack8(P.kl, v);
        if (l < 32) {
#pragma unroll
            for (int e = 0; e < 8; ++e) ss += v[e] * v[e]; }
        const float rkv = rsqrtf(wave_sum(ss) * (1.f / KVRANK) + EPS);
        const float cs[8] = {P.c0[0], P.c0[1], P.c0[2], P.c0[3], P.c1[0], P.c1[1], P.c1[2], P.c1[3]}, sn[8] = {P.s0[0], P.s0[1], P.s0[2], P.s0[3], P.s1[0], P.s1[1], P.s1[2], P.s1[3]};
        float krp[8]; unpack8(P.kr, krp);
#pragma unroll
        for (int hp = 0; hp < 4; ++hp) {
            const int h = 2 * hp + half;
            { float q[8]; unpack8(P.qv[hp], q);
#pragma unroll
              for (int e = 0; e < 8; ++e) q[e] = act ? q[e] * rq : 0.f;
              float s2 = 0.f;
#pragma unroll
              for (int e = 0; e < 8; ++e) s2 += q[e] * q[e];
#pragma unroll
              for (int o = 1; o < 32; o <<= 1) s2 += __shfl_xor(s2, o);
              const float rs = rsqrtf(s2 * (1.f / QKD) + EPS);
#pragma unroll
              for (int e = 0; e < 8; ++e) { q[e] = q[e] * rs * gq[e]; const float p = __shfl_xor(q[e], 4);
                  if (isrope) q[e] = isx2 ? (q[e] * cs[e] + p * sn[e]) : (q[e] * cs[e] - p * sn[e]);
                  q[e] *= QSCALE; }
              if (act) *(v4u*)(Qo + ((size_t)(b * MLA_H + h) * SEQ + s) * QKD + 8 * hl) = pack8(q); }
            { float k[8]; unpack8(P.kv[hp], k);
#pragma unroll
              for (int e = 0; e < 8; ++e) k[e] = (hl < 16) ? k[e] * rkv : (isrope ? krp[e] : 0.f);
              float s2 = 0.f;
#pragma unroll
              for (int e = 0; e < 8; ++e) s2 += k[e] * k[e];
#pragma unroll
              for (int o = 1; o < 32; o <<= 1) s2 += __shfl_xor(s2, o);
              const float rs = rsqrtf(s2 * (1.f / QKD) + EPS);
#pragma unroll
              for (int e = 0; e < 8; ++e) { k[e] = k[e] * rs * gk[e]; const float p = __shfl_xor(k[e], 4);
                  if (isrope) k[e] = isx2 ? (k[e] * cs[e] + p * sn[e]) : (k[e] * cs[e] - p * sn[e]); }
              if (act) *(v4u*)(Ko + ((size_t)(b * MLA_H + h) * SEQ + s) * QKD + 8 * hl) = pack8(k); }
            if (hl < 16) { float w[8]; unpack8(P.vv[hp], w);
#pragma unroll
                for (int e = 0; e < 8; ++e) w[e] *= rkv;
                *(v4u*)(Vo + ((size_t)(b * MLA_H + h) * SEQ + s) * VD + 8 * hl) = pack8(w); }
        }
    };
    int tk = gw; if (tk >= T) return;
    PrepIn A, B;
    PREP_LOAD(A, tk);
#pragma unroll 1
    for (;;) {
        const int t1 = tk + NGW; const bool h1 = t1 < T;
        PREP_LOAD(B, (h1 ? t1 : tk)); asm volatile("" : "+v"(A.ql.x), "+v"(A.kl.x) :: "memory");
        proc(A, tk);
        if (!h1) break;
        const int t2 = t1 + NGW; const bool h2 = t2 < T;
        PREP_LOAD(A, (h2 ? t2 : t1)); asm volatile("" : "+v"(B.ql.x), "+v"(B.kl.x) :: "memory");
        proc(B, t1);
        if (!h2) break;
        tk = t2;
    }
#undef PREP_LOAD
}

__device__ __forceinline__ void p4_attn_naive(Frame& F) {
    LAS float* qs = (LAS float*)(F.lds);
    LAS bf16* ks = (LAS bf16*)(F.lds + 49152);
    LAS bf16* vs = (LAS bf16*)(F.lds + 49152 + 25600);
    LAS float* ps = (LAS float*)(F.lds + 49152 + 25600 + 16384) + F.wave * 512;
    const bf16* Q = WSP(bf16, WS_Q); const bf16* K = WSP(bf16, WS_K); const bf16* V = WSP(bf16, WS_V); bf16* O = WSP(bf16, WS_OATT);
    const int tid = F.tid, lane = F.lane, w = F.wave;
    const int NIT = BATCH * MLA_H * NCHUNK;
    for (int it0 = 0; it0 < NIT; it0 += F.G) {
        const int it = it0 + (int)blockIdx.x; if (it >= NIT) break;
        const int rnd = it / 256, j = it % 256;
        const int bh = 2 * rnd + (j >> 7), c = (rnd & 1) ? (127 - (j & 127)) : (j & 127);
        const bf16* Qh = Q + ((size_t)bh * SEQ + (size_t)c * 64) * QKD; const bf16* Kh = K + (size_t)bh * SEQ * QKD; const bf16* Vh = V + (size_t)bh * SEQ * VD;
        __syncthreads();
        for (int i = tid; i < 64 * 24; i += NTHR) { float v[8]; unpack8(*(const v4u*)(Qh + (size_t)i * 8), v); const int r = i / 24, d = (i % 24) * 8;
#pragma unroll
            for (int e = 0; e < 8; ++e) qs[r * 192 + d + e] = v[e]; }
        float m[8], lsum[8], o0[8], o1[8];
#pragma unroll
        for (int r = 0; r < 8; ++r) { m[r] = -1e30f; lsum[r] = 0.f; o0[r] = 0.f; o1[r] = 0.f; }
        for (int kt = 0; kt <= c; ++kt) {
            __syncthreads();
            for (int i = tid; i < 64 * 24; i += NTHR) { const int r = i / 24, d = (i % 24) * 8; *(LAS v4u*)(ks + r * 200 + d) = *(const v4u*)(Kh + ((size_t)kt * 64 + r) * QKD + d); }
            for (int i = tid; i < 64 * 16; i += NTHR) { const int r = i / 16, d = (i % 16) * 8; *(LAS v4u*)(vs + r * 128 + d) = *(const v4u*)(Vh + ((size_t)kt * 64 + r) * VD + d); }
            __syncthreads();
            float sc[8];
#pragma unroll
            for (int r = 0; r < 8; ++r) sc[r] = 0.f;
#pragma unroll 2
            for (int d = 0; d < 192; d += 8) { float kv[8]; unpack8(*(const LAS v4u*)(ks + lane * 200 + d), kv);
#pragma unroll
                for (int r = 0; r < 8; ++r) { const f32x4 qa = *(const LAS f32x4*)(qs + (8 * w + r) * 192 + d), qb = *(const LAS f32x4*)(qs + (8 * w + r) * 192 + d + 4);
                    sc[r] += qa[0] * kv[0] + qa[1] * kv[1] + qa[2] * kv[2] + qa[3] * kv[3] + qb[0] * kv[4] + qb[1] * kv[5] + qb[2] * kv[6] + qb[3] * kv[7]; } }
#pragma unroll
            for (int r = 0; r < 8; ++r) { const float tm = wave_max(sc[r]); const float mn = fmaxf(m[r], tm); const float al = exp2f(m[r] - mn); const float p = exp2f(sc[r] - mn);
                lsum[r] = lsum[r] * al + wave_sum(p); o0[r] *= al; o1[r] *= al; m[r] = mn; sc[r] = p; }
            *(LAS f32x4*)(ps + lane * 8) = (f32x4){sc[0], sc[1], sc[2], sc[3]}; *(LAS f32x4*)(ps + lane * 8 + 4) = (f32x4){sc[4], sc[5], sc[6], sc[7]};
            LDS_WAIT(); asm volatile("" ::: "memory");
#pragma unroll 4
            for (int k = 0; k < 64; ++k) { const unsigned vv = *(const LAS unsigned*)(vs + k * 128 + 2 * lane); const float v0 = blo(vv), v1 = bhi(vv);
                const f32x4 pa = *(const LAS f32x4*)(ps + k * 8), pb = *(const LAS f32x4*)(ps + k * 8 + 4);
                o0[0] += pa[0] * v0; o1[0] += pa[0] * v1; o0[1] += pa[1] * v0; o1[1] += pa[1] * v1; o0[2] += pa[2] * v0; o1[2] += pa[2] * v1; o0[3] += pa[3] * v0; o1[3] += pa[3] * v1;
                o0[4] += pb[0] * v0; o1[4] += pb[0] * v1; o0[5] += pb[1] * v0; o1[5] += pb[1] * v1; o0[6] += pb[2] * v0; o1[6] += pb[2] * v1; o0[7] += pb[3] * v0; o1[7] += pb[3] * v1; }
            LDS_WAIT(); asm volatile("" ::: "memory");
        }
        const int b = bh / MLA_H, h = bh % MLA_H;
#pragma unroll
        for (int r = 0; r < 8; ++r) { const float il = 1.0f / lsum[r];
            *(unsigned*)(O + ((size_t)b * SEQ + (size_t)c * 64 + 8 * w + r) * DM + h * VD + 2 * lane) = pk2(o0[r] * il, o1[r] * il); }
    }
}

namespace attn {
typedef float f32x16 __attribute__((ext_vector_type(16)));
typedef short s16x4 __attribute__((ext_vector_type(4)));
constexpr int NW = 8, QBLK = 32, KVBLK = 64, QB = NW * QBLK, DQ = 192, DV = 128, KROW = DQ * 2;
constexpr int SHM_V = KVBLK * DV * 2, SHM_K = KVBLK * DQ * 2;
constexpr int NVB = 3;
constexpr int LDS_BYTES = NVB * SHM_V + 2 * SHM_K + NW * 64 * 4;
constexpr float THR = 8.f;
#define KSWZ(row, colB) ((row) * KROW + ((colB) ^ ((((row) >> 1) & 7) << 4)))
#define SBAR() __builtin_amdgcn_sched_barrier(0)
__device__ __forceinline__ int v_st(int k, int c) { const int kk = (k & ~0xC) | ((k & 4) << 1) | ((k & 8) >> 1); return ((kk >> 3) * 4 + (c >> 5)) * 512 + ((kk & 7) * 32 + (c & 31)) * 2; }
__device__ __forceinline__ int v_rd_base(int lane) { return ((lane & 3) << 3) | (((lane >> 2) & 3) << 6) | (((lane >> 4) & 1) << 5) | (((lane >> 5) & 1) << 8); }
constexpr int v_rd_off(int d0, int ks, int half) { return d0 * 512 + ks * 4096 + half * 2048; }
__device__ __forceinline__ int crow(int r, int hi) { return (r & 3) + 8 * (r >> 2) + 4 * hi; }
__device__ __forceinline__ unsigned cvtpk(float lo, float hi) { unsigned r; asm volatile("v_cvt_pk_bf16_f32 %0, %1, %2" : "=v"(r) : "v"(lo), "v"(hi)); return r; }
__device__ __forceinline__ void partialSM(f32x16& p0, f32x16& p1, float& m_reg, float& mn, float& alpha) {
    float pmax = p0[0];
#pragma unroll
    for (int r = 1; r < 16; ++r) pmax = fmaxf(pmax, p0[r]);
#pragma unroll
    for (int r = 0; r < 16; ++r) pmax = fmaxf(pmax, p1[r]);
    { auto rr = __builtin_amdgcn_permlane32_swap(__float_as_uint(pmax), __float_as_uint(pmax), false, false);
      pmax = fmaxf(__uint_as_float(rr[0]), __uint_as_float(rr[1])); }
    if (__builtin_expect(__all(pmax - m_reg <= THR), 1)) { mn = m_reg; alpha = 1.f; }
    else { mn = fmaxf(m_reg, pmax); alpha = __builtin_amdgcn_exp2f(m_reg - mn); m_reg = mn; }
#pragma unroll
    for (int r = 0; r < 16; ++r) { p0[r] -= mn; p1[r] -= mn; }
#pragma unroll
    for (int r = 0; r < 16; ++r) p0[r] = __builtin_amdgcn_exp2f(p0[r]);
}
__device__ __forceinline__ void finishSM(f32x16& p0, f32x16& p1, float alpha, float& l_reg, bf16x8& pa0, bf16x8& pa1, bf16x8& pa2, bf16x8& pa3) {
#pragma unroll
    for (int r = 0; r < 16; ++r) p1[r] = __builtin_amdgcn_exp2f(p1[r]);
    float ps = 0;
#pragma unroll
    for (int r = 0; r < 16; ++r) ps += p0[r];
#pragma unroll
    for (int r = 0; r < 16; ++r) ps += p1[r];
    { auto rr = __builtin_amdgcn_permlane32_swap(__float_as_uint(ps), __float_as_uint(ps), false, false);
      ps = __uint_as_float(rr[0]) + __uint_as_float(rr[1]); }
    l_reg = l_reg * alpha + ps;
#define PK4(P, B_, OUT) do { unsigned a0 = cvtpk(P[B_+0], P[B_+1]), a1 = cvtpk(P[B_+2], P[B_+3]);                          \
        unsigned b0 = cvtpk(P[B_+4], P[B_+5]), b1 = cvtpk(P[B_+6], P[B_+7]);                                             \
        auto r0 = __builtin_amdgcn_permlane32_swap(a0, b0, false, false); auto r1 = __builtin_amdgcn_permlane32_swap(a1, b1, false, false); \
        v4u w = {r0[0], r1[0], r0[1], r1[1]}; OUT = *reinterpret_cast<bf16x8*>(&w); } while (0)
    PK4(p0, 0, pa0); PK4(p0, 8, pa1); PK4(p1, 0, pa2); PK4(p1, 8, pa3);
#undef PK4
}
__device__ __forceinline__ void partialSMf(f32x16& p0, f32x16& p1, float C) {
    if (__builtin_amdgcn_readfirstlane(__float_as_int(C)) != 0) {
#pragma unroll
        for (int r = 0; r < 16; ++r) { p0[r] -= C; p1[r] -= C; } }
#pragma unroll
    for (int r = 0; r < 16; ++r) p0[r] = __builtin_amdgcn_exp2f(p0[r]);
}
__device__ __forceinline__ void finishSMf(f32x16& p0, f32x16& p1, float& l_reg, bf16x8& pa0, bf16x8& pa1, bf16x8& pa2, bf16x8& pa3) {
#pragma unroll
    for (int r = 0; r < 16; ++r) p1[r] = __builtin_amdgcn_exp2f(p1[r]);
    float ps = 0;
#pragma unroll
    for (int r = 0; r < 16; ++r) ps += p0[r];
#pragma unroll
    for (int r = 0; r < 16; ++r) ps += p1[r];
    { auto rr = __builtin_amdgcn_permlane32_swap(__float_as_uint(ps), __float_as_uint(ps), false, false);
      ps = __uint_as_float(rr[0]) + __uint_as_float(rr[1]); }
    l_reg += ps;
#define PK4(P, B_, OUT) do { unsigned a0 = cvtpk(P[B_+0], P[B_+1]), a1 = cvtpk(P[B_+2], P[B_+3]);                          \
        unsigned b0 = cvtpk(P[B_+4], P[B_+5]), b1 = cvtpk(P[B_+6], P[B_+7]);                                             \
        auto r0 = __builtin_amdgcn_permlane32_swap(a0, b0, false, false); auto r1 = __builtin_amdgcn_permlane32_swap(a1, b1, false, false); \
        v4u w = {r0[0], r1[0], r0[1], r1[1]}; OUT = *reinterpret_cast<bf16x8*>(&w); } while (0)
    PK4(p0, 0, pa0); PK4(p0, 8, pa1); PK4(p1, 0, pa2); PK4(p1, 8, pa3);
#undef PK4
}
template <int KB>
__device__ __forceinline__ void qkt(f32x16& p0, f32x16& p1, const char* K_lds, int lane_in, const bf16x8* qr, bool act) {
    int l_ = lane_in; asm volatile("" : "+v"(l_)); const int r32 = l_ & 31, hi = l_ >> 5;
    if (!act) { const float NEG = -__builtin_inff();
#pragma unroll
        for (int r = 0; r < 16; ++r) { p0[r] = NEG; p1[r] = NEG; } return; }
    const char* kb[4];
    __builtin_amdgcn_s_setprio(1);
#pragma unroll
    for (int dd = 0; dd < 4; ++dd) kb[dd] = K_lds + KB * SHM_K + KSWZ(r32, (dd * 16 + hi * 8) * 2);
    { const f32x16 z = f32x16{};
      const bf16x8 b0 = *reinterpret_cast<const bf16x8*>(kb[0]), b1 = *reinterpret_cast<const bf16x8*>(kb[0] + 32 * KROW);
      p0 = __builtin_amdgcn_mfma_f32_32x32x16_bf16(b0, qr[0], z, 0, 0, 0); p1 = __builtin_amdgcn_mfma_f32_32x32x16_bf16(b1, qr[0], z, 0, 0, 0); }
#pragma unroll
    for (int d0 = 1; d0 < 12; ++d0) { const char* a = kb[d0 & 3] + (d0 >> 2) * 128;
        bf16x8 b0 = *reinterpret_cast<const bf16x8*>(a);
        bf16x8 b1 = *reinterpret_cast<const bf16x8*>(a + 32 * KROW);
        p0 = __builtin_amdgcn_mfma_f32_32x32x16_bf16(b0, qr[d0], p0, 0, 0, 0);
        p1 = __builtin_amdgcn_mfma_f32_32x32x16_bf16(b1, qr[d0], p1, 0, 0, 0); }
    __builtin_amdgcn_s_setprio(0);
    __builtin_amdgcn_sched_group_barrier(0x100, 8, 0);
#pragma unroll
    for (int i = 0; i < 8; ++i) { __builtin_amdgcn_sched_group_barrier(0x8, 2, 0); __builtin_amdgcn_sched_group_barrier(0x100, 2, 0); }
    __builtin_amdgcn_sched_group_barrier(0x8, 8, 0);
}
__device__ __forceinline__ void pv_tile(f32x16* o, int vb0, bf16x8 pa0, bf16x8 pa1, bf16x8 pa2, bf16x8 pa3, bool act) {
    if (!act) return;
#define TRRD(dst, off) asm volatile("ds_read_b64_tr_b16 %0, %1 offset:%2" : "=&v"(dst) : "v"(vb0), "i"(off) : "memory")
#define PV_RD(S_, d0) do { constexpr int b_ = v_rd_off(d0, 0, 0); TRRD(S_##l0, b_); TRRD(S_##h0, b_ + 2048); TRRD(S_##l1, b_ + 4096); TRRD(S_##h1, b_ + 6144); TRRD(S_##l2, b_ + 8192); TRRD(S_##h2, b_ + 10240); TRRD(S_##l3, b_ + 12288); TRRD(S_##h3, b_ + 14336); } while (0)
#define PV_MM(S_, d0) do { \
        o[d0] = __builtin_amdgcn_mfma_f32_32x32x16_bf16(pa0, (bf16x8){S_##l0[0], S_##l0[1], S_##l0[2], S_##l0[3], S_##h0[0], S_##h0[1], S_##h0[2], S_##h0[3]}, o[d0], 0, 0, 0);   \
        o[d0] = __builtin_amdgcn_mfma_f32_32x32x16_bf16(pa1, (bf16x8){S_##l1[0], S_##l1[1], S_##l1[2], S_##l1[3], S_##h1[0], S_##h1[1], S_##h1[2], S_##h1[3]}, o[d0], 0, 0, 0);   \
        o[d0] = __builtin_amdgcn_mfma_f32_32x32x16_bf16(pa2, (bf16x8){S_##l2[0], S_##l2[1], S_##l2[2], S_##l2[3], S_##h2[0], S_##h2[1], S_##h2[2], S_##h2[3]}, o[d0], 0, 0, 0);   \
        o[d0] = __builtin_amdgcn_mfma_f32_32x32x16_bf16(pa3, (bf16x8){S_##l3[0], S_##l3[1], S_##l3[2], S_##l3[3], S_##h3[0], S_##h3[1], S_##h3[2], S_##h3[3]}, o[d0], 0, 0, 0); } while (0)
#define PV_WAIT(n) do { asm volatile("s_waitcnt lgkmcnt(" #n ")" ::: "memory"); SBAR(); } while (0)
    s16x4 Al0, Al1, Al2, Al3, Ah0, Ah1, Ah2, Ah3, Bl0, Bl1, Bl2, Bl3, Bh0, Bh1, Bh2, Bh3;
    PV_RD(A, 0); PV_RD(B, 1); PV_WAIT(8); PV_MM(A, 0); SBAR();
    PV_RD(A, 2); PV_WAIT(8); PV_MM(B, 1); SBAR();
    PV_RD(B, 3); PV_WAIT(8); PV_MM(A, 2); SBAR();
    PV_WAIT(0); PV_MM(B, 3);
#undef PV_RD
#undef PV_MM
#undef PV_WAIT
#undef TRRD
}
struct BlockRef { const bf16* Q; const bf16* K; const bf16* V; bf16* O; int qb; const float* ssq; const float* rq; float smax; };
struct Seam { bf16x8 qr[12]; bf16x8 st_v0, st_v1, st_k0, st_k1, st_k2; };
#define VMW() asm volatile("s_waitcnt vmcnt(0)" ::: "memory")
#define VMWN(n) asm volatile("s_waitcnt vmcnt(%0)" :: "i"(n) : "memory")
#define SLOAD_H(Kp, Vp, t) do { const __amdgpu_buffer_rsrc_t rk_ = __builtin_amdgcn_make_buffer_rsrc((void*)(Kp), 0, SEQ * DQ * 2, 0x00020000), rv_ = __builtin_amdgcn_make_buffer_rsrc((void*)(Vp), 0, SEQ * DV * 2, 0x00020000); \
        int t16_ = tid * 16; asm volatile("" : "+v"(t16_)); const int sk_ = (t) * SHM_K, sv_ = (t) * SHM_V;     \
        S.st_v0 = __builtin_bit_cast(bf16x8, __builtin_amdgcn_raw_buffer_load_b128(rv_, t16_, sv_, 0)); S.st_v1 = __builtin_bit_cast(bf16x8, __builtin_amdgcn_raw_buffer_load_b128(rv_, t16_, sv_ + 8192, 0)); \
        S.st_k0 = __builtin_bit_cast(bf16x8, __builtin_amdgcn_raw_buffer_load_b128(rk_, t16_, sk_, 0)); S.st_k1 = __builtin_bit_cast(bf16x8, __builtin_amdgcn_raw_buffer_load_b128(rk_, t16_, sk_ + 8192, 0)); \
        S.st_k2 = __builtin_bit_cast(bf16x8, __builtin_amdgcn_raw_buffer_load_b128(rk_, t16_, sk_ + 16384, 0)); } while (0)
#define SWRITE_HK(bf) do { int t_ = tid; asm volatile("" : "+v"(t_)); const int c0_ = t_, c1_ = t_ + 512, c2_ = t_ + 1024; char* kb_ = K_lds + (bf) * SHM_K;     \
        *(bf16x8*)(kb_ + KSWZ(c0_ / 24, (c0_ % 24) * 16)) = S.st_k0; *(bf16x8*)(kb_ + KSWZ(c1_ / 24, (c1_ % 24) * 16)) = S.st_k1; *(bf16x8*)(kb_ + KSWZ(c2_ / 24, (c2_ % 24) * 16)) = S.st_k2; } while (0)
#define SWRITE_HV(bf) do { int t_ = tid; asm volatile("" : "+v"(t_)); char* vb_ = V_lds + (bf) * SHM_V + v_st(t_ >> 4, (t_ & 15) * 8); *(bf16x8*)vb_ = S.st_v0; *(bf16x8*)(vb_ + 8192) = S.st_v1; } while (0)
#define SWRITE_H(bf) do { SWRITE_HV(bf); SWRITE_HK(bf); } while (0)
#define QLOAD(ref) do { _Pragma("unroll") for (int d0 = 0; d0 < 12; ++d0) S.qr[d0] = *(const bf16x8*)((ref).Q + (size_t)(wid * QBLK + r32) * DQ + d0 * 16 + hi * 8); } while (0)
#define KW_SETUP()
__device__ __forceinline__ int vbase_of(char* V_lds, int lane) { int l_ = lane; asm volatile("" : "+v"(l_)); return (int)(uintptr_t)V_lds + v_rd_base(l_); }
__device__ __forceinline__ void prime(const BlockRef& cur, char* lds, Seam& S) {
    const int tid = threadIdx.x, wid = __builtin_amdgcn_readfirstlane(tid >> 6), lane = tid & 63, r32 = lane & 31, hi = lane >> 5;
    char* K_lds = lds + NVB * SHM_V;
    QLOAD(cur);
    SLOAD_H(cur.K, cur.V, 0); VMW(); SWRITE_HK(0);
    __syncthreads();
}
__device__ __forceinline__ void block(const BlockRef& cur, const BlockRef& nxt, char* lds, Seam& S) {
    int tid = threadIdx.x; asm volatile("" : "+v"(tid));
    const int wid = __builtin_amdgcn_readfirstlane(tid >> 6), lane = tid & 63, r32 = lane & 31, hi = lane >> 5;
    const int NT = 4 * cur.qb + 4;
    const int tmax = 4 * cur.qb + (wid >> 1);
    char* V_lds = lds; char* K_lds = lds + NVB * SHM_V;
    float* ws = (float*)(lds + NVB * SHM_V + 2 * SHM_K) + wid * 64; float* li_l = ws, * al_l = ws + 32;
    float m_reg = -1e30f, l_reg = 0; f32x16 o[4] = {};
    const bf16* Kh = cur.K; const bf16* Vh = cur.V;
#define RESC(a) do { if (__any((a) < 1.f)) { int l_ = lane; asm volatile("" : "+v"(l_)); const int r32_ = l_ & 31, hi_ = l_ >> 5; if (hi_ == 0) al_l[r32_] = (a); asm volatile("s_waitcnt lgkmcnt(0)" ::: "memory");              \
                     _Pragma("unroll") for (int d_ = 0; d_ < 4; ++d_) _Pragma("unroll") for (int r = 0; r < 16; ++r) o[d_][r] *= al_l[crow(r, hi_)]; } } while (0)
#define ACT(t) ((t) <= tmax)
    f32x16 pA0, pA1, pB0, pB1; float mnA, mnB, alA, alB; bf16x8 pa0, pa1, pa2, pa3;
    SWRITE_HV(0); SBAR();
    SLOAD_H(Kh, Vh, 1);
    SBAR(); qkt<0>(pA0, pA1, K_lds, lane, S.qr, true);
    partialSM(pA0, pA1, m_reg, mnA, alA);
    VMW(); SWRITE_H(1);
    __syncthreads();
    int vr = 0, vw = 2;
#define VROT(x) ((x) == NVB - 1 ? 0 : (x) + 1)
#define HALF_STEP(PX0, PX1, mnX, alX, PY0, PY1, alY, t, KB, SB) do {                                                          \
        SBAR(); if ((t) + 1 < NT) { SLOAD_H(Kh, Vh, (t) + 1); SBAR(); }                 \
        qkt<KB>(PX0, PX1, K_lds, lane, S.qr, ACT(t));                                                                     \
        finishSM(PY0, PY1, alY, l_reg, pa0, pa1, pa2, pa3); SBAR();                                                           \
        pv_tile(o, vbase_of(V_lds, lane) + vr * SHM_V, pa0, pa1, pa2, pa3, ACT((t) - 1));                                                       \
        if ((t) + 1 < NT) { VMW(); SWRITE_HK(SB); SWRITE_HV(vw); SBAR(); }                                                   \
        partialSM(PX0, PX1, m_reg, mnX, alX);                                                                                 \
        RESC(alX); vr = VROT(vr); vw = VROT(vw); __syncthreads(); } while (0)
    for (int t = 1; t + 1 < NT; t += 2) {
        HALF_STEP(pB0, pB1, mnB, alB, pA0, pA1, alA, t, 1, 0);
        HALF_STEP(pA0, pA1, mnA, alA, pB0, pB1, alB, t + 1, 0, 1);
    }
    SBAR(); qkt<1>(pB0, pB1, K_lds, lane, S.qr, ACT(NT - 1)); SBAR();
    SLOAD_H(nxt.K, nxt.V, 0); SBAR();
    QLOAD(nxt);
    SBAR();
    finishSM(pA0, pA1, alA, l_reg, pa0, pa1, pa2, pa3); SBAR();
    pv_tile(o, vbase_of(V_lds, lane) + vr * SHM_V, pa0, pa1, pa2, pa3, ACT(NT - 2));
    partialSM(pB0, pB1, m_reg, mnB, alB); __syncthreads(); RESC(alB);
    finishSM(pB0, pB1, alB, l_reg, pa0, pa1, pa2, pa3); SBAR(); pv_tile(o, vbase_of(V_lds, lane) + VROT(vr) * SHM_V, pa0, pa1, pa2, pa3, ACT(NT - 1));
    SBAR(); VMWN(12); SWRITE_HK(0); SBAR();
    { int le = lane; asm volatile("" : "+v"(le)); const int r32e = le & 31, hie = le >> 5;
      if (hie == 0) li_l[r32e] = l_reg; asm volatile("s_waitcnt lgkmcnt(0)" ::: "memory");
      float rli[16];
#pragma unroll
      for (int r = 0; r < 16; ++r) rli[r] = __builtin_amdgcn_rcpf(li_l[crow(r, hie)]);
      bf16* Ow = cur.O + (size_t)(wid * QBLK) * DM;
#pragma unroll
      for (int r = 0; r < 16; ++r) { const int orow = crow(r, hie);
#pragma unroll
          for (int d0 = 0; d0 < 4; ++d0) { const float v = o[d0][r] * rli[r]; const float vn = __shfl_xor(v, 1);
              if ((r32e & 1) == 0) *(unsigned*)(Ow + (size_t)orow * DM + d0 * 32 + r32e) = cvtpk(v, vn); } } }
    __syncthreads();
#undef RESC
#undef ACT
#undef HALF_STEP
#undef VROT
}
#undef VMW
#undef VMWN
#undef SLOAD_H
#undef SWRITE_HK
#undef SWRITE_HV
#undef SWRITE_H
#undef QLOAD
#undef KW_SETUP
#undef KSWZ
#undef SBAR
}
__device__ __forceinline__ attn::BlockRef attn_ref(Frame& F, int bh, int qb) {
    attn::BlockRef r; const int b = bh / MLA_H, h = bh % MLA_H;
    r.Q = WSP(bf16, WS_Q) + ((size_t)bh * SEQ + (size_t)qb * 256) * QKD; r.K = WSP(bf16, WS_K) + (size_t)bh * SEQ * QKD; r.V = WSP(bf16, WS_V) + (size_t)bh * SEQ * VD;
    r.O = WSP(bf16, WS_OATT) + ((size_t)b * SEQ + (size_t)qb * 256) * DM + h * VD; r.qb = qb;
    r.ssq = WSP(float, WS_SSQ) + ((size_t)b * SEQ + (size_t)qb * 256) * 48 + 6 * h; r.rq = WSP(float, WS_RQ) + (size_t)b * SEQ + (size_t)qb * 256; r.smax = *WSP(float, WS_SMAX); return r;
}
__device__ __forceinline__ void p4_attn_mfma(Frame& F) {
    char* lds = (char*)(F.lds + RING_OFF);
    constexpr int NITEM = BATCH * MLA_H * 16;
    attn::Seam S;
    int it = F.vcu; if (it >= NITEM) return;
    int pass = 0;
    attn::BlockRef cur = attn_ref(F, it / 16, it % 16);
    __syncthreads();
    attn::prime(cur, lds, S);
    for (;;) {
        const bool more_pass = pass == 0, more_item = it + F.G < NITEM, last = !more_pass && !more_item;
        int itn = it, passn = pass + 1; if (!more_pass) { passn = 0; itn = more_item ? it + F.G : it; }
        const attn::BlockRef nxt = last ? cur : attn_ref(F, itn / 16, passn ? 31 - (itn % 16) : itn % 16);
        attn::block(cur, nxt, lds, S);
        if (last) break;
        cur = nxt; it = itn; pass = passn;
    }
}
namespace attn3 {
using namespace attn;
constexpr int NKB = 3, NVB3 = 3;
constexpr int LDS_BYTES3 = NVB3 * SHM_V + NKB * SHM_K + NW * 64 * 4;
#define KSWZ3(row, colB) ((row) * KROW + ((colB) ^ ((((row) >> 1) & 7) << 4)))
#define SBAR3() __builtin_amdgcn_sched_barrier(0)
typedef __attribute__((address_space(3))) unsigned las_u32;
__device__ __forceinline__ void qkt_rt3k(f32x16& p0, f32x16& p1, const char* Kb, const int (&kso)[4], const bf16x8* qr, bool act);
__device__ __forceinline__ void qkt_rt3(f32x16& p0, f32x16& p1, const char* Kb, int lane_in, const bf16x8* qr, bool act) {
    int l_ = lane_in; asm volatile("" : "+v"(l_)); const int r32 = l_ & 31, hi = l_ >> 5;
    if (!act) { const float NEG = -__builtin_inff();
#pragma unroll
        for (int r = 0; r < 16; ++r) { p0[r] = NEG; p1[r] = NEG; } return; }
    const char* kb[4];
#pragma unroll
    for (int dd = 0; dd < 4; ++dd) kb[dd] = Kb + KSWZ3(r32, (dd * 16 + hi * 8) * 2);
    { const f32x16 z = f32x16{};
      const bf16x8 b0 = *reinterpret_cast<const bf16x8*>(kb[0]), b1 = *reinterpret_cast<const bf16x8*>(kb[0] + 32 * KROW);
      p0 = __builtin_amdgcn_mfma_f32_32x32x16_bf16(b0, qr[0], z, 0, 0, 0); p1 = __builtin_amdgcn_mfma_f32_32x32x16_bf16(b1, qr[0], z, 0, 0, 0); }
#pragma unroll
    for (int d0 = 1; d0 < 12; ++d0) { const char* a = kb[d0 & 3] + (d0 >> 2) * 128;
        const bf16x8 b0 = *reinterpret_cast<const bf16x8*>(a), b1 = *reinterpret_cast<const bf16x8*>(a + 32 * KROW);
        p0 = __builtin_amdgcn_mfma_f32_32x32x16_bf16(b0, qr[d0], p0, 0, 0, 0);
        p1 = __builtin_amdgcn_mfma_f32_32x32x16_bf16(b1, qr[d0], p1, 0, 0, 0); }
    __builtin_amdgcn_sched_group_barrier(0x100, 8, 0);
#pragma unroll
    for (int i = 0; i < 8; ++i) { __builtin_amdgcn_sched_group_barrier(0x8, 2, 0); __builtin_amdgcn_sched_group_barrier(0x100, 2, 0); }
    __builtin_amdgcn_sched_group_barrier(0x8, 8, 0);
}
__device__ __forceinline__ void qkt_rt3k(f32x16& p0, f32x16& p1, const char* Kb, const int (&kso)[4], const bf16x8* qr, bool act) {
    if (!act) { const float NEG = -__builtin_inff();
#pragma unroll
        for (int r = 0; r < 16; ++r) { p0[r] = NEG; p1[r] = NEG; } return; }
    const char* kb[4];
#pragma unroll
    for (int dd = 0; dd < 4; ++dd) kb[dd] = Kb + kso[dd];
    { const f32x16 z = f32x16{};
      const bf16x8 b0 = *reinterpret_cast<const bf16x8*>(kb[0]), b1 = *reinterpret_cast<const bf16x8*>(kb[0] + 32 * KROW);
      p0 = __builtin_amdgcn_mfma_f32_32x32x16_bf16(b0, qr[0], z, 0, 0, 0); p1 = __builtin_amdgcn_mfma_f32_32x32x16_bf16(b1, qr[0], z, 0, 0, 0); }
#pragma unroll
    for (int d0 = 1; d0 < 12; ++d0) { const char* a = kb[d0 & 3] + (d0 >> 2) * 128;
        const bf16x8 b0 = *reinterpret_cast<const bf16x8*>(a), b1 = *reinterpret_cast<const bf16x8*>(a + 32 * KROW);
        p0 = __builtin_amdgcn_mfma_f32_32x32x16_bf16(b0, qr[d0], p0, 0, 0, 0);
        p1 = __builtin_amdgcn_mfma_f32_32x32x16_bf16(b1, qr[d0], p1, 0, 0, 0); }
    __builtin_amdgcn_sched_group_barrier(0x100, 8, 0);
#pragma unroll
    for (int i = 0; i < 8; ++i) { __builtin_amdgcn_sched_group_barrier(0x8, 2, 0); __builtin_amdgcn_sched_group_barrier(0x100, 2, 0); }
    __builtin_amdgcn_sched_group_barrier(0x8, 8, 0);
}
template <bool ALWAYS>
__device__ __forceinline__ void qkt_fsm(f32x16& p0, f32x16& p1, const char* Kb, int lane_in, const bf16x8* qr, bool act,
                                        f32x16& y0, f32x16& y1, float alpha, float& l_reg, bf16x8& pa0, bf16x8& pa1, bf16x8& pa2, bf16x8& pa3) {
    if (!ALWAYS && !act) { qkt_rt3(p0, p1, Kb, lane_in, qr, false); finishSM(y0, y1, alpha, l_reg, pa0, pa1, pa2, pa3); return; }
    int l_ = lane_in; asm volatile("" : "+v"(l_)); const int r32 = l_ & 31, hi = l_ >> 5;
    const char* kb[4];
#pragma unroll
    for (int dd = 0; dd < 4; ++dd) kb[dd] = Kb + KSWZ3(r32, (dd * 16 + hi * 8) * 2);
#define KF(d0, B0, B1) do { const char* a_ = kb[(d0) & 3] + ((d0) >> 2) * 128; B0 = *reinterpret_cast<const bf16x8*>(a_); B1 = *reinterpret_cast<const bf16x8*>(a_ + 32 * KROW); } while (0)
#define PK4(P, B_, OUT) do { unsigned a0 = cvtpk(P[B_+0], P[B_+1]), a1 = cvtpk(P[B_+2], P[B_+3]);                          \
        unsigned b0 = cvtpk(P[B_+4], P[B_+5]), b1 = cvtpk(P[B_+6], P[B_+7]);                                             \
        auto r0 = __builtin_amdgcn_permlane32_swap(a0, b0, false, false); auto r1 = __builtin_amdgcn_permlane32_swap(a1, b1, false, false); \
        v4u w = {r0[0], r1[0], r0[1], r1[1]}; OUT = *reinterpret_cast<bf16x8*>(&w); } while (0)
    bf16x8 fa0, fa1, fb0, fb1;
    const f32x16 z = f32x16{};
    float s0, s1, s2, s3;
    KF(0, fa0, fa1); SBAR3();
    KF(1, fb0, fb1); p0 = __builtin_amdgcn_mfma_f32_32x32x16_bf16(fa0, qr[0], z, 0, 0, 0); p1 = __builtin_amdgcn_mfma_f32_32x32x16_bf16(fa1, qr[0], z, 0, 0, 0); SBAR3();
#pragma unroll
    for (int r = 0; r < 4; ++r) y1[r] = __builtin_amdgcn_exp2f(y1[r]); SBAR3();
    KF(2, fa0, fa1); p0 = __builtin_amdgcn_mfma_f32_32x32x16_bf16(fb0, qr[1], p0, 0, 0, 0); p1 = __builtin_amdgcn_mfma_f32_32x32x16_bf16(fb1, qr[1], p1, 0, 0, 0); SBAR3();
#pragma unroll
    for (int r = 4; r < 8; ++r) y1[r] = __builtin_amdgcn_exp2f(y1[r]); SBAR3();
    KF(3, fb0, fb1); p0 = __builtin_amdgcn_mfma_f32_32x32x16_bf16(fa0, qr[2], p0, 0, 0, 0); p1 = __builtin_amdgcn_mfma_f32_32x32x16_bf16(fa1, qr[2], p1, 0, 0, 0); SBAR3();
#pragma unroll
    for (int r = 8; r < 12; ++r) y1[r] = __builtin_amdgcn_exp2f(y1[r]); SBAR3();
    KF(4, fa0, fa1); p0 = __builtin_amdgcn_mfma_f32_32x32x16_bf16(fb0, qr[3], p0, 0, 0, 0); p1 = __builtin_amdgcn_mfma_f32_32x32x16_bf16(fb1, qr[3], p1, 0, 0, 0); SBAR3();
#pragma unroll
    for (int r = 12; r < 16; ++r) y1[r] = __builtin_amdgcn_exp2f(y1[r]); SBAR3();
    KF(5, fb0, fb1); p0 = __builtin_amdgcn_mfma_f32_32x32x16_bf16(fa0, qr[4], p0, 0, 0, 0); p1 = __builtin_amdgcn_mfma_f32_32x32x16_bf16(fa1, qr[4], p1, 0, 0, 0); SBAR3();
    s0 = ((y0[0] + y0[1]) + (y0[2] + y0[3])) + ((y0[4] + y0[5]) + (y0[6] + y0[7])); SBAR3();
    KF(6, fa0, fa1); p0 = __builtin_amdgcn_mfma_f32_32x32x16_bf16(fb0, qr[5], p0, 0, 0, 0); p1 = __builtin_amdgcn_mfma_f32_32x32x16_bf16(fb1, qr[5], p1, 0, 0, 0); SBAR3();
    s1 = ((y0[8] + y0[9]) + (y0[10] + y0[11])) + ((y0[12] + y0[13]) + (y0[14] + y0[15])); SBAR3();
    KF(7, fb0, fb1); p0 = __builtin_amdgcn_mfma_f32_32x32x16_bf16(fa0, qr[6], p0, 0, 0, 0); p1 = __builtin_amdgcn_mfma_f32_32x32x16_bf16(fa1, qr[6], p1, 0, 0, 0); SBAR3();
    s2 = ((y1[0] + y1[1]) + (y1[2] + y1[3])) + ((y1[4] + y1[5]) + (y1[6] + y1[7])); SBAR3();
    KF(8, fa0, fa1); p0 = __builtin_amdgcn_mfma_f32_32x32x16_bf16(fb0, qr[7], p0, 0, 0, 0); p1 = __builtin_amdgcn_mfma_f32_32x32x16_bf16(fb1, qr[7], p1, 0, 0, 0); SBAR3();
    s3 = ((y1[8] + y1[9]) + (y1[10] + y1[11])) + ((y1[12] + y1[13]) + (y1[14] + y1[15])); SBAR3();
    KF(9, fb0, fb1); p0 = __builtin_amdgcn_mfma_f32_32x32x16_bf16(fa0, qr[8], p0, 0, 0, 0); p1 = __builtin_amdgcn_mfma_f32_32x32x16_bf16(fa1, qr[8], p1, 0, 0, 0); SBAR3();
    { float ps = (s0 + s1) + (s2 + s3);
      auto rr = __builtin_amdgcn_permlane32_swap(__float_as_uint(ps), __float_as_uint(ps), false, false); ps = __uint_as_float(rr[0]) + __uint_as_float(rr[1]);
      l_reg = l_reg * alpha + ps; }
    PK4(y0, 0, pa0); SBAR3();
    KF(10, fa0, fa1); p0 = __builtin_amdgcn_mfma_f32_32x32x16_bf16(fb0, qr[9], p0, 0, 0, 0); p1 = __builtin_amdgcn_mfma_f32_32x32x16_bf16(fb1, qr[9], p1, 0, 0, 0); SBAR3();
    PK4(y0, 8, pa1); SBAR3();
    KF(11, fb0, fb1); p0 = __builtin_amdgcn_mfma_f32_32x32x16_bf16(fa0, qr[10], p0, 0, 0, 0); p1 = __builtin_amdgcn_mfma_f32_32x32x16_bf16(fa1, qr[10], p1, 0, 0, 0); SBAR3();
    PK4(y1, 0, pa2); SBAR3();
    p0 = __builtin_amdgcn_mfma_f32_32x32x16_bf16(fb0, qr[11], p0, 0, 0, 0); p1 = __builtin_amdgcn_mfma_f32_32x32x16_bf16(fb1, qr[11], p1, 0, 0, 0); SBAR3();
    PK4(y1, 8, pa3);
#undef KF
#undef PK4
}
__device__ __forceinline__ void block3(const BlockRef& cur, char* lds) {
    int tid = threadIdx.x; asm volatile("" : "+v"(tid));
    const int wid = __builtin_amdgcn_readfirstlane(tid >> 6), lane = tid & 63, r32 = lane & 31, hi = lane >> 5;
    const int NT = 4 * cur.qb + 4;
    const int tmax = 4 * cur.qb + (wid >> 1);
    char* V_lds = lds; char* K_lds = lds + NVB3 * SHM_V;
    float* ws = (float*)(lds + NVB3 * SHM_V + NKB * SHM_K) + wid * 64; float* li_l = ws, * al_l = ws + 32;
    float l_reg = 0; f32x16 o[4] = {}; const float smax = cur.smax > 40.f ? cur.smax - 40.f : 0.f;
    const char* Kg = (const char*)cur.K; const char* Vg = (const char*)cur.V;
    const unsigned ldsK = (unsigned)(uintptr_t)K_lds, ldsV = (unsigned)(uintptr_t)V_lds;
    const int vbase = (int)(uintptr_t)V_lds + v_rd_base(lane);
    int kso[4];
#pragma unroll
    for (int dd = 0; dd < 4; ++dd) kso[dd] = KSWZ3(r32, (dd * 16 + hi * 8) * 2);
    unsigned koff[3], voff[2];
#pragma unroll
    for (int j_ = 0; j_ < 3; ++j_) { const int A_ = (wid * 3 + j_) * 1024 + lane * 16, row_ = A_ / KROW, pc_ = (A_ % KROW) >> 4, c_ = (pc_ & 24) | ((pc_ & 7) ^ ((row_ >> 1) & 7)); koff[j_] = (unsigned)(row_ * KROW + c_ * 16); }
#pragma unroll
    for (int j_ = 0; j_ < 2; ++j_) { const int a_ = (wid * 2 + j_) * 64 + lane, sub_ = a_ >> 5, kk_ = (sub_ >> 2) * 8 + ((a_ & 31) >> 2), k_ = (kk_ & ~0xC) | ((kk_ & 4) << 1) | ((kk_ & 8) >> 1), c_ = (sub_ & 3) * 32 + (a_ & 3) * 8; voff[j_] = (unsigned)(k_ * (DV * 2) + c_ * 2); }
#define DMA_K(t, slot) do { _Pragma("unroll") for (int j_ = 0; j_ < 3; ++j_) \
        __builtin_amdgcn_global_load_lds((const unsigned*)(Kg + (size_t)(t) * SHM_K + koff[j_]), (las_u32*)(uintptr_t)(ldsK + (slot) * SHM_K + (wid * 3 + j_) * 1024), 16, 0, 0); } while (0)
#define DMA_V(t, slot) do { _Pragma("unroll") for (int j_ = 0; j_ < 2; ++j_) \
        __builtin_amdgcn_global_load_lds((const unsigned*)(Vg + (size_t)(t) * SHM_V + voff[j_]), (las_u32*)(uintptr_t)(ldsV + (slot) * SHM_V + (wid * 2 + j_) * 1024), 16, 0, 0); } while (0)
#define WBAR(n) asm volatile("s_waitcnt vmcnt(" #n ") lgkmcnt(0)\n\ts_barrier" ::: "memory")
#define RESC3(a) do { if (__any((a) < 1.f)) { int l_ = lane; asm volatile("" : "+v"(l_)); const int r32_ = l_ & 31, hi_ = l_ >> 5; if (hi_ == 0) al_l[r32_] = (a); asm volatile("s_waitcnt lgkmcnt(0)" ::: "memory");              \
                     _Pragma("unroll") for (int d_ = 0; d_ < 4; ++d_) _Pragma("unroll") for (int r = 0; r < 16; ++r) o[d_][r] *= al_l[crow(r, hi_)]; } } while (0)
#define ACT3(t) ((t) <= tmax)
    if (wid >= 4) __builtin_amdgcn_s_setprio(2);
    WBAR(0);
    DMA_K(0, 0); DMA_V(0, 0); DMA_K(1, 1);
    bf16x8 qr[12];
#pragma unroll
    for (int d0 = 0; d0 < 12; ++d0) qr[d0] = *(const bf16x8*)(cur.Q + (size_t)(wid * QBLK + r32) * DQ + d0 * 16 + hi * 8);
    {
      const float* sp = cur.ssq + (size_t)(wid * QBLK + r32) * 48; const float rqv = cur.rq[wid * QBLK + r32];
      const float ssv = ((sp[0] + sp[1]) + (sp[2] + sp[3])) + (sp[4] + sp[5]);
      const float sc = rqv * rsqrtf(rqv * rqv * ssv * (1.f / 192.f) + 1e-6f) * QSCALE;
      asm volatile("s_waitcnt vmcnt(0)" ::: "memory");
#pragma unroll
      for (int d0 = 0; d0 < 12; ++d0) { v4u w = __builtin_bit_cast(v4u, qr[d0]); v4u o;
          o.x = cvtpk(blo(w.x) * sc, bhi(w.x) * sc); o.y = cvtpk(blo(w.y) * sc, bhi(w.y) * sc); o.z = cvtpk(blo(w.z) * sc, bhi(w.z) * sc); o.w = cvtpk(blo(w.w) * sc, bhi(w.w) * sc);
          qr[d0] = __builtin_bit_cast(bf16x8, o); } }
    asm volatile("s_waitcnt vmcnt(0)" ::: "memory");
#pragma unroll
    for (int d0 = 0; d0 < 12; ++d0) asm volatile("" : "+v"(qr[d0]));
    WBAR(0);
    f32x16 pA0, pA1, pB0, pB1; bf16x8 pa0, pa1, pa2, pa3;
    DMA_K(2, 2); DMA_V(1, 1);
    SBAR3(); qkt_rt3k(pA0, pA1, K_lds, kso, qr, true);
    partialSMf(pA0, pA1, smax);
    WBAR(5);
    int bt = 1;
#define WINDOW3(PX0, PX1, PY0, PY1, t, ALW) do { const int nx_ = bt == 2 ? 0 : bt + 1, pv_ = bt == 0 ? 2 : bt - 1;           \
        SBAR3(); if ((t) + 2 < NT) DMA_K((t) + 2, pv_); if ((t) + 1 < NT) DMA_V((t) + 1, nx_); SBAR3();                                     \
        qkt_rt3k(PX0, PX1, K_lds + bt * SHM_K, kso, qr, ALW || ACT3(t)); finishSMf(PY0, PY1, l_reg, pa0, pa1, pa2, pa3); SBAR3();            \
        pv_tile(o, vbase + pv_ * SHM_V, pa0, pa1, pa2, pa3, ALW || ACT3((t) - 1));                                           \
        partialSMf(PX0, PX1, smax);                                                                                    \
        bt = nx_; SBAR3(); if ((t) + 2 < NT) WBAR(5); else if ((t) + 1 < NT) WBAR(2); else WBAR(0); SBAR3(); } while (0)
    int t = 1;
    for (; t + 1 < NT - 3; t += 2) {
        WINDOW3(pB0, pB1, pA0, pA1, t, true);
        WINDOW3(pA0, pA1, pB0, pB1, t + 1, true);
    }
    for (; t + 1 < NT; t += 2) {
        WINDOW3(pB0, pB1, pA0, pA1, t, false);
        WINDOW3(pA0, pA1, pB0, pB1, t + 1, false);
    }
    WINDOW3(pB0, pB1, pA0, pA1, NT - 1, false);
    finishSMf(pB0, pB1, l_reg, pa0, pa1, pa2, pa3); SBAR3();
    pv_tile(o, vbase + (bt == 0 ? 2 : bt - 1) * SHM_V, pa0, pa1, pa2, pa3, ACT3(NT - 1));
    __builtin_amdgcn_s_setprio(0);
    { int le = lane; asm volatile("" : "+v"(le)); const int r32e = le & 31, hie = le >> 5;
      if (hie == 0) li_l[r32e] = l_reg; asm volatile("s_waitcnt lgkmcnt(0)" ::: "memory");
      float rli[16];
#pragma unroll
      for (int r = 0; r < 16; ++r) rli[r] = __builtin_amdgcn_rcpf(li_l[crow(r, hie)]);
      bf16* Ow = cur.O + (size_t)(wid * QBLK) * DM;
#pragma unroll
      for (int r = 0; r < 16; ++r) { const int orow = crow(r, hie);
#pragma unroll
          for (int d0 = 0; d0 < 4; ++d0) { const float v = o[d0][r] * rli[r]; const float vn = __shfl_xor(v, 1);
              if ((r32e & 1) == 0) *(unsigned*)(Ow + (size_t)orow * DM + d0 * 32 + r32e) = cvtpk(v, vn); } } }
#undef DMA_K
#undef DMA_V
#undef WBAR
#undef RESC3
#undef ACT3
#undef WINDOW3
}
#undef KSWZ3
#undef SBAR3
}
__device__ __forceinline__ void p4_attn_dma(Frame& F) {
    char* lds = (char*)(F.lds + RING_OFF);
    constexpr int NITEM = BATCH * MLA_H * 16;
    for (int it = F.vcu; it < NITEM; it += F.G) {
#pragma unroll 1
        for (int pass = 0; pass < 2; ++pass) { const attn::BlockRef cur = attn_ref(F, it / 16, pass ? 31 - (it % 16) : it % 16); attn3::block3(cur, lds); }
    }
    asm volatile("s_waitcnt vmcnt(0) lgkmcnt(0)" ::: "memory"); __syncthreads();
}
__device__ __forceinline__ void p2_rq(Frame& F) {
    const int gw = F.vcu * NWAVES + F.wave, NGW = F.G * NWAVES, l = F.lane; const bf16* QL = WSP(bf16, WS_QLAT); float* RQ = WSP(float, WS_RQ);
    for (int base = gw; base < T; base += 8 * NGW) {
        v4u w[8];
#pragma unroll
        for (int i = 0; i < 8; ++i) { const int t = base + i * NGW; w[i] = *(const v4u*)(QL + (size_t)(t < T ? t : base) * QRANK + 8 * (l < 48 ? l : 0)); }
#pragma unroll
        for (int i = 0; i < 8; ++i) { const int t = base + i * NGW; float v[8]; unpack8(w[i], v); float ss = 0.f;
            if (l < 48) {
#pragma unroll
                for (int e = 0; e < 8; ++e) ss += v[e] * v[e]; }
            ss = wave_sum(ss); if (l == 0 && t < T) RQ[t] = rsqrtf(ss * (1.f / QRANK) + EPS); }
    }
}
__device__ __forceinline__ void p5a_conv(Frame& F) {
    const bf16* PROJ = WSP(bf16, WS_PROJ); bf16* XC = WSP(bf16, WS_XC);
    const float* cw = F.in[I_CONVW]; const float* cb = F.in[I_CONVB];
    constexpr int TB = 8, NIT = (T / TB) * (CONV_DIM / 8);
    const bool skew = F.G == 256; const int bx = (int)blockIdx.x; const bool lowb = bx < 128;
    const int it0 = !skew ? F.vcu * NTHR + F.tid : lowb ? bx * NTHR + F.tid : NIT / 3 + (bx - 128) * NTHR + F.tid, itE = !skew ? NIT : lowb ? NIT / 3 : NIT, itS = !skew ? F.G * NTHR : 128 * NTHR;
    static_assert(NIT % 3 == 0 && (NIT / 3) % (128 * NTHR) == 0, "conv split");
    for (int it = it0; it < itE; it += itS) {
        const int c0 = (it % (CONV_DIM / 8)) * 8, tk0 = (it / (CONV_DIM / 8)) * TB, s0 = tk0 % SEQ;
        float w[4][8], bias[8];
#pragma unroll
        for (int k = 0; k < 4; ++k) { const f32x4 a = *(const f32x4*)(cw + k * CONV_DIM + c0), b = *(const f32x4*)(cw + k * CONV_DIM + c0 + 4);
            w[k][0] = a[0]; w[k][1] = a[1]; w[k][2] = a[2]; w[k][3] = a[3]; w[k][4] = b[0]; w[k][5] = b[1]; w[k][6] = b[2]; w[k][7] = b[3]; }
        { const f32x4 a = *(const f32x4*)(cb + c0), b = *(const f32x4*)(cb + c0 + 4); bias[0] = a[0]; bias[1] = a[1]; bias[2] = a[2]; bias[3] = a[3]; bias[4] = b[0]; bias[5] = b[1]; bias[6] = b[2]; bias[7] = b[3]; }
        const bf16* src = PROJ + (size_t)tk0 * IN_PAD + OFF_XBC + c0;
        v4u raw[TB + 3];
#pragma unroll
        for (int i = 0; i < TB + 3; ++i) raw[i] = (s0 + i - 3 >= 0) ? *(const v4u*)(src + (ptrdiff_t)(i - 3) * IN_PAD) : (v4u){0u, 0u, 0u, 0u};
#pragma unroll
        for (int i = 0; i < TB; ++i) { float acc[8];
#pragma unroll
            for (int e = 0; e < 8; ++e) acc[e] = bias[e];
#pragma unroll
            for (int k = 0; k < 4; ++k) { float v[8]; unpack8(raw[i + k], v);
#pragma unroll
                for (int e = 0; e < 8; ++e) acc[e] += v[e] * w[k][e]; }
#pragma unroll
            for (int e = 0; e < 8; ++e) acc[e] = siluf_(acc[e]);
            *(v4u*)(XC + (size_t)(tk0 + i) * CONV_DIM + c0) = pack8(acc); }
    }
}

__device__ __forceinline__ void p5_ssd_naive(Frame& F) {
    const bf16* PROJ = WSP(bf16, WS_PROJ); const bf16* XC = WSP(bf16, WS_XC); bf16* YN = WSP(bf16, WS_YN);
    LAS float* sB = (LAS float*)(F.lds); LAS float* sC = sB + 128; LAS float* part = sC + 128;
    const int tid = F.tid, e = tid >> 6, p = tid & 63;
    for (int it = (int)blockIdx.x; it < BATCH * SSD_G; it += F.G) {
        const int b = it / SSD_G, g = it % SSD_G, h = g * SSD_HPG + e, col = h * SSD_P + p;
        const float a = -__expf(F.in[I_ALOG][h]), dtb = F.in[I_DTB][h], dsk = F.in[I_DSKIP][h], gn = F.in[I_GSSD][col];
        float st[128];
#pragma unroll
        for (int n = 0; n < 128; ++n) st[n] = 0.f;
        for (int s = 0; s < SEQ; ++s) {
            const size_t row = (size_t)b * SEQ + s;
            __syncthreads();
            if (tid < 256) { const float v = bf2f(XC[row * CONV_DIM + 1024 + (tid >> 7) * 256 + g * 128 + (tid & 127)]); if (tid < 128) sB[tid] = v; else sC[tid - 128] = v; }
            const float dt = softplusf_(bf2f(PROJ[row * IN_PAD + OFF_DT + h]) + dtb), dA = __expf(dt * a);
            const float x = bf2f(XC[row * CONV_DIM + col]), z = bf2f(PROJ[row * IN_PAD + col]), dx = dt * x;
            __syncthreads();
            float y = 0.f;
#pragma unroll
            for (int n = 0; n < 128; n += 4) { const f32x4 bv = *(const LAS f32x4*)(sB + n), cv = *(const LAS f32x4*)(sC + n);
                st[n] = dA * st[n] + dx * bv[0]; st[n + 1] = dA * st[n + 1] + dx * bv[1]; st[n + 2] = dA * st[n + 2] + dx * bv[2]; st[n + 3] = dA * st[n + 3] + dx * bv[3];
                y += st[n] * cv[0] + st[n + 1] * cv[1] + st[n + 2] * cv[2] + st[n + 3] * cv[3]; }
            y = (y + dsk * x) * siluf_(z);
            const float q = wave_sum(y * y);
            if (p == 0) part[(s & 1) * 8 + e] = q;
            __syncthreads();
            float tot = 0.f;
#pragma unroll
            for (int i = 0; i < 8; ++i) tot += part[(s & 1) * 8 + i];
            YN[row * DM + col] = (bf16)f2bf(y * rsqrtf(tot * (1.f / 512.f) + EPS) * gn);
        }
    }
}
namespace ssd {
typedef float f32x16 __attribute__((ext_vector_type(16)));
constexpr int XT_OFF = 0, BT_OFF = 65536, BN_OFF = 81920, CN_OFF = 99328, SDT_OFF = 116736, SAC_OFF = 118784, SW_OFF = 120832, NP = 272;
__device__ __forceinline__ int xt_addr(int p, int s) { return p * 128 + ((2 * s) ^ (((p >> 1) & 7) << 4)); }
__device__ __forceinline__ int xt_frag(int p, int chunk) { return p * 128 + ((chunk ^ ((p >> 1) & 7)) << 4); }
__device__ __forceinline__ int crow(int r, int hi) { return (r & 3) + 8 * (r >> 2) + 4 * hi; }
}
__device__ __forceinline__ v4u widen_pair(v2u a, v2u b) {
    const auto r0 = __builtin_amdgcn_permlane32_swap(a.x, b.x, false, false); const auto r1 = __builtin_amdgcn_permlane32_swap(a.y, b.y, false, false);
    return (v4u){r0[0], r1[0], r0[1], r1[1]};
}
__device__ __forceinline__ void p5_ssd_c1(Frame& F) {
    using namespace ssd;
    const bf16* PROJ = WSP(bf16, WS_PROJ); const bf16* XC = WSP(bf16, WS_XC); bf16* YDIAG = WSP(bf16, WS_YDIAG); bf16* STATES = WSP(bf16, WS_STATES);
    float* ACUM = WSP(float, WS_ACUM); float* CDEC = WSP(float, WS_CDEC);
    LAS unsigned char* L = F.lds;
    const int lane = F.lane, w = F.wave, r32 = lane & 31, hi = lane >> 5;
    for (int it = (int)blockIdx.x; it < BATCH * NCHUNK * SSD_G; it += F.G) {
        const int g = it & 1, c = (it >> 1) & (NCHUNK - 1), b = it >> 8, h = g * SSD_HPG + w;
        const size_t t0 = (size_t)b * SEQ + (size_t)c * CHUNK;
        __syncthreads();
        { const bf16* xrow = XC + (t0 + lane) * CONV_DIM;
          LAS unsigned char* xb = L + XT_OFF + w * 8192; LAS unsigned char* bb = L + BT_OFF + w * 2048;
          int lx[8];
#pragma unroll
          for (int cc = 0; cc < 8; ++cc) lx[cc] = (2 * lane) ^ (cc << 4);
#pragma unroll
          for (int j = 0; j < 8; ++j) { const int cg = w * 8 + j; const v4u v = *(const v4u*)(xrow + g * 512 + cg * 8); const unsigned e[4] = {v.x, v.y, v.z, v.w};
#pragma unroll
              for (int i = 0; i < 8; ++i) *(LAS unsigned short*)(xb + lx[(4 * j + (i >> 1)) & 7] + (1024 * j + 128 * i)) = (unsigned short)((i & 1) ? (e[i >> 1] >> 16) : (e[i >> 1] & 0xffffu)); }
#pragma unroll
          for (int j = 0; j < 2; ++j) { const int cg = w * 2 + j; const v4u vb = *(const v4u*)(xrow + 1024 + g * 128 + cg * 8), vc = *(const v4u*)(xrow + 1280 + g * 128 + cg * 8);
              *(LAS v4u*)(L + BN_OFF + lane * NP + cg * 16) = vb; *(LAS v4u*)(L + CN_OFF + lane * NP + cg * 16) = vc; const unsigned e[4] = {vb.x, vb.y, vb.z, vb.w};
#pragma unroll
              for (int i = 0; i < 8; ++i) *(LAS unsigned short*)(bb + lx[(4 * j + (i >> 1)) & 7] + (1024 * j + 128 * i)) = (unsigned short)((i & 1) ? (e[i >> 1] >> 16) : (e[i >> 1] & 0xffffu)); } }
        { const float a = -__expf(F.in[I_ALOG][h]);
          const float dtv = softplusf_(bf2f(PROJ[(t0 + lane) * IN_PAD + OFF_DT + h]) + F.in[I_DTB][h]);
          float ac = dtv * a;
#pragma unroll
          for (int o = 1; o < 64; o <<= 1) { const float nb = __shfl_up(ac, o); if (lane >= o) ac += nb; }
          const float alast = __shfl(ac, 63);
          ((LAS float*)(L + SDT_OFF))[w * 64 + lane] = dtv; ((LAS float*)(L + SAC_OFF))[w * 64 + lane] = ac; ((LAS float*)(L + SW_OFF))[w * 64 + lane] = __expf(alast - ac) * dtv;
          ACUM[(t0 + lane) * SSD_H + h] = ac; if (lane == 63) CDEC[((size_t)b * NCHUNK + c) * SSD_H + h] = __expf(ac); }
        __syncthreads();
        f32x4 cacc[2];
#pragma unroll
        for (int j = 0; j < 2; ++j) { const int q = 2 * w + j, bi = q >> 2, bj = q & 3; cacc[j] = (f32x4){0.f, 0.f, 0.f, 0.f};
#pragma unroll
            for (int ks = 0; ks < 4; ++ks) { const bf16x8 af = *(const LAS bf16x8*)(L + CN_OFF + (16 * bi + (lane & 15)) * NP + (32 * ks + 8 * (lane >> 4)) * 2);
                const bf16x8 bfg = *(const LAS bf16x8*)(L + BN_OFF + (16 * bj + (lane & 15)) * NP + (32 * ks + 8 * (lane >> 4)) * 2);
                cacc[j] = __builtin_amdgcn_mfma_f32_16x16x32_bf16(af, bfg, cacc[j], 0, 0, 0); } }
        __syncthreads();
#pragma unroll
        for (int j = 0; j < 2; ++j) { const int q = 2 * w + j, bi = q >> 2, bj = q & 3;
#pragma unroll
            for (int r = 0; r < 4; ++r) *(LAS float*)(L + CN_OFF + (16 * bi + 4 * (lane >> 4) + r) * NP + (16 * bj + (lane & 15)) * 4) = cacc[j][r]; }
        __syncthreads();
        bf16x8 xf[2][4];
#pragma unroll
        for (int pb = 0; pb < 2; ++pb)
#pragma unroll
            for (int ks = 0; ks < 4; ++ks) xf[pb][ks] = *(const LAS bf16x8*)(L + XT_OFF + xt_frag(w * 64 + 32 * pb + r32, 2 * ks + hi));
        const LAS float* sdt = (const LAS float*)(L + SDT_OFF) + w * 64; const LAS float* sac = (const LAS float*)(L + SAC_OFF) + w * 64; const LAS float* sw = (const LAS float*)(L + SW_OFF) + w * 64;
        const float dsk = F.in[I_DSKIP][h];
        f32x16 yacc[2][2];
#pragma unroll
        for (int lb = 0; lb < 2; ++lb)
#pragma unroll
            for (int pb = 0; pb < 2; ++pb) yacc[lb][pb] = f32x16{};
#pragma unroll
        for (int lb = 0; lb < 2; ++lb) { const int l = 32 * lb + r32; const float acl = sac[l];
#pragma unroll
            for (int ks = 0; ks < 4; ++ks) { if (ks >= 2 * lb + 2) continue;
                const int s0 = 16 * ks + 8 * hi;
                const f32x4 c0 = *(const LAS f32x4*)(L + CN_OFF + l * NP + s0 * 4), c1 = *(const LAS f32x4*)(L + CN_OFF + l * NP + s0 * 4 + 16);
                const f32x4 a0 = *(const LAS f32x4*)(sac + s0), a1 = *(const LAS f32x4*)(sac + s0 + 4), d0 = *(const LAS f32x4*)(sdt + s0), d1 = *(const LAS f32x4*)(sdt + s0 + 4);
                float mv[8];
#pragma unroll
                for (int j = 0; j < 8; ++j) { const int s = s0 + j; const float cb = j < 4 ? c0[j & 3] : c1[j & 3], as = j < 4 ? a0[j & 3] : a1[j & 3], ds = j < 4 ? d0[j & 3] : d1[j & 3];
                    float v = (s <= l) ? cb * __expf(acl - as) * ds : 0.f; if (s == l) v += dsk; mv[j] = v; }
                const v4u mw = pack8(mv); const bf16x8 mf = __builtin_bit_cast(bf16x8, mw);
#pragma unroll
                for (int pb = 0; pb < 2; ++pb) yacc[lb][pb] = __builtin_amdgcn_mfma_f32_32x32x16_bf16(xf[pb][ks], mf, yacc[lb][pb], 0, 0, 0); } }
#pragma unroll
        for (int lb = 0; lb < 2; ++lb)
#pragma unroll
            for (int pb = 0; pb < 2; ++pb)
#pragma unroll
                for (int q = 0; q < 4; q += 2) { v2u oa, ob; oa.x = pk2(yacc[lb][pb][4 * q], yacc[lb][pb][4 * q + 1]); oa.y = pk2(yacc[lb][pb][4 * q + 2], yacc[lb][pb][4 * q + 3]);
                    ob.x = pk2(yacc[lb][pb][4 * q + 4], yacc[lb][pb][4 * q + 5]); ob.y = pk2(yacc[lb][pb][4 * q + 6], yacc[lb][pb][4 * q + 7]);
                    *(v4u*)(YDIAG + (t0 + 32 * lb + r32) * DM + h * SSD_P + 32 * pb + 8 * q + 8 * hi) = widen_pair(oa, ob); }
#pragma unroll
        for (int ks = 0; ks < 4; ++ks) { const int s0 = 16 * ks + 8 * hi; const f32x4 w0 = *(const LAS f32x4*)(sw + s0), w1 = *(const LAS f32x4*)(sw + s0 + 4);
#pragma unroll
            for (int pb = 0; pb < 2; ++pb) { float xv[8]; unpack8(__builtin_bit_cast(v4u, xf[pb][ks]), xv);
                xv[0] *= w0[0]; xv[1] *= w0[1]; xv[2] *= w0[2]; xv[3] *= w0[3]; xv[4] *= w1[0]; xv[5] *= w1[1]; xv[6] *= w1[2]; xv[7] *= w1[3];
                xf[pb][ks] = __builtin_bit_cast(bf16x8, pack8(xv)); } }
        bf16* stp = STATES + (((size_t)b * NCHUNK + c) * SSD_H + h) * (SSD_P * SSD_N);
#pragma unroll 1
        for (int nb = 0; nb < 4; ++nb) { bf16x8 bt[4];
#pragma unroll
            for (int ks = 0; ks < 4; ++ks) bt[ks] = *(const LAS bf16x8*)(L + BT_OFF + xt_frag(32 * nb + r32, 2 * ks + hi));
#pragma unroll
            for (int pb = 0; pb < 2; ++pb) { f32x16 sa = f32x16{};
#pragma unroll
                for (int ks = 0; ks < 4; ++ks) sa = __builtin_amdgcn_mfma_f32_32x32x16_bf16(bt[ks], xf[pb][ks], sa, 0, 0, 0);
#pragma unroll
                for (int q = 0; q < 4; q += 2) { v2u oa, ob; oa.x = pk2(sa[4 * q], sa[4 * q + 1]); oa.y = pk2(sa[4 * q + 2], sa[4 * q + 3]); ob.x = pk2(sa[4 * q + 4], sa[4 * q + 5]); ob.y = pk2(sa[4 * q + 6], sa[4 * q + 7]);
                    *(v4u*)(stp + (32 * pb + r32) * SSD_N + 32 * nb + 8 * q + 8 * hi) = widen_pair(oa, ob); } } }
    }
}
__device__ __forceinline__ void p6_ssd_scan(Frame& F) {
    bf16* STATES = WSP(bf16, WS_STATES); const float* CDEC = WSP(float, WS_CDEC);
    constexpr int NEL = BATCH * SSD_H * SSD_P * (SSD_N / 2);
    constexpr size_t CSTR = (size_t)SSD_H * SSD_P * SSD_N / 2;
    constexpr int SB = 16;
    static_assert(NCHUNK % (2 * SB) == 0, "scan batches");
    for (int idx = (int)blockIdx.x * NTHR + F.tid; idx < NEL; idx += F.G * NTHR) {
        const int n2 = idx & 63, p = (idx >> 6) & 63, h = (idx >> 12) & 15, b = idx >> 16;
        unsigned* ptr = (unsigned*)STATES + ((size_t)b * NCHUNK * SSD_H + h) * (SSD_P * SSD_N / 2) + p * (SSD_N / 2) + n2;
        const float* dec = CDEC + (size_t)b * NCHUNK * SSD_H + h;
        float h0 = 0.f, h1 = 0.f;
        unsigned uA[SB], uB[SB]; float dA[SB], dB[SB];
#define SC_LOAD(U, D, c0) do { _Pragma("unroll") for (int i = 0; i < SB; ++i) { U[i] = ptr[(size_t)((c0) + i) * CSTR]; D[i] = dec[((c0) + i) * SSD_H]; } } while (0)
#define SC_PROC(U, D, c0) do { _Pragma("unroll") for (int i = 0; i < SB; ++i) { const unsigned pv = pk2(h0, h1); h0 = D[i] * h0 + blo(U[i]); h1 = D[i] * h1 + bhi(U[i]); ptr[(size_t)((c0) + i) * CSTR] = pv; } } while (0)
        SC_LOAD(uA, dA, 0);
#pragma unroll 1
        for (int c = 0; c < NCHUNK; c += 2 * SB) {
            SC_LOAD(uB, dB, c + SB); asm volatile("" : "+v"(uA[0]) :: "memory");
            SC_PROC(uA, dA, c);
            const int cn = (c + 2 * SB < NCHUNK) ? c + 2 * SB : c + SB;
            SC_LOAD(uA, dA, cn); asm volatile("" : "+v"(uB[0]) :: "memory");
            SC_PROC(uB, dB, c + SB);
        }
#undef SC_LOAD
#undef SC_PROC
    }
}
__device__ __forceinline__ void p7_ssd_c3(Frame& F) {
    using namespace ssd;
    const bf16* PROJ = WSP(bf16, WS_PROJ); const bf16* XC = WSP(bf16, WS_XC); const bf16* YDIAG = WSP(bf16, WS_YDIAG); const bf16* STATES = WSP(bf16, WS_STATES);
    const float* ACUM = WSP(float, WS_ACUM); bf16* YN = WSP(bf16, WS_YN);
    LAS unsigned char* L = F.lds; LAS float* red = (LAS float*)(L + 64 * NP);
    const int tid = F.tid, lane = F.lane, w = F.wave, r32 = lane & 31, hi = lane >> 5;
    for (int it = (int)blockIdx.x; it < BATCH * NCHUNK * SSD_G; it += F.G) {
        const int g = it & 1, c = (it >> 1) & (NCHUNK - 1), b = it >> 8, h = g * SSD_HPG + w;
        const size_t t0 = (size_t)b * SEQ + (size_t)c * CHUNK;
        __syncthreads();
        { const int row = tid >> 3;
#pragma unroll
          for (int j = 0; j < 2; ++j) { const int ch = (tid & 7) * 2 + j; *(LAS v4u*)(L + row * NP + ch * 16) = *(const v4u*)(XC + (t0 + row) * CONV_DIM + 1280 + g * 128 + ch * 8); } }
        __syncthreads();
        const bf16* prev = STATES + (((size_t)b * NCHUNK + c) * SSD_H + h) * (SSD_P * SSD_N);
        bf16x8 bq[2][8];
#pragma unroll
        for (int pb = 0; pb < 2; ++pb)
#pragma unroll
            for (int ks = 0; ks < 8; ++ks) bq[pb][ks] = *(const bf16x8*)(prev + (32 * pb + r32) * SSD_N + 16 * ks + 8 * hi);
        float eac[2]; v2u yd[2][2][4], zz[2][2][4];
#pragma unroll
        for (int lb = 0; lb < 2; ++lb) { const size_t row = t0 + 32 * lb + r32; eac[lb] = ACUM[row * SSD_H + h];
#pragma unroll
            for (int pb = 0; pb < 2; ++pb)
#pragma unroll
                for (int q = 0; q < 4; ++q) { const int col = h * SSD_P + 32 * pb + 8 * q + 4 * hi; yd[lb][pb][q] = *(const v2u*)(YDIAG + row * DM + col); zz[lb][pb][q] = *(const v2u*)(PROJ + row * IN_PAD + col); } }
        f32x16 acc[2][2];
#pragma unroll
        for (int pb = 0; pb < 2; ++pb)
#pragma unroll
            for (int lb = 0; lb < 2; ++lb) acc[pb][lb] = f32x16{};
#pragma unroll
        for (int ks = 0; ks < 8; ++ks) { bf16x8 af[2];
#pragma unroll
            for (int lb = 0; lb < 2; ++lb) af[lb] = *(const LAS bf16x8*)(L + (32 * lb + r32) * NP + (16 * ks + 8 * hi) * 2);
#pragma unroll
            for (int pb = 0; pb < 2; ++pb)
#pragma unroll
                for (int lb = 0; lb < 2; ++lb) acc[pb][lb] = __builtin_amdgcn_mfma_f32_32x32x16_bf16(bq[pb][ks], af[lb], acc[pb][lb], 0, 0, 0); }
#pragma unroll
        for (int lb = 0; lb < 2; ++lb) { const float ea = __expf(eac[lb]); float ss = 0.f;
#pragma unroll
            for (int pb = 0; pb < 2; ++pb)
#pragma unroll
                for (int q = 0; q < 4; ++q) { const float y4[4] = {blo(yd[lb][pb][q].x), bhi(yd[lb][pb][q].x), blo(yd[lb][pb][q].y), bhi(yd[lb][pb][q].y)};
                    const float z4[4] = {blo(zz[lb][pb][q].x), bhi(zz[lb][pb][q].x), blo(zz[lb][pb][q].y), bhi(zz[lb][pb][q].y)};
#pragma unroll
                    for (int i = 0; i < 4; ++i) { const float y = (y4[i] + ea * acc[pb][lb][4 * q + i]) * siluf_(z4[i]); acc[pb][lb][4 * q + i] = y; ss += y * y; } }
            ss += __shfl_xor(ss, 32);
            if (hi == 0) red[w * 64 + 32 * lb + r32] = ss; }
        __syncthreads();
#pragma unroll
        for (int lb = 0; lb < 2; ++lb) { const size_t row = t0 + 32 * lb + r32; float tot = 0.f;
#pragma unroll
            for (int i = 0; i < 8; ++i) tot += red[i * 64 + 32 * lb + r32];
            const float rs = rsqrtf(tot * (1.f / 512.f) + EPS);
#pragma unroll
            for (int pb = 0; pb < 2; ++pb)
#pragma unroll
                for (int q = 0; q < 4; q += 2) { const int col = h * SSD_P + 32 * pb + 8 * q + 4 * hi; const f32x4 ga = *(const f32x4*)(F.in[I_GSSD] + col), gb = *(const f32x4*)(F.in[I_GSSD] + col + 8); v2u oa, ob;
                    oa.x = pk2(acc[pb][lb][4 * q] * rs * ga[0], acc[pb][lb][4 * q + 1] * rs * ga[1]); oa.y = pk2(acc[pb][lb][4 * q + 2] * rs * ga[2], acc[pb][lb][4 * q + 3] * rs * ga[3]);
                    ob.x = pk2(acc[pb][lb][4 * q + 4] * rs * gb[0], acc[pb][lb][4 * q + 5] * rs * gb[1]); ob.y = pk2(acc[pb][lb][4 * q + 6] * rs * gb[2], acc[pb][lb][4 * q + 7] * rs * gb[3]);
                    *(v4u*)(YN + row * DM + h * SSD_P + 32 * pb + 8 * q + 8 * hi) = widen_pair(oa, ob); } }
    }
}
__device__ __forceinline__ int wr_off(int k, int slot) { return (k >> 1) * 64 + (k & 1) * 32 + ((slot ^ ((k >> 1) & 7)) << 2); }
__device__ __forceinline__ void p11_router(Frame& F) {
    LAS float* wr = (LAS float*)(F.lds);
    LAS unsigned* cnt = (LAS unsigned*)(F.lds + LDSCTL_OFF);
    const float* x1 = F.out; unsigned char* H2 = WSP(unsigned char, WS_XN); int* TOPI = WSP(int, WS_TOPI); float* TOPG = WSP(float, WS_TOPG); int* CNT = WSP(int, WS_CNT);
    const int tid = F.tid, lane = F.lane, w = F.wave;
    typedef float f32x2_ __attribute__((ext_vector_type(2)));
    __syncthreads();
    { f32x4 tw[16];
#pragma unroll
      for (int it = 0; it < 16; ++it) tw[it] = *(const f32x4*)(F.in[I_WR] + (size_t)(tid + it * NTHR) * 4);
#pragma unroll
      for (int it = 0; it < 16; ++it) { const int i = tid + it * NTHR, k = i >> 3, sl = i & 7; *(LAS f32x4*)(wr + wr_off(k, sl)) = tw[it]; } }
    const int e = lane & 31, hf = lane >> 5;
    const float bre = F.in[I_BR][e];
    const LAS float* wb[8];
#pragma unroll
    for (int sl = 0; sl < 8; ++sl) wb[sl] = wr + (lane >> 1) * 64 + (lane & 1) * 32 + ((sl ^ ((lane >> 1) & 7)) << 2);
    LAS float* gfl = (LAS float*)(F.lds + LDSCTL_OFF + 4096);
    for (int i = tid; i < DM; i += NTHR) gfl[i] = F.in[I_GFFN][i];
    const LAS float* gfp = gfl + lane;
    for (int vb = (int)blockIdx.x; vb < T / 64; vb += F.G) {
        __syncthreads();
        if (tid < 32) cnt[tid] = 0u;
        __syncthreads();
        float hvA[16], hvB[16];
#pragma unroll
        for (int j = 0; j < 16; ++j) { hvA[j] = x1[(size_t)(vb * 64 + w * 8) * DM + lane + 64 * j]; hvB[j] = x1[(size_t)(vb * 64 + w * 8 + 1) * DM + lane + 64 * j]; }
#pragma unroll 1
        for (int tp = 0; tp < 4; ++tp) {
            const int tkA = vb * 64 + w * 8 + 2 * tp;
            float ssA = 0.f, ssB = 0.f;
#pragma unroll
            for (int j = 0; j < 16; ++j) { ssA += hvA[j] * hvA[j]; ssB += hvB[j] * hvB[j]; }
            const float* xn = x1 + (size_t)(tkA + (tp < 3 ? 2 : 0)) * DM;
            float rA, rB;
            { float s2 = (hf ? ssB : ssA) + __shfl_xor(hf ? ssA : ssB, 32);
#pragma unroll
              for (int o = 1; o < 32; o <<= 1) s2 += __shfl_xor(s2, o);
              const float r = rsqrtf(s2 * (1.f / DM) + EPS); rA = __shfl(r, 0); rB = __shfl(r, 32); }
            f32x2_ lgA[16], lgB[16];
#pragma unroll
            for (int i = 0; i < 16; ++i) { lgA[i] = (f32x2_){0.f, 0.f}; lgB[i] = (f32x2_){0.f, 0.f}; }
#pragma unroll
            for (int j = 0; j < 16; ++j) { const float gj = gfp[64 * j]; const float ha = hvA[j] * rA * gj, hb = hvB[j] * rB * gj;
                H2[(size_t)tkA * DM + lane + 64 * j] = (unsigned char)(__builtin_amdgcn_cvt_pk_fp8_f32(fminf(fmaxf(ha * H2_SCALE, -448.f), 448.f), 0.f, 0, false) & 0xff);
                H2[(size_t)(tkA + 1) * DM + lane + 64 * j] = (unsigned char)(__builtin_amdgcn_cvt_pk_fp8_f32(fminf(fmaxf(hb * H2_SCALE, -448.f), 448.f), 0.f, 0, false) & 0xff);
                hvA[j] = xn[lane + 64 * j]; hvB[j] = xn[DM + lane + 64 * j];
                const f32x2_ ha2 = (f32x2_){ha, ha}, hb2 = (f32x2_){hb, hb};
#pragma unroll
                for (int sl = 0; sl < 8; ++sl) { const f32x4 wv = *(const LAS f32x4*)(wb[sl] + j * 2048);
                    const f32x2_ w01 = (f32x2_){wv[0], wv[1]}, w23 = (f32x2_){wv[2], wv[3]};
                    lgA[2 * sl] = ha2 * w01 + lgA[2 * sl]; lgA[2 * sl + 1] = ha2 * w23 + lgA[2 * sl + 1];
                    lgB[2 * sl] = hb2 * w01 + lgB[2 * sl]; lgB[2 * sl + 1] = hb2 * w23 + lgB[2 * sl + 1]; }
                if (j & 1) __builtin_amdgcn_sched_barrier(0); }
            float lg[32];
#pragma unroll
            for (int i = 0; i < 32; ++i) { const float a = (i & 1) ? lgA[i >> 1].y : lgA[i >> 1].x, b = (i & 1) ? lgB[i >> 1].y : lgB[i >> 1].x; lg[i] = (hf ? b : a) + __shfl_xor(hf ? a : b, 32); }
#define RED_STEP(NV, MSK) { const bool up = (lane & (MSK)) != 0; _Pragma("unroll") for (int i = 0; i < (NV) / 2; ++i) { const float snd = up ? lg[i] : lg[i + (NV) / 2]; const float kp = up ? lg[i + (NV) / 2] : lg[i]; lg[i] = kp + __shfl_xor(snd, (MSK)); } }
            RED_STEP(32, 16) RED_STEP(16, 8) RED_STEP(8, 4) RED_STEP(4, 2) RED_STEP(2, 1)
#undef RED_STEP
            const float v = lg[0] + bre;
            float tv[4]; int tix[4];
            { const unsigned vb_ = __float_as_uint(v); float key = __uint_as_float((vb_ & ~31u) | (unsigned)((vb_ >> 31) ? e : 31 - e));
#pragma unroll
              for (int k = 0; k < 4; ++k) { float mx = key;
#pragma unroll
                  for (int o = 1; o < 32; o <<= 1) mx = fmaxf(mx, __shfl_xor(mx, o));
                  const unsigned mb = __float_as_uint(mx); const int es = (mb >> 31) ? (int)(mb & 31u) : 31 - (int)(mb & 31u);
                  tv[k] = mx; tix[k] = es; if (e == es) key = -INFINITY; } }
            const float e1 = __expf(tv[1] - tv[0]), e2 = __expf(tv[2] - tv[0]), e3 = __expf(tv[3] - tv[0]), inv = 1.0f / (1.0f + e1 + e2 + e3);
            if (e == 0) { const int tk = tkA + hf; *(int4*)(TOPI + (size_t)tk * 4) = make_int4(tix[0], tix[1], tix[2], tix[3]); *(f32x4*)(TOPG + (size_t)tk * 4) = (f32x4){inv, e1 * inv, e2 * inv, e3 * inv};
                __hip_atomic_fetch_add(&cnt[tix[0]], 1u, __ATOMIC_RELAXED, __HIP_MEMORY_SCOPE_WORKGROUP); __hip_atomic_fetch_add(&cnt[tix[1]], 1u, __ATOMIC_RELAXED, __HIP_MEMORY_SCOPE_WORKGROUP); __hip_atomic_fetch_add(&cnt[tix[2]], 1u, __ATOMIC_RELAXED, __HIP_MEMORY_SCOPE_WORKGROUP); __hip_atomic_fetch_add(&cnt[tix[3]], 1u, __ATOMIC_RELAXED, __HIP_MEMORY_SCOPE_WORKGROUP); }
        }
        __syncthreads();
        if (tid < 32) CNT[vb * 32 + tid] = (int)cnt[tid];
    }
}

__device__ __forceinline__ void p12_slots(Frame& F) {
    LAS int* tot = (LAS int*)(F.lds); LAS int* pre = tot + 32; LAS int* start = pre + 32; LAS int* cur = start + 32; LAS int* nmt_s = cur + 32; LAS int* psum = nmt_s + 32; LAS int* ppre = psum + 512;
    const int* CNT = WSP(int, WS_CNT); const int* TOPI = WSP(int, WS_TOPI); int* SLOT = WSP(int, WS_SLOT); int* ROWTOK = WSP(int, WS_ROWTOK); int* MTE = WSP(int, WS_MTE);
    const int tid = F.tid, lane = F.lane;
    for (int vb = (int)blockIdx.x; vb < T / 64; vb += F.G) {
        __syncthreads();
        { const int e = tid & 31, part = tid >> 5; int a = 0, p = 0;
#pragma unroll
          for (int i = 0; i < 16; ++i) { const int c = CNT[(part * 16 + i) * 32 + e]; if (part * 16 + i < vb) p += c; a += c; }
          psum[part * 32 + e] = a; ppre[part * 32 + e] = p; }
        __syncthreads();
        if (tid < 32) { int a = 0, p = 0;
#pragma unroll
            for (int i = 0; i < 16; ++i) { a += psum[i * 32 + tid]; p += ppre[i * 32 + tid]; } tot[tid] = a; pre[tid] = p; }
        __syncthreads();
        if (tid == 0) { int s = 0; for (int e = 0; e < 32; ++e) { start[e] = s; s += ((tot[e] + 255) >> 8) << 8; } nmt_s[0] = s >> 8; }
        __syncthreads();
        if (tid < 32) cur[tid] = start[tid] + pre[tid];
        __syncthreads();
        if (tid < 64) {
            const int tk = vb * 64 + lane; const int4 ti = *(const int4*)(TOPI + (size_t)tk * 4); int ex[4] = {ti.x, ti.y, ti.z, ti.w}; int sl[4];
#pragma unroll 1
            for (int ee = 0; ee < 32; ++ee) {
                int mine = 0;
#pragma unroll
                for (int k = 0; k < 4; ++k) mine += (ex[k] == ee) ? 1 : 0;
                int incl = mine;
#pragma unroll
                for (int o = 1; o < 64; o <<= 1) { const int nb = __shfl_up(incl, o); if (lane >= o) incl += nb; }
                const int base = cur[ee] + incl - mine;
#pragma unroll
                for (int k = 0; k < 4; ++k) if (ex[k] == ee) sl[k] = base;
            }
            *(int4*)(SLOT + (size_t)tk * 4) = make_int4(sl[0], sl[1], sl[2], sl[3]);
#pragma unroll
            for (int k = 0; k < 4; ++k) ROWTOK[sl[k]] = tk;
        }
        if (vb == 0) {
            for (int e = 0; e < 32; ++e) { const int n = tot[e], pd = ((n + 255) >> 8) << 8; for (int i = n + tid; i < pd; i += NTHR) ROWTOK[start[e] + i] = 0;
                for (int i = tid; i < (pd >> 8); i += NTHR) MTE[(start[e] >> 8) + i] = e; }
            if (tid == 0) MTE[MT_MAX] = nmt_s[0];
        }
    }
}

__device__ __forceinline__ void p13_gateup_naive(Frame& F) {
    LAS bf16* hs = (LAS bf16*)(F.lds);
    const bf16* H2 = WSP(bf16, WS_XN); const int* ROWTOK = WSP(int, WS_ROWTOK); const int* MTE = WSP(int, WS_MTE); bf16* ACT = WSP(bf16, WS_ACT);
    const int tid = F.tid, nmt = MTE[MT_MAX];
    for (int it = (int)blockIdx.x; it < nmt * 16; it += F.G) {
        const int mt = it >> 4, s0 = it * 16, e = MTE[mt];
        __syncthreads();
        for (int i = tid; i < 16 * 128; i += NTHR) { const int r = i >> 7, c = (i & 127) * 8; *(LAS v4u*)(hs + r * 1024 + c) = *(const v4u*)(H2 + (size_t)ROWTOK[s0 + r] * DM + c); }
        __syncthreads();
        const bf16* We = WSP(bf16, WS_WGU) + (size_t)e * 2 * FF * DM;
#pragma unroll 1
        for (int jj = 0; jj < 2; ++jj) {
            const int j = tid + 512 * jj, rowg = (j >> 7) * 256 + (j & 127), rowl = rowg + 128;
            float ag[16], al[16];
#pragma unroll
            for (int s = 0; s < 16; ++s) { ag[s] = 0.f; al[s] = 0.f; }
#pragma unroll 1
            for (int k = 0; k < DM; k += 8) { float wg[8], wl[8]; unpack8(*(const v4u*)(We + (size_t)rowg * DM + k), wg); unpack8(*(const v4u*)(We + (size_t)rowl * DM + k), wl);
#pragma unroll
                for (int s = 0; s < 16; ++s) { float hv[8]; unpack8(*(const LAS v4u*)(hs + s * 1024 + k), hv);
#pragma unroll
                    for (int q = 0; q < 8; ++q) { ag[s] += hv[q] * wg[q]; al[s] += hv[q] * wl[q]; } } }
            const float bg = F.in[I_BGU][(size_t)e * 2 * FF + j], bl = F.in[I_BGU][(size_t)e * 2 * FF + FF + j];
#pragma unroll
            for (int s = 0; s < 16; ++s) { const float glu = fminf(ag[s] + bg, 7.0f), lin = fminf(fmaxf(al[s] + bl, -7.0f), 7.0f);
                ACT[(size_t)(s0 + s) * FF + j] = (bf16)f2bf(glu * (1.0f / (1.0f + __expf(-1.702f * glu))) * (lin + 1.0f)); }
        }
    }
}
__device__ __forceinline__ void p14_down_naive(Frame& F) {
    LAS bf16* as = (LAS bf16*)(F.lds);
    const int* MTE = WSP(int, WS_MTE); const bf16* ACT = WSP(bf16, WS_ACT); bf16* YS = WSP(bf16, WS_YS);
    const int tid = F.tid, nmt = MTE[MT_MAX];
    for (int it = (int)blockIdx.x; it < nmt * 16; it += F.G) {
        const int mt = it >> 4, s0 = it * 16, e = MTE[mt];
        __syncthreads();
        for (int i = tid; i < 16 * 128; i += NTHR) { const int r = i >> 7, c = (i & 127) * 8; *(LAS v4u*)(as + r * 1024 + c) = *(const v4u*)(ACT + (size_t)(s0 + r) * FF + c); }
        __syncthreads();
        const bf16* We = WSP(bf16, WS_WDN) + (size_t)e * DM * FF;
#pragma unroll 1
        for (int jj = 0; jj < 2; ++jj) {
            const int j = tid + 512 * jj;
            float a[16];
#pragma unroll
            for (int s = 0; s < 16; ++s) a[s] = 0.f;
#pragma unroll 1
            for (int k = 0; k < FF; k += 8) { float wv[8]; unpack8(*(const v4u*)(We + (size_t)j * FF + k), wv);
#pragma unroll
                for (int s = 0; s < 16; ++s) { float hv[8]; unpack8(*(const LAS v4u*)(as + s * 1024 + k), hv);
#pragma unroll
                    for (int q = 0; q < 8; ++q) a[s] += hv[q] * wv[q]; } }
            const float bd = F.in[I_BDN][(size_t)e * DM + j];
#pragma unroll
            for (int s = 0; s < 16; ++s) YS[(size_t)(s0 + s) * DM + j] = (bf16)f2bf(a[s] + bd);
        }
    }
}
__device__ __forceinline__ void p15_combine(Frame& F) {
    const bf16* YS = WSP(bf16, WS_YS); const int* SLOT = WSP(int, WS_SLOT); const float* TOPG = WSP(float, WS_TOPG);
    const int gw = F.vcu * NWAVES + F.wave, NGW = F.G * NWAVES, lane = F.lane;
    for (int tk = gw; tk < T; tk += NGW) {
        const int4 sl = *(const int4*)(SLOT + (size_t)tk * 4); const f32x4 g = *(const f32x4*)(TOPG + (size_t)tk * 4);
        const int s4[4] = {sl.x, sl.y, sl.z, sl.w}; const float g4[4] = {g[0], g[1], g[2], g[3]};
        float* orow = F.out + (size_t)tk * DM;
#pragma unroll
        for (int j = 0; j < 4; ++j) { f32x4 o = *(const f32x4*)(orow + 4 * lane + 256 * j);
#pragma unroll
            for (int k = 0; k < 4; ++k) { const v2u y = *(const v2u*)(YS + (size_t)s4[k] * DM + 4 * lane + 256 * j);
                o[0] += g4[k] * blo(y.x); o[1] += g4[k] * bhi(y.x); o[2] += g4[k] * blo(y.y); o[3] += g4[k] * bhi(y.y); }
            *(f32x4*)(orow + 4 * lane + 256 * j) = o; }
    }
}
namespace pg8 {
__device__ __forceinline__ float xsum4(float v) { v += __shfl_xor(v, 16); v += __shfl_xor(v, 32); return v; }
struct EpiQUp {
    static constexpr bool PERM = true, AFTER_DRAIN = false;
    const float* gq; unsigned char* ws;
    __device__ __forceinline__ void operator()(const f32x4 (&acc)[2][2][4][2], const Unit& u, int wr, int wc, int fr, int fq) const {
        asm volatile("" : "+v"(fr), "+v"(fq));
        const int row0 = u.pm * BM + wr * 64 + fr; const float* RT = (const float*)(ws + WS_ROPE); bf16_t* Q = (bf16_t*)(ws + WS_Q); float* SSQ = (float*)(ws + WS_SSQ);
#pragma unroll
        for (int bj = 0; bj < 2; ++bj) {
            const int colg = u.pn * BM + bj * HALF + wc * 32, h = colg / 192, d0 = colg % 192, g32 = colg >> 5;
            const bool rope = d0 >= 128; const int i4 = rope ? ((d0 - 128) >> 3) + fq : 0;
            const float* gp = gq + (rope ? 128 + 4 * i4 : d0 + 8 * fq); const f32x4 g0 = *(const f32x4*)gp, g1 = *(const f32x4*)(gp + (rope ? 32 : 4));
            f32x4 cs[8], sn[8];
            if (rope) {
#pragma unroll
                for (int q = 0; q < 8; ++q) { const int s = (row0 + (q >> 2) * HALF + (q & 3) * 16) & (8192 - 1); cs[q] = *(const f32x4*)(RT + s * 64 + 4 * i4); sn[q] = *(const f32x4*)(RT + s * 64 + 32 + 4 * i4); } }
#pragma unroll
            for (int q = 0; q < 8; ++q) { const int ai = q >> 2, m = q & 3, row = row0 + ai * HALF + m * 16, b = row >> 13, s = row & (8192 - 1);
                const f32x4 v0 = acc[ai][bj][m][0], v1 = acc[ai][bj][m][1];
                const float ss = xsum4(((v0[0] * v0[0] + v0[1] * v0[1]) + (v0[2] * v0[2] + v0[3] * v0[3])) + ((v1[0] * v1[0] + v1[1] * v1[1]) + (v1[2] * v1[2] + v1[3] * v1[3])));
                if (fq == 0) SSQ[(size_t)row * 48 + g32] = ss;
                bf16_t* qrow = Q + ((size_t)(b * 8 + h) * 8192 + s) * 192;
                const f32x4 x1 = v0 * g0, x2 = v1 * g1;
                if (!rope) { u32x4 w; w.x = cvt_pk_bf16(x1[0], x1[1]); w.y = cvt_pk_bf16(x1[2], x1[3]); w.z = cvt_pk_bf16(x2[0], x2[1]); w.w = cvt_pk_bf16(x2[2], x2[3]); *(u32x4*)(qrow + d0 + 8 * fq) = w; }
                else { const f32x4 o1 = x1 * cs[q] - x2 * sn[q], o2 = x2 * cs[q] + x1 * sn[q]; typedef unsigned u32x2_ __attribute__((ext_vector_type(2)));
                    *(u32x2_*)(qrow + 128 + 4 * i4) = (u32x2_){cvt_pk_bf16(o1[0], o1[1]), cvt_pk_bf16(o1[2], o1[3])}; *(u32x2_*)(qrow + 160 + 4 * i4) = (u32x2_){cvt_pk_bf16(o2[0], o2[1]), cvt_pk_bf16(o2[2], o2[3])}; } }
        }
    }
};
struct EpiKVUp {
    static constexpr bool PERM = true, AFTER_DRAIN = false;
    const float* gk; unsigned char* ws; PG8_LAS float* lds;
    __device__ __forceinline__ void operator()(const f32x4 (&acc)[2][2][4][2], const Unit& u, int wr, int wc, int fr, int fq) const {
        asm volatile("" : "+v"(fr), "+v"(fq));
        PG8_LAS float* part = lds; PG8_LAS float* rkvl = lds + 1024; PG8_LAS float* sskl = lds + 1280;
        const float* RT = (const float*)(ws + WS_ROPE); const bf16_t* KVL = (const bf16_t*)(ws + WS_KVLAT); const bf16_t* KR = (const bf16_t*)(ws + WS_PROJ) + OFF_KROPE; constexpr int ldkr = IN_PAD;
        bf16_t* K = (bf16_t*)(ws + WS_K); bf16_t* V = (bf16_t*)(ws + WS_V);
        const int h = u.pn, rl0 = wr * 64 + fr;
#pragma unroll
        for (int aj = 0; aj < 2; ++aj) { const int rl = rl0 + aj * HALF + wc * 16, row = u.pm * BM + rl;
            const u32x4* lp = (const u32x4*)(KVL + (size_t)row * 256 + 64 * fq); u32x4 lw[8];
#pragma unroll
            for (int j = 0; j < 8; ++j) lw[j] = lp[j];
            const u32x4 k1 = *(const u32x4*)(KR + (size_t)row * ldkr + 8 * fq), k2 = *(const u32x4*)(KR + (size_t)row * ldkr + 32 + 8 * fq);
            float ss = 0.f;
#pragma unroll
            for (int j = 0; j < 8; ++j) { const unsigned ww[4] = {lw[j].x, lw[j].y, lw[j].z, lw[j].w};
#pragma unroll
                for (int e = 0; e < 4; ++e) { const float a = bf_lo(ww[e]), b2 = bf_hi(ww[e]); ss += a * a + b2 * b2; } }
            ss = xsum4(ss);
            float sk = 0.f; { const unsigned ww[8] = {k1.x, k1.y, k1.z, k1.w, k2.x, k2.y, k2.z, k2.w};
#pragma unroll
                for (int e = 0; e < 8; ++e) { const float a = bf_lo(ww[e]), b2 = bf_hi(ww[e]); sk += a * a + b2 * b2; } }
            sk = xsum4(sk);
            if (fq == 0) { rkvl[rl] = rsqrtf(ss * (1.f / 256.f) + 1e-6f); sskl[rl] = sk; }
            asm volatile("" ::: "memory"); }
#pragma unroll
        for (int q = 0; q < 8; ++q) { const int ai = q >> 2, m = q & 3; const f32x4 v0 = acc[ai][0][m][0], v1 = acc[ai][0][m][1];
            const float ss = xsum4(((v0[0] * v0[0] + v0[1] * v0[1]) + (v0[2] * v0[2] + v0[3] * v0[3])) + ((v1[0] * v1[0] + v1[1] * v1[1]) + (v1[2] * v1[2] + v1[3] * v1[3])));
            if (fq == 0) part[(rl0 + ai * HALF + m * 16) * 4 + wc] = ss; }
        const float* gp = gk + wc * 32 + 8 * fq; const f32x4 g0 = *(const f32x4*)gp, g1 = *(const f32x4*)(gp + 4);
        const f32x4 gr1a = *(const f32x4*)(gk + 128 + 8 * fq), gr1b = *(const f32x4*)(gk + 128 + 8 * fq + 4), gr2a = *(const f32x4*)(gk + 160 + 8 * fq), gr2b = *(const f32x4*)(gk + 160 + 8 * fq + 4);
        asm volatile("s_waitcnt lgkmcnt(0)" ::: "memory"); __builtin_amdgcn_s_barrier(); asm volatile("" ::: "memory");
        u32x4 kr1[2], kr2[2]; f32x4 c1[2], c2[2], s1[2], s2[2];
#pragma unroll
        for (int aj = 0; aj < 2; ++aj) { const int row = u.pm * BM + rl0 + aj * HALF + wc * 16, s = row & (8192 - 1);
            kr1[aj] = *(const u32x4*)(KR + (size_t)row * ldkr + 8 * fq); kr2[aj] = *(const u32x4*)(KR + (size_t)row * ldkr + 32 + 8 * fq);
            c1[aj] = *(const f32x4*)(RT + s * 64 + 8 * fq); c2[aj] = *(const f32x4*)(RT + s * 64 + 8 * fq + 4); s1[aj] = *(const f32x4*)(RT + s * 64 + 32 + 8 * fq); s2[aj] = *(const f32x4*)(RT + s * 64 + 32 + 8 * fq + 4); }
#pragma unroll
        for (int q = 0; q < 8; ++q) { const int ai = q >> 2, m = q & 3, rl = rl0 + ai * HALF + m * 16, row = u.pm * BM + rl, b = row >> 13, s = row & (8192 - 1);
            const f32x4 pp = *(const PG8_LAS f32x4*)(part + rl * 4); const float rkv = rkvl[rl], sk = sskl[rl];
            const float rs = rsqrtf((rkv * rkv * ((pp[0] + pp[1]) + (pp[2] + pp[3])) + sk) * (1.f / 192.f) + 1e-6f), kn = rkv * rs;
            const size_t tb = (size_t)(b * 8 + h) * 8192 + s;
            { const f32x4 x0 = acc[ai][0][m][0] * g0 * kn, x1 = acc[ai][0][m][1] * g1 * kn; u32x4 w; w.x = cvt_pk_bf16(x0[0], x0[1]); w.y = cvt_pk_bf16(x0[2], x0[3]); w.z = cvt_pk_bf16(x1[0], x1[1]); w.w = cvt_pk_bf16(x1[2], x1[3]);
              *(u32x4*)(K + tb * 192 + wc * 32 + 8 * fq) = w; }
            { const f32x4 x0 = acc[ai][1][m][0] * rkv, x1 = acc[ai][1][m][1] * rkv; u32x4 w; w.x = cvt_pk_bf16(x0[0], x0[1]); w.y = cvt_pk_bf16(x0[2], x0[3]); w.z = cvt_pk_bf16(x1[0], x1[1]); w.w = cvt_pk_bf16(x1[2], x1[3]);
              *(u32x4*)(V + tb * 128 + wc * 32 + 8 * fq) = w; } }
#pragma unroll
        for (int aj = 0; aj < 2; ++aj) { const int rl = rl0 + aj * HALF + wc * 16, row = u.pm * BM + rl, b = row >> 13, s = row & (8192 - 1);
            const f32x4 pp = *(const PG8_LAS f32x4*)(part + rl * 4); const float rkv = rkvl[rl], sk = sskl[rl];
            const float rs = rsqrtf((rkv * rkv * ((pp[0] + pp[1]) + (pp[2] + pp[3])) + sk) * (1.f / 192.f) + 1e-6f);
            const f32x4 a1 = (f32x4){bf_lo(kr1[aj].x), bf_hi(kr1[aj].x), bf_lo(kr1[aj].y), bf_hi(kr1[aj].y)} * gr1a * rs, b1 = (f32x4){bf_lo(kr1[aj].z), bf_hi(kr1[aj].z), bf_lo(kr1[aj].w), bf_hi(kr1[aj].w)} * gr1b * rs;
            const f32x4 a2 = (f32x4){bf_lo(kr2[aj].x), bf_hi(kr2[aj].x), bf_lo(kr2[aj].y), bf_hi(kr2[aj].y)} * gr2a * rs, b2 = (f32x4){bf_lo(kr2[aj].z), bf_hi(kr2[aj].z), bf_lo(kr2[aj].w), bf_hi(kr2[aj].w)} * gr2b * rs;
            const f32x4 oa1 = a1 * c1[aj] - a2 * s1[aj], ob1 = b1 * c2[aj] - b2 * s2[aj], oa2 = a2 * c1[aj] + a1 * s1[aj], ob2 = b2 * c2[aj] + b1 * s2[aj];
            bf16_t* kp = K + ((size_t)(b * 8 + h) * 8192 + s) * 192;
            u32x4 w; w.x = cvt_pk_bf16(oa1[0], oa1[1]); w.y = cvt_pk_bf16(oa1[2], oa1[3]); w.z = cvt_pk_bf16(ob1[0], ob1[1]); w.w = cvt_pk_bf16(ob1[2], ob1[3]); *(u32x4*)(kp + 128 + 8 * fq) = w;
            w.x = cvt_pk_bf16(oa2[0], oa2[1]); w.y = cvt_pk_bf16(oa2[2], oa2[3]); w.z = cvt_pk_bf16(ob2[0], ob2[1]); w.w = cvt_pk_bf16(ob2[2], ob2[3]); *(u32x4*)(kp + 160 + 8 * fq) = w; }
    }
};
}
struct Args { const float* in[25]; float* out; unsigned char* ws; int ph_lo, ph_hi; };
constexpr int NPHASE = 16;
__global__ void __launch_bounds__(NTHR, 2) mega_fwd(Args args) {
    extern __shared__ __attribute__((aligned(16))) unsigned char lds[];
    Frame F;
    F.lds = (LAS unsigned char*)lds;
    F.MISC = (volatile LAS unsigned*)(F.lds + MISC_OFF);
    F.tid = threadIdx.x; F.lane = F.tid & 63; F.wave = __builtin_amdgcn_readfirstlane(F.tid >> 6);
    F.G = gridDim.x; { const int bx = blockIdx.x; F.vcu = (F.G % 8 == 0) ? (bx % 8) * (F.G / 8) + bx / 8 : bx; }
#pragma unroll
    for (int i = 0; i < 25; ++i) F.in[i] = args.in[i];
    F.out = args.out; F.ws = args.ws;
    F.ctl = (gu32*)(F.ws + WS_CTL);
    for (int u = F.tid; u < (LDS_BYTES - LDSCTL_OFF) / 4; u += NTHR) ((LAS unsigned*)(F.lds + LDSCTL_OFF))[u] = 0u;
    __syncthreads();
    const int lo = args.ph_lo, hi = args.ph_hi;
    const bool multi = (hi - lo) > 1;
    XcdBarrier bar; bar.bar = (unsigned*)(F.ctl + CW_BAR); bar.x = 0; bar.st = nullptr;
    if (multi) bar = xcd_barrier_post((unsigned*)(F.ctl + CW_BAR), F.MISC + 8);
#ifndef PH_MASK
#define PH_MASK 0xFFFFFF
#endif
#define IN(k) (((PH_MASK >> (k)) & 1) && lo <= (k) && (k) < hi)
#define SEAM(k) do { if (IN(k) && IN((k) + 1)) xcd_barrier(bar); } while (0)
    using namespace pg8;
    bf16* PROJ = WSP(bf16, WS_PROJ);
    if (IN(0)) { p0_prologue(F); } SEAM(0);
    if (IN(1)) { Gemm g{WSP(bf16, WS_XN), WSP(bf16, WS_WIN), T, IN_PAD, DM, DM}; StaticOrder S; S.init(T, IN_PAD, F.G, (int)blockIdx.x);
        EpiPerm8<FStoreProj> E{{PROJ, IN_PAD, WSP(bf16, WS_QLAT), WSP(bf16, WS_KVLAT)}}; gemm_phase<EpiPerm8<FStoreProj>, StaticOrder, true, true>(F.lds + RING_OFF, g, S, E);
        p0_deferred(F, ((T / 256) * (IN_PAD / 256)) % F.G); } SEAM(1);
    if (IN(2)) {
        { Gemm g{WSP(bf16, WS_QLAT), WSP(bf16, WS_WQ), T, MLA_H * QKD, QRANK, QRANK}; StaticOrder S; S.init(T, MLA_H * QKD, F.G, (int)blockIdx.x);
          EpiQUp E{F.in[I_GQKQ], F.ws}; gemm_phase<EpiQUp, StaticOrder, true, true>(F.lds + RING_OFF, g, S, E); }
        { Gemm g{WSP(bf16, WS_KVLAT), WSP(bf16, WS_WKV), T, MLA_H * 256, KVRANK, KVRANK}; StaticOrder S; S.init(T, MLA_H * 256, F.G, (int)blockIdx.x);
          EpiKVUp E{F.in[I_GQKK], F.ws, (LAS float*)(F.lds + LDSCTL_OFF + 1024)};
          gemm_phase<EpiKVUp, StaticOrder, true, true>(F.lds + RING_OFF, g, S, E); }
        p2_rq(F);
        p5a_conv(F); } SEAM(2);
    if (IN(4)) { p5_ssd_c1(F); } SEAM(4);
    if (IN(5)) { p4_attn_dma(F); }
    if (IN(6)) { p6_ssd_scan(F); } SEAM(6);
    if (IN(7)) { p7_ssd_c3(F); } SEAM(7);
    if (IN(8)) { Gemm g{WSP(bf16, WS_YN), WSP(bf16, WS_WSSD), T, DM, DM, DM}; StaticOrder S; S.init(T, DM, F.G, (int)blockIdx.x);
        EpiPipe8<GGate1> E{{PROJ + OFF_GATE, IN_PAD, WSP(bf16, WS_MRG), DM}}; gemm_phase<EpiPipe8<GGate1>, StaticOrder, true, true>(F.lds + RING_OFF, g, S, E); }
    if (IN(9)) { Gemm g{WSP(bf16, WS_OATT), WSP(bf16, WS_WMLA), T, DM, DM, DM}; StaticOrder S; S.init(T, DM, F.G, (int)blockIdx.x);
        EpiPipe8<GGate2> E{{PROJ + OFF_GATE + DM, IN_PAD, WSP(bf16, WS_MRG), DM}}; gemm_phase<EpiPipe8<GGate2>, StaticOrder, true, true>(F.lds + RING_OFF, g, S, E); } SEAM(9);
    if (IN(10)) { Gemm g{WSP(bf16, WS_MRG), WSP(bf16, WS_WO), T, DM, DM, DM}; StaticOrder S; S.init(T, DM, F.G, (int)blockIdx.x);
        EpiPipe8<GResF32> E{{F.in[I_X], F.out, DM}}; gemm_phase<EpiPipe8<GResF32>, StaticOrder, true, true>(F.lds + RING_OFF, g, S, E); } SEAM(10);
    if (IN(11)) { p11_router(F); } SEAM(11);
    if (IN(12)) { p12_slots(F); } SEAM(12);
    if (IN(13)) { const int* MTE = WSP(int, WS_MTE); const int nmt = MTE[MT_MAX]; Gemm g{WSP(bf16, WS_XN), WSP(bf16, WS_WGU), nmt * 256, 2 * FF, DM / 2, DM / 2, 0x7b7b7b7b, 0x76767676};
        MoeOrder S; S.init(nmt, 2 * FF, F.G, (int)blockIdx.x, WSP(int, WS_ROWTOK), MTE, (size_t)2 * FF * DM);
        EpiGateUp E{F.in[I_BGU], MTE, WSP(unsigned char, WS_ACT)}; gemm_phase<EpiGateUp, MoeOrder, true, true, true>(F.lds + RING_OFF, g, S, E); } SEAM(13);
    if (IN(14)) { const int* MTE = WSP(int, WS_MTE); const int nmt = MTE[MT_MAX]; Gemm g{WSP(bf16, WS_ACT), WSP(bf16, WS_WDN), nmt * 256, DM, FF / 2, FF / 2, 0x7d7d7d7d, 0x76767676};
        MoeOrder S; S.init(nmt, DM, F.G, (int)blockIdx.x, nullptr, MTE, (size_t)DM * FF);
        EpiDown E{F.in[I_BDN], MTE, WSP(bf16, WS_YS)}; gemm_phase<EpiDown, MoeOrder, true, true, true>(F.lds + RING_OFF, g, S, E); } SEAM(14);
    if (IN(15)) { p15_combine(F); }
#undef IN
#undef SEAM
}

#ifndef MK_SINGLE
#define MK_SINGLE 1
#endif
extern "C" void kernel_launch(void* const* d_in, const int* in_sizes, int n_in, void* d_out, int out_size, void* d_ws, size_t ws_size, hipStream_t stream) {
    static int grid = 0;
    if (grid == 0) {
        if (n_in != 25 || in_sizes[0] != T * DM || out_size != T * DM || ws_size < WS_END) { fprintf(stderr, "kernel_launch: unexpected shapes (n_in %d, in0 %d, out %d, ws %zu); nothing launched\n", n_in, n_in > 0 ? in_sizes[0] : -1, out_size, ws_size); grid = -1; return; }
        int dev = 0, cus = 0;
        if (hipGetDevice(&dev) != hipSuccess || hipDeviceGetAttribute(&cus, hipDeviceAttributeMultiprocessorCount, dev) != hipSuccess) { grid = -1; return; }
        if (hipFuncSetAttribute((const void*)mega_fwd, hipFuncAttributeMaxDynamicSharedMemorySize, LDS_BYTES) != hipSuccess) { fprintf(stderr, "kernel_launch: hipFuncSetAttribute failed\n"); grid = -1; return; }
        (void)hipGetLastError();
        int per_cu = 0;
        if (hipOccupancyMaxActiveBlocksPerMultiprocessor(&per_cu, (const void*)mega_fwd, NTHR, LDS_BYTES) != hipSuccess || per_cu < 1) { fprintf(stderr, "kernel_launch: occupancy query says the workgroup does not fit a CU\n"); grid = -1; return; }
        grid = cus;
    }
    if (grid < 0) return;
    if (hipMemsetAsync((char*)d_ws + WS_CTL, 0, CTL_ZERO_BYTES, stream) != hipSuccess) return;
    Args a{};
    for (int i = 0; i < 25; ++i) a.in[i] = (const float*)d_in[i];
    a.out = (float*)d_out; a.ws = (unsigned char*)d_ws;
    if (MK_SINGLE) { a.ph_lo = 0; a.ph_hi = NPHASE; hipLaunchKernelGGL(mega_fwd, dim3(grid), dim3(NTHR), LDS_BYTES, stream, a);
#ifdef PROBE_PHASE
        a.ph_lo = PROBE_PHASE; a.ph_hi = PROBE_PHASE + 1; hipLaunchKernelGGL(mega_fwd, dim3(grid), dim3(NTHR), LDS_BYTES, stream, a);
#endif
    }
    else for (int p = 0; p < NPHASE; ++p) { a.ph_lo = p; a.ph_hi = p + 1; hipLaunchKernelGGL(mega_fwd, dim3(grid), dim3(NTHR), LDS_BYTES, stream, a); }
}
```

```cpp
#include <hip/hip_runtime.h>
#include <cstdio>
#include <cstdint>
#include <cmath>
namespace pg8 {
#define PG8_LAS __attribute__((address_space(3)))
typedef unsigned short bf16_t;
typedef short bf16x8 __attribute__((ext_vector_type(8)));
typedef float f32x4 __attribute__((ext_vector_type(4)));
typedef unsigned u32x4 __attribute__((ext_vector_type(4)));
#define PG8_ZACC(x) (x) = __builtin_amdgcn_mfma_f32_16x16x32_bf16(pg8_zf_, pg8_zf_, (f32x4){0.f, 0.f, 0.f, 0.f}, 0, 0, 0)
#define PG8_ZDECL() const bf16x8 pg8_zf_ = {0, 0, 0, 0, 0, 0, 0, 0}
constexpr int BM = 256, BK = 64, HALF = 128, HTB = HALF * BK * 2  , STAGE_BYTES = 8 * HTB, NXCD = 8, WGM = 8;

__host__ __device__ __forceinline__ int lds_byte(int r, int c) { const int st = (r >> 4) * 2 + (c >> 5), rr = r & 15, cc = c & 31, ob = rr * 64 + cc * 2; return st * 1024 + (ob ^ (((ob >> 9) & 1) << 5)); }
__host__ __device__ __forceinline__ void stage_rc(int b, int& R, int& C) { const int st = b / 1024, sb = b % 1024, swz = sb ^ (((sb >> 9) & 1) << 5); R = (st >> 1) * 16 + swz / 64; C = (st & 1) * 32 + (swz % 64) / 2; }
__host__ __device__ __forceinline__ int perm32(int rho) { const int n = rho >> 4, i = rho & 15; return 8 * (i >> 2) + 4 * n + (i & 3); }

struct Unit { int pm, pn; };
struct Gemm { const bf16_t* A; const bf16_t* Bt; int M, N, K, lda; int sclA = 0x7f7f7f7f, sclB = 0x7f7f7f7f; };

struct StaticOrder {
    int nM, nN, nwg, G, c, wgm = WGM;
    __host__ __device__ void init(int M, int N, int G_, int c_) { nM = M / BM; nN = N / BM; nwg = nM * nN; G = G_; c = c_; }
    __host__ __device__ bool next(int i, Unit& u) const {
        const long L = (long)i * G + c; if (L >= nwg) return false;
        int wgid = (int)L; { const int q = nwg / NXCD, r = nwg % NXCD, xcd = wgid % NXCD, off = wgid / NXCD; wgid = (xcd < r ? xcd * (q + 1) : r * (q + 1) + (xcd - r) * q) + off; }
        const int nig = wgm * nN, gid = wgid / nig, fm = gid * wgm, gsz = (nM - fm) < wgm ? (nM - fm) : wgm;
        u.pm = fm + ((wgid % nig) % gsz); u.pn = (wgid % nig) / gsz; return true;
    }
    __device__ __forceinline__ void a_ready(const Unit&) const {}
    __device__ __forceinline__ void done(const Unit&) const {}
    __device__ __forceinline__ size_t b_off(const Unit&) const { return 0; }
    __device__ __forceinline__ int a_row(const Unit& u, int r) const { return u.pm * BM + r; }
};

__device__ __forceinline__ unsigned cvt_pk_bf16(float lo, float hi) { unsigned r; asm volatile("v_cvt_pk_bf16_f32 %0, %1, %2" : "=v"(r) : "v"(lo), "v"(hi)); return r; }
typedef float f32x2 __attribute__((ext_vector_type(2)));
__device__ __forceinline__ f32x2 gelu_pk(f32x2 v) {
    const f32x2 av = __builtin_elementwise_abs(v), d = av * 0.2316418882f + 1.0f;
    f32x2 t; t.x = __builtin_amdgcn_rcpf(d.x); t.y = __builtin_amdgcn_rcpf(d.y);
    f32x2 q = t * 0.5307027145f + (-0.7265760135f); q = q * t + 0.7107068705f; q = q * t + (-0.142248368f); q = q * t + 0.127414796f; q = q * t;
    const f32x2 s = (v * v) * (-0.72134752044f);
    f32x2 e; e.x = __builtin_amdgcn_exp2f(s.x); e.y = __builtin_amdgcn_exp2f(s.y);
    const f32x2 m = v * (q * e), r = v - m;
    f32x2 o; o.x = v.x < 0.f ? m.x : r.x; o.y = v.y < 0.f ? m.y : r.y; return o;
}

template <int ACT  > struct EpiBf16 {
    static constexpr bool PERM = true, AFTER_DRAIN = false; static_assert(ACT == 0 || ACT == 1, "EpiBf16: ACT is 0 (none) or 1 (gelu_pk)");
    bf16_t* O; int ldc; const float* bias; int split_cols; size_t split_stride; float scale0;
    __device__ __forceinline__ void operator()(f32x4 (&acc)[2][2][4][2], const Unit& u, int wr, int wc, int fr, int fq) const {
        const int row0 = u.pm * BM + wr * 64 + fr; int colt = u.pn * BM; bf16_t* base = O;
        float sc = 1.f; if (split_cols) { const int t = colt / split_cols; base += (size_t)t * split_stride; colt -= t * split_cols; if (t == 0) sc = scale0; }
        const int col0 = colt + wc * 32 + 8 * fq, bcol0 = u.pn * BM + wc * 32 + 8 * fq;
        f32x4 bv[2][2];
#pragma unroll
        for (int bj = 0; bj < 2; ++bj)
#pragma unroll
            for (int n = 0; n < 2; ++n) bv[bj][n] = bias ? *(const f32x4*)(bias + bcol0 + bj * HALF + 4 * n) : (f32x4){0.f, 0.f, 0.f, 0.f};
#pragma unroll
        for (int ai = 0; ai < 2; ++ai)
#pragma unroll
            for (int m = 0; m < 4; ++m) { bf16_t* rowp = base + (size_t)(row0 + ai * HALF + m * 16) * ldc + col0;
#pragma unroll
                for (int bj = 0; bj < 2; ++bj) { f32x4 v0 = acc[ai][bj][m][0] + bv[bj][0], v1 = acc[ai][bj][m][1] + bv[bj][1];
                    if (ACT == 1) { f32x2 a = gelu_pk((f32x2){v0[0], v0[1]}), b = gelu_pk((f32x2){v0[2], v0[3]}), c = gelu_pk((f32x2){v1[0], v1[1]}), d = gelu_pk((f32x2){v1[2], v1[3]});
                        v0 = (f32x4){a.x, a.y, b.x, b.y}; v1 = (f32x4){c.x, c.y, d.x, d.y}; }
                    v0 = v0 * sc; v1 = v1 * sc; u32x4 w; w.x = cvt_pk_bf16(v0[0], v0[1]); w.y = cvt_pk_bf16(v0[2], v0[3]); w.z = cvt_pk_bf16(v1[0], v1[1]); w.w = cvt_pk_bf16(v1[2], v1[3]);
                    *(u32x4*)(rowp + bj * HALF) = w; } }
    }
};
__device__ __forceinline__ float bf_lo(unsigned w) { return __uint_as_float(w << 16); }
__device__ __forceinline__ float bf_hi(unsigned w) { return __uint_as_float(w & 0xffff0000u); }
__device__ __forceinline__ float sigmoidf_(float x) { return __builtin_amdgcn_rcpf(1.0f + __expf(-x)); }
template <class F> struct EpiPerm8 {
    static constexpr bool PERM = true, AFTER_DRAIN = false;
    F f;
    __device__ __forceinline__ void operator()(f32x4 (&acc)[2][2][4][2], const Unit& u, int wr, int wc, int fr, int fq) const {
        PG8_ZDECL();
        const int row0 = u.pm * BM + wr * 64 + fr, col0 = u.pn * BM + wc * 32 + 8 * fq;
#pragma unroll
        for (int ai = 0; ai < 2; ++ai)
#pragma unroll
            for (int m = 0; m < 4; ++m)
#pragma unroll
                for (int bj = 0; bj < 2; ++bj) { float v[8]; const f32x4 v0 = acc[ai][bj][m][0], v1 = acc[ai][bj][m][1];
                    v[0] = v0[0]; v[1] = v0[1]; v[2] = v0[2]; v[3] = v0[3]; v[4] = v1[0]; v[5] = v1[1]; v[6] = v1[2]; v[7] = v1[3];
                    f(u, row0 + ai * HALF + m * 16, col0 + bj * HALF, v); PG8_ZACC(acc[ai][bj][m][0]); PG8_ZACC(acc[ai][bj][m][1]); }
    }
};
__device__ __forceinline__ u32x4 pack8bf(const float (&v)[8]) { u32x4 w; w.x = cvt_pk_bf16(v[0], v[1]); w.y = cvt_pk_bf16(v[2], v[3]); w.z = cvt_pk_bf16(v[4], v[5]); w.w = cvt_pk_bf16(v[6], v[7]); return w; }
struct FStoreBf16 { bf16_t* O; int ldc;
    __device__ __forceinline__ void operator()(const Unit&, int row, int col, float (&v)[8]) const { *(u32x4*)(O + (size_t)row * ldc + col) = pack8bf(v); } };
struct FStoreProj { bf16_t* O; int ldc; bf16_t* QL; bf16_t* KVL;
    __device__ __forceinline__ void operator()(const Unit& u, int row, int col, float (&v)[8]) const { const u32x4 w = pack8bf(v); __builtin_nontemporal_store(w, (u32x4*)(O + (size_t)row * ldc + col));
        if (u.pn >= 10 && u.pn <= 12) { if (col >= 2576 && col < 2960) *(u32x4*)(QL + (size_t)row * 384 + (col - 2576)) = w; else if (col >= 2960 && col < 3216) *(u32x4*)(KVL + (size_t)row * 256 + (col - 2960)) = w; } } };
struct FGate1 { const bf16_t* gate; int ldg; bf16_t* O; int ldc;
    __device__ __forceinline__ void operator()(const Unit&, int row, int col, float (&v)[8]) const {
        const u32x4 g = *(const u32x4*)(gate + (size_t)row * ldg + col);
        v[0] *= sigmoidf_(bf_lo(g.x)); v[1] *= sigmoidf_(bf_hi(g.x)); v[2] *= sigmoidf_(bf_lo(g.y)); v[3] *= sigmoidf_(bf_hi(g.y));
        v[4] *= sigmoidf_(bf_lo(g.z)); v[5] *= sigmoidf_(bf_hi(g.z)); v[6] *= sigmoidf_(bf_lo(g.w)); v[7] *= sigmoidf_(bf_hi(g.w));
        *(u32x4*)(O + (size_t)row * ldc + col) = pack8bf(v); } };
struct FGate2 { const bf16_t* gate; int ldg; bf16_t* O; int ldc;
    __device__ __forceinline__ void operator()(const Unit&, int row, int col, float (&v)[8]) const {
        const u32x4 g = *(const u32x4*)(gate + (size_t)row * ldg + col); const u32x4 o = *(const u32x4*)(O + (size_t)row * ldc + col);
        v[0] = bf_lo(o.x) + v[0] * sigmoidf_(bf_lo(g.x)); v[1] = bf_hi(o.x) + v[1] * sigmoidf_(bf_hi(g.x)); v[2] = bf_lo(o.y) + v[2] * sigmoidf_(bf_lo(g.y)); v[3] = bf_hi(o.y) + v[3] * sigmoidf_(bf_hi(g.y));
        v[4] = bf_lo(o.z) + v[4] * sigmoidf_(bf_lo(g.z)); v[5] = bf_hi(o.z) + v[5] * sigmoidf_(bf_hi(g.z)); v[6] = bf_lo(o.w) + v[6] * sigmoidf_(bf_lo(g.w)); v[7] = bf_hi(o.w) + v[7] * sigmoidf_(bf_hi(g.w));
        *(u32x4*)(O + (size_t)row * ldc + col) = pack8bf(v); } };
struct FResF32 { const float* base; float* out; int ldc;
    __device__ __forceinline__ void operator()(const Unit&, int row, int col, float (&v)[8]) const {
        const f32x4 b0 = *(const f32x4*)(base + (size_t)row * ldc + col), b1 = *(const f32x4*)(base + (size_t)row * ldc + col + 4);
        *(f32x4*)(out + (size_t)row * ldc + col) = (f32x4){b0[0] + v[0], b0[1] + v[1], b0[2] + v[2], b0[3] + v[3]};
        *(f32x4*)(out + (size_t)row * ldc + col + 4) = (f32x4){b1[0] + v[4], b1[1] + v[5], b1[2] + v[6], b1[3] + v[7]}; } };
template <class G> struct EpiPipe8 {
    static constexpr bool PERM = true, AFTER_DRAIN = false;
    G f;
    __device__ __forceinline__ void operator()(f32x4 (&acc)[2][2][4][2], const Unit& u, int wr, int wc, int fr, int fq) const {
        const int row0 = u.pm * BM + wr * 64 + fr, col0 = u.pn * BM + wc * 32 + 8 * fq;
        PG8_ZDECL();
        constexpr int D = G::DEPTH;
        typename G::L l[D];
#pragma unroll
        for (int g = 0; g < D; ++g) f.load(u, row0 + (g >> 3) * HALF + ((g >> 1) & 3) * 16, col0 + (g & 1) * HALF, l[g]);
#pragma unroll
        for (int g = 0; g < 16; ++g) { const int ai = g >> 3, m = (g >> 1) & 3, bj = g & 1; float v[8]; const f32x4 v0 = acc[ai][bj][m][0], v1 = acc[ai][bj][m][1];
            v[0] = v0[0]; v[1] = v0[1]; v[2] = v0[2]; v[3] = v0[3]; v[4] = v1[0]; v[5] = v1[1]; v[6] = v1[2]; v[7] = v1[3];
            f.apply(u, row0 + ai * HALF + m * 16, col0 + bj * HALF, v, l[g % D]); PG8_ZACC(acc[ai][bj][m][0]); PG8_ZACC(acc[ai][bj][m][1]);
            if (g + D < 16) { const int g2 = g + D; f.load(u, row0 + (g2 >> 3) * HALF + ((g2 >> 1) & 3) * 16, col0 + (g2 & 1) * HALF, l[g % D]); } }
    }
};
__device__ __forceinline__ f32x2 sig2_bf(unsigned w) { f32x2 t = (f32x2){bf_lo(w), bf_hi(w)} * (-1.4426950408889634f); t.x = __builtin_amdgcn_exp2f(t.x); t.y = __builtin_amdgcn_exp2f(t.y);
    const f32x2 d = t + 1.0f; f32x2 r; r.x = __builtin_amdgcn_rcpf(d.x); r.y = __builtin_amdgcn_rcpf(d.y); return r; }
struct GGate1 { const bf16_t* gate; int ldg; bf16_t* O; int ldc;
    typedef u32x4 L; static constexpr int DEPTH = 16;
    __device__ __forceinline__ void load(const Unit&, int row, int col, L& g) const { g = *(const u32x4*)(gate + (size_t)row * ldg + col); }
    __device__ __forceinline__ void apply(const Unit&, int row, int col, float (&v)[8], const L& g) const {
        const f32x2 a = (f32x2){v[0], v[1]} * sig2_bf(g.x), b = (f32x2){v[2], v[3]} * sig2_bf(g.y), c = (f32x2){v[4], v[5]} * sig2_bf(g.z), d = (f32x2){v[6], v[7]} * sig2_bf(g.w);
        u32x4 w; w.x = cvt_pk_bf16(a.x, a.y); w.y = cvt_pk_bf16(b.x, b.y); w.z = cvt_pk_bf16(c.x, c.y); w.w = cvt_pk_bf16(d.x, d.y);
        *(u32x4*)(O + (size_t)row * ldc + col) = w; } };
struct GGate2 { const bf16_t* gate; int ldg; bf16_t* O; int ldc;
    struct L { u32x4 g, o; }; static constexpr int DEPTH = 6;
    __device__ __forceinline__ void load(const Unit&, int row, int col, L& l) const { l.g = *(const u32x4*)(gate + (size_t)row * ldg + col); l.o = *(const u32x4*)(O + (size_t)row * ldc + col); }
    __device__ __forceinline__ void apply(const Unit&, int row, int col, float (&v)[8], const L& l) const { const u32x4 g = l.g, o = l.o;
        const f32x2 a = (f32x2){v[0], v[1]} * sig2_bf(g.x) + (f32x2){bf_lo(o.x), bf_hi(o.x)}, b = (f32x2){v[2], v[3]} * sig2_bf(g.y) + (f32x2){bf_lo(o.y), bf_hi(o.y)};
        const f32x2 c = (f32x2){v[4], v[5]} * sig2_bf(g.z) + (f32x2){bf_lo(o.z), bf_hi(o.z)}, d = (f32x2){v[6], v[7]} * sig2_bf(g.w) + (f32x2){bf_lo(o.w), bf_hi(o.w)};
        u32x4 w; w.x = cvt_pk_bf16(a.x, a.y); w.y = cvt_pk_bf16(b.x, b.y); w.z = cvt_pk_bf16(c.x, c.y); w.w = cvt_pk_bf16(d.x, d.y);
        *(u32x4*)(O + (size_t)row * ldc + col) = w; } };
struct GResF32 { const float* base; float* out; int ldc;
    struct L { f32x4 b0, b1; }; static constexpr int DEPTH = 6;
    __device__ __forceinline__ void load(const Unit&, int row, int col, L& l) const { l.b0 = *(const f32x4*)(base + (size_t)row * ldc + col); l.b1 = *(const f32x4*)(base + (size_t)row * ldc + col + 4); }
    __device__ __forceinline__ void apply(const Unit&, int row, int col, float (&v)[8], const L& l) const {
        *(f32x4*)(out + (size_t)row * ldc + col) = (f32x4){l.b0[0] + v[0], l.b0[1] + v[1], l.b0[2] + v[2], l.b0[3] + v[3]};
        *(f32x4*)(out + (size_t)row * ldc + col + 4) = (f32x4){l.b1[0] + v[4], l.b1[1] + v[5], l.b1[2] + v[6], l.b1[3] + v[7]}; } };
#ifndef MOE_WGM
#define MOE_WGM 2
#endif
struct MoeOrder {
    StaticOrder so; const int* rowtok; const int* mte; size_t bstride;
    __device__ void init(int nmt, int N, int G_, int c_, const int* rowtok_, const int* mte_, size_t bstride_) { so.init(nmt * BM, N, G_, c_); so.wgm = MOE_WGM; rowtok = rowtok_; mte = mte_; bstride = bstride_; }
    __device__ bool next(int i, Unit& u) const { return so.next(i, u); }
    __device__ __forceinline__ void a_ready(const Unit&) const {}
    __device__ __forceinline__ void done(const Unit&) const {}
    __device__ __forceinline__ size_t b_off(const Unit& u) const { return (size_t)mte[u.pm] * bstride; }
    __device__ __forceinline__ int a_row(const Unit& u, int r) const { return rowtok ? rowtok[u.pm * BM + r] : u.pm * BM + r; }
};
struct EpiGateUp {
    static constexpr bool PERM = true, AFTER_DRAIN = false;
    const float* bgu; const int* mte; unsigned char* ACT;
    static __device__ __forceinline__ f32x2 act2(f32x2 g, f32x2 l) {
        g.x = fminf(g.x, 7.0f); g.y = fminf(g.y, 7.0f); l.x = fminf(fmaxf(l.x, -7.0f), 7.0f); l.y = fminf(fmaxf(l.y, -7.0f), 7.0f);
        f32x2 t = g * (-1.702f * 1.4426950408889634f); t.x = __builtin_amdgcn_exp2f(t.x); t.y = __builtin_amdgcn_exp2f(t.y);
        const f32x2 d = t + 1.0f; f32x2 r; r.x = __builtin_amdgcn_rcpf(d.x); r.y = __builtin_amdgcn_rcpf(d.y);
        return (g * r) * (l * 4.0f + 4.0f);
    }
    __device__ __forceinline__ void operator()(f32x4 (&acc)[2][2][4][2], const Unit& u, int wr, int wc, int fr, int fq) const {
        PG8_ZDECL();
        const int e = mte[u.pm], row0 = u.pm * BM + wr * 64 + fr, j0 = u.pn * HALF + wc * 32 + 8 * fq;
        const float* bg = bgu + (size_t)e * 2048 + j0; const float* bl = bg + 1024;
        const f32x4 bgv[2] = {*(const f32x4*)bg, *(const f32x4*)(bg + 4)}, blv[2] = {*(const f32x4*)bl, *(const f32x4*)(bl + 4)};
#pragma unroll
        for (int ai = 0; ai < 2; ++ai)
#pragma unroll
            for (int m = 0; m < 4; ++m) { int w[2];
#pragma unroll
                for (int h = 0; h < 2; ++h) { const f32x4 G = acc[ai][0][m][h] + bgv[h], L = acc[ai][1][m][h] + blv[h];
                    const f32x2 v01 = act2((f32x2){G[0], G[1]}, (f32x2){L[0], L[1]}), v23 = act2((f32x2){G[2], G[3]}, (f32x2){L[2], L[3]});
                    w[h] = __builtin_amdgcn_cvt_pk_fp8_f32(v01.x, v01.y, 0, false); w[h] = __builtin_amdgcn_cvt_pk_fp8_f32(v23.x, v23.y, w[h], true); }
                typedef unsigned u32x2_ __attribute__((ext_vector_type(2))); *(u32x2_*)(ACT + (size_t)(row0 + ai * HALF + m * 16) * 1024 + j0) = (u32x2_){(unsigned)w[0], (unsigned)w[1]};
                PG8_ZACC(acc[ai][0][m][0]); PG8_ZACC(acc[ai][0][m][1]); PG8_ZACC(acc[ai][1][m][0]); PG8_ZACC(acc[ai][1][m][1]); }
    }
};
struct EpiDown {
    static constexpr bool PERM = true, AFTER_DRAIN = false;
    const float* bdn; const int* mte; bf16_t* YS;
    __device__ __forceinline__ void operator()(f32x4 (&acc)[2][2][4][2], const Unit& u, int wr, int wc, int fr, int fq) const {
        const int row0 = u.pm * BM + wr * 64 + fr, col0 = u.pn * BM + wc * 32 + 8 * fq;
        PG8_ZDECL();
        const float* b = bdn + (size_t)mte[u.pm] * 1024 + col0;
        f32x4 bv[2][2];
#pragma unroll
        for (int bj = 0; bj < 2; ++bj) { bv[bj][0] = *(const f32x4*)(b + bj * HALF); bv[bj][1] = *(const f32x4*)(b + bj * HALF + 4); }
#pragma unroll
        for (int ai = 0; ai < 2; ++ai)
#pragma unroll
            for (int m = 0; m < 4; ++m)
#pragma unroll
                for (int bj = 0; bj < 2; ++bj) { const f32x4 v0 = acc[ai][bj][m][0] + bv[bj][0], v1 = acc[ai][bj][m][1] + bv[bj][1];
                    u32x4 w; w.x = cvt_pk_bf16(v0[0], v0[1]); w.y = cvt_pk_bf16(v0[2], v0[3]); w.z = cvt_pk_bf16(v1[0], v1[1]); w.w = cvt_pk_bf16(v1[2], v1[3]);
                    *(u32x4*)(YS + (size_t)(row0 + ai * HALF + m * 16) * 1024 + col0 + bj * HALF) = w; PG8_ZACC(acc[ai][bj][m][0]); PG8_ZACC(acc[ai][bj][m][1]); }
    }
};
typedef int v4i_t __attribute__((ext_vector_type(4)));
typedef int v8i_t __attribute__((ext_vector_type(8)));
typedef float f32x8_t __attribute__((ext_vector_type(8)));
template <class Epi, class Sched, bool ALIGN_EPI = false, bool SP2 = true, bool FP8 = false>
__device__ __forceinline__ void gemm_phase(PG8_LAS unsigned char* lds, const Gemm g, const Sched& S, const Epi& E) {
    static_assert(SP2, "only the two-super-phase loop is kept in this file");
    const int tid = threadIdx.x, wid = __builtin_amdgcn_readfirstlane(tid >> 6), lane = tid & 63, wr = wid >> 2, wc = wid & 3, fr = lane & 15, fq = lane >> 4;
    const int K = g.K, nt = K / BK;
    unsigned vA0[2], vA1[2], nA0[2], nA1[2], voffB[2]; int RA[2], CA[2];
#pragma unroll
    for (int i = 0; i < 2; ++i) { int R, C; stage_rc(tid * 16 + i * 8192, R, C); const int Rb = Epi::PERM ? ((R & ~31) + perm32(R & 31)) : R;
        RA[i] = R; CA[i] = C; voffB[i] = (unsigned)(Rb * K + C) * 2u; }
    const size_t kstep = (size_t)(BK * 2);
    const size_t hstepB = (size_t)HALF * K * 2;
    const size_t tstepB = 2 * hstepB;
    const unsigned ldsw = (unsigned)wid * 1024u;
    const int aoff = lds_byte(wr * 64 + fr, fq * 8), boff = lds_byte(wc * 32 + fr, fq * 8);
#define PG8_SA(b, h) (((b) * 2 + (h)) * HTB)
#define PG8_SB(b, h) ((4 + (b) * 2 + (h)) * HTB)
#define PG8_STAGE(bufoff, gbase, voff) do { _Pragma("unroll") for (int _i = 0; _i < 2; ++_i) \
        __builtin_amdgcn_global_load_lds((const unsigned*)((const char*)(gbase) + (voff)[_i]), (PG8_LAS unsigned*)(lds + (bufoff) + ldsw + _i * 8192), 16, 0, 0); } while (0)
#define PG8_LDA(dst, dst8, b, h) do { if constexpr (!FP8) { _Pragma("unroll") for (int m = 0; m < 4; ++m) _Pragma("unroll") for (int k = 0; k < 2; ++k) dst[m][k] = *(const PG8_LAS bf16x8*)(lds + PG8_SA(b, h) + aoff + m * 2048 + k * 1024); } \
      else { _Pragma("unroll") for (int m = 0; m < 4; ++m) { const v4i_t lo_ = *(const PG8_LAS v4i_t*)(lds + PG8_SA(b, h) + aoff + m * 2048), hi_ = *(const PG8_LAS v4i_t*)(lds + PG8_SA(b, h) + aoff + m * 2048 + 1024); dst8[m] = __builtin_shufflevector(lo_, hi_, 0, 1, 2, 3, 4, 5, 6, 7); } } } while (0)
#define PG8_LDB(dst, dst8, b, h) do { if constexpr (!FP8) { _Pragma("unroll") for (int n = 0; n < 2; ++n) _Pragma("unroll") for (int k = 0; k < 2; ++k) dst[n][k] = *(const PG8_LAS bf16x8*)(lds + PG8_SB(b, h) + boff + n * 2048 + k * 1024); } \
      else { _Pragma("unroll") for (int n = 0; n < 2; ++n) { const v4i_t lo_ = *(const PG8_LAS v4i_t*)(lds + PG8_SB(b, h) + boff + n * 2048), hi_ = *(const PG8_LAS v4i_t*)(lds + PG8_SB(b, h) + boff + n * 2048 + 1024); dst8[n] = __builtin_shufflevector(lo_, hi_, 0, 1, 2, 3, 4, 5, 6, 7); } } } while (0)
#define PG8_MMA(ai, bj, At, Bt, At8, Bt8) do { __builtin_amdgcn_s_setprio(1); if constexpr (!FP8) { _Pragma("unroll") for (int m = 0; m < 4; ++m) _Pragma("unroll") for (int n = 0; n < 2; ++n) _Pragma("unroll") for (int k = 0; k < 2; ++k) \
        acc[ai][bj][m][n] = __builtin_amdgcn_mfma_f32_16x16x32_bf16(Bt[n][k], At[m][k], acc[ai][bj][m][n], 0, 0, 0); } \
      else { _Pragma("unroll") for (int m = 0; m < 4; ++m) _Pragma("unroll") for (int n = 0; n < 2; ++n)   \
        asm volatile("v_mfma_scale_f32_16x16x128_f8f6f4 %0, %1, %2, %0, %3, %4 op_sel_hi:[0,0,0]" : "+v"(acc[ai][bj][m][n]) : "v"(Bt8[n]), "v"(At8[m]), "v"(sclB), "v"(sclA)); } \
      __builtin_amdgcn_s_setprio(0); } while (0)
#define PG8_WAIT_V(n) asm volatile("s_waitcnt vmcnt(" #n ")" ::: "memory")
#define PG8_WAIT_L(n) asm volatile("s_waitcnt lgkmcnt(" #n ")" ::: "memory")
#define PG8_BAR __builtin_amdgcn_s_barrier()
#define PG8_SCHED __builtin_amdgcn_sched_barrier(0)
#define PG8_AROWS(d0, d1, u) do { _Pragma("unroll") for (int _i = 0; _i < 2; ++_i) { d0[_i] = (unsigned)((size_t)S.a_row(u, RA[_i]) * g.lda + CA[_i]) * 2u; d1[_i] = (unsigned)((size_t)S.a_row(u, HALF + RA[_i]) * g.lda + CA[_i]) * 2u; } } while (0)
    Unit cur, nxt; int ui = 0;
    if (!S.next(0, cur)) return;
    f32x4 acc[2][2][4][2];
#pragma unroll
    for (int a = 0; a < 2; ++a)
#pragma unroll
        for (int b = 0; b < 2; ++b)
#pragma unroll
            for (int m = 0; m < 4; ++m)
#pragma unroll
                for (int n = 0; n < 2; ++n) acc[a][b][m][n] = (f32x4){0.f, 0.f, 0.f, 0.f};
    bf16x8 At[4][2], B0[2][2], B1[2][2]; v8i_t At8[4], B08[2], B18[2]; const int sclA = g.sclA, sclB = g.sclB; (void)At8; (void)B08; (void)B18; (void)sclA; (void)sclB;
    const char* const gA = (const char*)g.A;
    const char* cB = (const char*)g.Bt + (size_t)cur.pn * tstepB + S.b_off(cur);
    PG8_AROWS(vA0, vA1, cur);
    S.a_ready(cur);
    PG8_STAGE(PG8_SB(0, 0), cB, voffB); PG8_STAGE(PG8_SB(0, 1), cB + hstepB, voffB); PG8_STAGE(PG8_SA(0, 0), gA, vA0); PG8_STAGE(PG8_SA(0, 1), gA, vA1);
    if (wr == 1) PG8_BAR;
    PG8_WAIT_V(2); PG8_BAR;
    PG8_STAGE(PG8_SB(1, 0), cB + kstep, voffB); PG8_STAGE(PG8_SA(1, 0), gA + kstep, vA0); PG8_STAGE(PG8_SB(1, 1), cB + hstepB + kstep, voffB);
    PG8_WAIT_V(6); PG8_BAR;
    for (;;) {
        const bool has_next = S.next(ui + 1, nxt);
        const char* nB = has_next ? (const char*)g.Bt + (size_t)nxt.pn * tstepB + S.b_off(nxt) : cB;
        if (has_next) { PG8_AROWS(nA0, nA1, nxt); } else { nA0[0] = vA0[0]; nA0[1] = vA0[1]; nA1[0] = vA1[0]; nA1[1] = vA1[1]; }
#pragma unroll 1
        for (int t = 0; t < nt; t += 2) {
            const bool last = (t == nt - 2);
            const char* a1 = gA + (size_t)(t + 1) * kstep;
            const char* a2 = last ? gA : gA + (size_t)(t + 2) * kstep; const char* b2 = last ? nB : cB + (size_t)(t + 2) * kstep;
            const char* a3 = a2 + kstep; const char* b3 = b2 + kstep;
            unsigned x0[2], x1[2]; x0[0] = last ? nA0[0] : vA0[0]; x0[1] = last ? nA0[1] : vA0[1]; x1[0] = last ? nA1[0] : vA1[0]; x1[1] = last ? nA1[1] : vA1[1];
            if (last && has_next) S.a_ready(nxt);
            PG8_LDB(B0, B08, 0, 0); PG8_LDB(B1, B18, 0, 1); PG8_SCHED; PG8_LDA(At, At8, 0, 0); PG8_STAGE(PG8_SA(1, 1), a1, vA1);
            PG8_WAIT_V(8); PG8_WAIT_L(0); PG8_BAR; PG8_MMA(0, 0, At, B0, At8, B08); PG8_MMA(0, 1, At, B1, At8, B18); PG8_BAR; PG8_SCHED;
            PG8_LDA(At, At8, 0, 1); PG8_STAGE(PG8_SB(0, 0), b2, voffB); PG8_STAGE(PG8_SB(0, 1), b2 + hstepB, voffB); PG8_STAGE(PG8_SA(0, 0), a2, x0);
            PG8_WAIT_V(8); PG8_WAIT_L(0); PG8_BAR; PG8_MMA(1, 0, At, B0, At8, B08); PG8_MMA(1, 1, At, B1, At8, B18); PG8_BAR; PG8_SCHED;
            PG8_LDB(B0, B08, 1, 0); PG8_LDB(B1, B18, 1, 1); PG8_SCHED; PG8_LDA(At, At8, 1, 0); PG8_STAGE(PG8_SA(0, 1), a2, x1);
            PG8_WAIT_V(8); PG8_WAIT_L(0); PG8_BAR; PG8_MMA(0, 0, At, B0, At8, B08); PG8_MMA(0, 1, At, B1, At8, B18); PG8_BAR; PG8_SCHED;
            PG8_LDA(At, At8, 1, 1); PG8_STAGE(PG8_SB(1, 0), b3, voffB); PG8_STAGE(PG8_SB(1, 1), b3 + hstepB, voffB); PG8_STAGE(PG8_SA(1, 0), a3, x0);
            PG8_WAIT_V(8); PG8_WAIT_L(0); PG8_BAR; PG8_MMA(1, 0, At, B0, At8, B08); PG8_MMA(1, 1, At, B1, At8, B18); PG8_BAR; PG8_SCHED;
        }
        if constexpr (ALIGN_EPI) { if (wr == 0) PG8_BAR; }
        if constexpr (FP8) asm volatile("s_nop 15\n\ts_nop 7" ::: "memory");
        if constexpr (!Epi::AFTER_DRAIN) { E(acc, cur, wr, wc, fr, fq); S.done(cur); }
        if (!has_next) break;
        cur = nxt; cB = nB; ++ui; vA0[0] = nA0[0]; vA0[1] = nA0[1]; vA1[0] = nA1[0]; vA1[1] = nA1[1];
        if constexpr (ALIGN_EPI) { if (wr == 1) PG8_BAR; }
    }
    PG8_WAIT_V(0);
    if constexpr (!ALIGN_EPI) { if (wr == 0) PG8_BAR; }
    PG8_BAR;
    if constexpr (Epi::AFTER_DRAIN) { E.fused(acc, cur, wr, wc, fr, fq, lds, wid, lane); S.done(cur); }
#undef PG8_SA
#undef PG8_SB
#undef PG8_STAGE
#undef PG8_LDA
#undef PG8_LDB
#undef PG8_MMA
#undef PG8_WAIT_V
#undef PG8_WAIT_L
#undef PG8_BAR
#undef PG8_SCHED
#undef PG8_AROWS
}
}
constexpr int NWAVES = 8, NTHR = 512;
constexpr int BATCH = 2, SEQ = 8192, DM = 1024, T = BATCH * SEQ;
constexpr int CHUNK = 64, NCHUNK = SEQ / CHUNK;
constexpr int SSD_H = 16, SSD_P = 64, SSD_G = 2, SSD_HPG = 8, SSD_N = 128, CONV_DIM = 1536;
constexpr int MLA_H = 8, QRANK = 384, KVRANK = 256, NOPE = 128, ROPE = 64, QKD = 192, VD = 128;
constexpr int NE = 32, TOPK = 4, FF = 1024;
constexpr int OFF_XBC = 1024, OFF_DT = 2560, OFF_QLAT = 2576, OFF_KVLAT = 2960, OFF_KROPE = 3216, OFF_GATE = 3280, IN_DIM = 5328, IN_PAD = 5376;
constexpr float EPS = 1e-6f;
constexpr int MT_MAX = 288, NSLOT_MAX = MT_MAX * 256;
constexpr float WGU_SCALE = 512.f, H2_SCALE = 16.f;
constexpr float QSCALE = 0.07216878364870322f * 1.4426950408889634f;

constexpr size_t MiB = 1u << 20;
constexpr size_t WS_CTL = 0, CTL_ZERO_BYTES = 1 * MiB;
constexpr size_t WS_WIN = 896 * MiB, WS_WQ = 907 * MiB, WS_WKV = 909 * MiB, WS_WSSD = 911 * MiB, WS_WMLA = 913 * MiB, WS_WO = 915 * MiB, WS_WGU = 22 * MiB, WS_WDN = 150 * MiB;
constexpr size_t WS_XN = 864 * MiB, WS_YN = 246 * MiB, WS_OATT = 278 * MiB, WS_MRG = 310 * MiB;
constexpr size_t WS_ACUM = 342 * MiB, WS_TOPI = 343 * MiB, WS_TOPG = WS_TOPI + 256 * 1024, WS_SLOT = WS_TOPG + 256 * 1024, WS_CNT = WS_SLOT + 256 * 1024;
constexpr size_t WS_ROWTOK = 344 * MiB, WS_MTE = WS_ROWTOK + 512 * 1024, WS_CDEC = WS_MTE + 64 * 1024;
constexpr size_t WS_ROPE = 346 * MiB;
constexpr size_t WS_QLAT = 917 * MiB, WS_KVLAT = 929 * MiB;
constexpr size_t WS_CONVC = 352 * MiB;
constexpr size_t WS_PROJ = 696 * MiB, WS_QPRE = 528 * MiB, WS_KVPRE = 576 * MiB, WS_Q = 360 * MiB, WS_K = 408 * MiB, WS_V = 456 * MiB, WS_XC = 624 * MiB, WS_YDIAG = 592 * MiB, WS_STATES = 528 * MiB;
constexpr size_t WS_ACT = 360 * MiB, WS_YS = 504 * MiB;
constexpr size_t WS_SSQ = 937 * MiB, WS_RQ = 941 * MiB;
constexpr size_t WS_SMAX = WS_RQ + 512 * 1024;
constexpr size_t WS_END = 944 * MiB;
static_assert(WS_ACT + (size_t)NSLOT_MAX * FF * 2 <= WS_YS && WS_YS + (size_t)NSLOT_MAX * DM * 2 <= WS_END, "moe overlay");
static_assert(WS_PROJ + (size_t)T * IN_PAD * 2 <= WS_XN, "proj");
constexpr int CW_TMO = 0, CW_CODE = 1, CW_BAR = 4096;

constexpr int RING_OFF = 0, RING_BYTES = 131072;
constexpr int LDSCTL_OFF = RING_BYTES, MISC_OFF = LDSCTL_OFF + 320;
constexpr int LDS_BYTES = 147456;

#define GAS __attribute__((address_space(1)))
#define LAS __attribute__((address_space(3)))
typedef unsigned short bf16;
typedef unsigned v4u __attribute__((ext_vector_type(4)));
typedef unsigned v2u __attribute__((ext_vector_type(2)));
typedef float f32x4 __attribute__((ext_vector_type(4)));
typedef float f32x2 __attribute__((ext_vector_type(2)));
typedef short bf16x8 __attribute__((ext_vector_type(8)));
typedef GAS unsigned gu32;
typedef GAS unsigned long long gu64;
#define RLX_AGENT __ATOMIC_RELAXED, __HIP_MEMORY_SCOPE_AGENT
#define LDS_WAIT() asm volatile("s_waitcnt lgkmcnt(0)" ::: "memory")
#define VM_WAIT() asm volatile("s_waitcnt vmcnt(0)" ::: "memory")
__device__ __forceinline__ unsigned f2bf(float f) { unsigned u = __builtin_bit_cast(unsigned, f); return (u + 0x7fffu + ((u >> 16) & 1u)) >> 16; }
typedef float pkf32x2_ __attribute__((ext_vector_type(2))); typedef __bf16 pkbf16x2_ __attribute__((ext_vector_type(2)));
__device__ __forceinline__ unsigned pk2(float lo, float hi) { const pkbf16x2_ r = __builtin_convertvector((pkf32x2_){lo, hi}, pkbf16x2_); return __builtin_bit_cast(unsigned, r); }
__device__ __forceinline__ float bf2f(unsigned short b) { return __uint_as_float((unsigned)b << 16); }
__device__ __forceinline__ float blo(unsigned w) { return __uint_as_float(w << 16); }
__device__ __forceinline__ float bhi(unsigned w) { return __uint_as_float(w & 0xffff0000u); }
__device__ __forceinline__ void unpack8(const v4u w, float (&v)[8]) { v[0] = blo(w.x); v[1] = bhi(w.x); v[2] = blo(w.y); v[3] = bhi(w.y); v[4] = blo(w.z); v[5] = bhi(w.z); v[6] = blo(w.w); v[7] = bhi(w.w); }
__device__ __forceinline__ v4u pack8(const float (&v)[8]) { v4u w; w.x = pk2(v[0], v[1]); w.y = pk2(v[2], v[3]); w.z = pk2(v[4], v[5]); w.w = pk2(v[6], v[7]); return w; }
__device__ __forceinline__ float wave_sum(float v) {
#pragma unroll
    for (int o = 1; o < 64; o <<= 1) v += __shfl_xor(v, o);
    return v;
}
__device__ __forceinline__ float wave_max(float v) {
#pragma unroll
    for (int o = 1; o < 64; o <<= 1) v = fmaxf(v, __shfl_xor(v, o));
    return v;
}
__device__ __forceinline__ float siluf_(float x) { return x * __builtin_amdgcn_rcpf(1.0f + __expf(-x)); }
__device__ __forceinline__ float softplusf_(float x) { return x > 20.f ? x : log1pf(__expf(x)); }
#define XB_TMO      128
#define XB_XCNT(j)  (256  + 64 * (j))
#define XB_XSUB(j)  (1280 + 64 * (j))
#define XB_XGEN(j)  (2304 + 64 * (j))
#define XB_TOP      3328
#define XB_TOPGEN   3392
#define XCD_BAR_WORDS 3456
#define XB_SPIN_CAP (1u << 18)

__device__ __forceinline__ unsigned xb_ld(unsigned* p)              { return __hip_atomic_load(p, __ATOMIC_RELAXED, __HIP_MEMORY_SCOPE_AGENT); }
__device__ __forceinline__ unsigned xb_add(unsigned* p, unsigned v) { return __hip_atomic_fetch_add(p, v, __ATOMIC_RELAXED, __HIP_MEMORY_SCOPE_AGENT); }
__device__ __forceinline__ unsigned xb_xcc_id() { return (unsigned)__builtin_amdgcn_s_getreg((3 << 11) | 20) & 0xFu; }
#define XB_SPIN(cond, bar) do { unsigned _sp = 0; while (cond) { __builtin_amdgcn_s_sleep(1); \
    if ((++_sp & 255u) == 0u) { if (xb_ld(&(bar)[XB_TMO])) break; if (_sp > XB_SPIN_CAP) { atomicAdd(&(bar)[XB_TMO], 1u); break; } } } } while (0)

struct XcdBarrier {
    unsigned* bar; unsigned x;
    volatile LAS unsigned* st;
};

__device__ __forceinline__ XcdBarrier xcd_barrier_post(unsigned* bar, volatile LAS unsigned* st) {
    XcdBarrier b; b.bar = bar; b.x = xb_xcc_id(); b.st = st;
    if (threadIdx.x == 0) (void)xb_add(&bar[XB_XCNT(b.x)], 1u);
    return b;
}
__device__ __forceinline__ void xcd_barrier_complete(unsigned* bar, unsigned x, unsigned& nloc, unsigned& nx) {
    const unsigned G = gridDim.x * gridDim.y * gridDim.z;
    unsigned sum, cnt, mine, sp = 0u;
    for (;;) {
        sum = 0u; cnt = 0u; mine = 0u;
#pragma unroll
        for (unsigned j = 0; j < 16; ++j) { const unsigned c = xb_ld(&bar[XB_XCNT(j)]); sum += c; cnt += (c > 0u) ? 1u : 0u; mine = (j == x) ? c : mine; }
        if (sum == G) break;
        __builtin_amdgcn_s_sleep(1);
        if ((++sp & 255u) == 0u) { if (xb_ld(&bar[XB_TMO])) break; if (sp > XB_SPIN_CAP) { atomicAdd(&bar[XB_TMO], 1u); break; } }
    }
    nloc = mine > 0u ? mine : 1u; nx = cnt > 0u ? cnt : 1u;
}

__device__ __forceinline__ void xcd_barrier(const XcdBarrier& b) {
    asm volatile("s_waitcnt vmcnt(0)" ::: "memory");
    __syncthreads();
    if (threadIdx.x == 0) {
        unsigned* bar = b.bar;
        __builtin_amdgcn_s_waitcnt(0);
        unsigned nloc = b.st[0], nx = b.st[1];
        if (nloc == 0u) { xcd_barrier_complete(bar, b.x, nloc, nx); b.st[0] = nloc; b.st[1] = nx; }
        const unsigned old = xb_add(&bar[XB_XSUB(b.x)], 1u);
        const unsigned gen = old / nloc;
        if (old + 1u == (gen + 1u) * nloc) {
            __builtin_amdgcn_fence(__ATOMIC_RELEASE, "agent");
            asm volatile("s_waitcnt vmcnt(0)" ::: "memory");
            const unsigned og = xb_add(&bar[XB_TOP], 1u);
            const unsigned tg = og / nx;
            asm volatile("buffer_inv sc1" ::: "memory");
            if (og + 1u == (tg + 1u) * nx) xb_add(&bar[XB_TOPGEN], 1u);
            else XB_SPIN(xb_ld(&bar[XB_TOPGEN]) == tg, bar);
            asm volatile("s_waitcnt vmcnt(0)" ::: "memory");
            xb_add(&bar[XB_XGEN(b.x)], 1u);
            asm volatile("s_waitcnt vmcnt(0)" ::: "memory");
        } else {
            asm volatile("buffer_inv sc1" ::: "memory");
            XB_SPIN(xb_ld(&bar[XB_XGEN(b.x)]) == gen, bar);
            asm volatile("s_waitcnt vmcnt(0)" ::: "memory");
        }
        asm volatile("" ::: "memory");
    }
    __syncthreads();
}
struct Frame {
    LAS unsigned char* lds;
    volatile LAS unsigned* MISC;
    gu32* ctl;
    int tid, lane, wave;
    int vcu, G;
    const float* in[25]; float* out; unsigned char* ws;
};
#define WSP(T_, off) ((T_*)(F.ws + (off)))
enum { I_X = 0, I_GMIX, I_WIN, I_CONVW, I_CONVB, I_DTB, I_ALOG, I_DSKIP, I_GSSD, I_WSSD, I_GQL, I_WQUP, I_GKVL, I_WKVUP, I_GQKQ, I_GQKK, I_WMLA, I_WO, I_GFFN, I_WR, I_BR, I_WGU, I_BGU, I_WDN, I_BDN };

__device__ __forceinline__ void p0_transpose_item(const float* W, int K, int N, bf16* WT, int n0dst, const float* kscale, LAS float* scr, int kb, int nb, int lane, int pmode = 0) {
    const int k0 = 64 * kb, n0 = 32 * nb;
#pragma unroll
    for (int i = 0; i < 8; ++i) { const int kk = 8 * i + (lane >> 3), n = n0 + 4 * (lane & 7);
        f32x4 v = (n < N) ? __builtin_nontemporal_load((const f32x4*)(W + (size_t)(k0 + kk) * N + n)) : (f32x4){0.f, 0.f, 0.f, 0.f}; if (kscale) v = v * kscale[k0 + kk];
        LAS float* d = scr + kk * 33 + 4 * (lane & 7); d[0] = v[0]; d[1] = v[1]; d[2] = v[2]; d[3] = v[3]; }
    LDS_WAIT(); asm volatile("" ::: "memory");
    const int c = lane & 7;
#pragma unroll
    for (int j = 0; j < 4; ++j) { const int n = (lane >> 3) + 8 * j; const LAS float* s = scr + (8 * c) * 33 + n;
        v4u o; o.x = pk2(s[0 * 33], s[1 * 33]); o.y = pk2(s[2 * 33], s[3 * 33]); o.z = pk2(s[4 * 33], s[5 * 33]); o.w = pk2(s[6 * 33], s[7 * 33]);
        const int nd = pmode ? 8 * (n >> 2) + (n & 3) + (pmode == 2 ? 4 : 0) : n;
        *(v4u*)(WT + (size_t)(n0dst + nd) * K + k0 + 8 * c) = o; }
    LDS_WAIT(); asm volatile("" ::: "memory");
}
__device__ __forceinline__ void rms_row_to_bf16(int lane, const float* xrow, const float* gain, bf16* orow) {
    const f32x4* xr = (const f32x4*)xrow + lane; const f32x4* gr = (const f32x4*)gain + lane;
    f32x4 v[4]; float s = 0.f;
#pragma unroll
    for (int j = 0; j < 4; ++j) { v[j] = __builtin_nontemporal_load(xr + 64 * j); s += (v[j].x * v[j].x + v[j].y * v[j].y) + (v[j].z * v[j].z + v[j].w * v[j].w); }
    const float r = rsqrtf(wave_sum(s) * (1.f / DM) + EPS);
    unsigned long long* o8 = (unsigned long long*)orow + lane;
#pragma unroll
    for (int j = 0; j < 4; ++j) { const f32x4 g = gr[64 * j]; o8[64 * j] = (unsigned long long)pk2(v[j].x * r * g.x, v[j].y * r * g.y) | ((unsigned long long)pk2(v[j].z * r * g.z, v[j].w * r * g.w) << 32); }
}
__device__ __forceinline__ unsigned pk4_fp8(float a, float b, float c, float d);
__device__ __forceinline__ float clamp_e4m3(float v) { return fminf(fmaxf(v, -448.f), 448.f); }
__device__ __forceinline__ void rms_row_to_fp8(int lane, const float* xrow, const float* gain, unsigned char* orow) {
    const f32x4* xr = (const f32x4*)xrow + lane; const f32x4* gr = (const f32x4*)gain + lane;
    f32x4 v[4]; float s = 0.f;
#pragma unroll
    for (int j = 0; j < 4; ++j) { v[j] = __builtin_nontemporal_load(xr + 64 * j); s += (v[j].x * v[j].x + v[j].y * v[j].y) + (v[j].z * v[j].z + v[j].w * v[j].w); }
    const float r = rsqrtf(wave_sum(s) * (1.f / DM) + EPS) * H2_SCALE;
    unsigned* o4 = (unsigned*)orow + lane;
#pragma unroll
    for (int j = 0; j < 4; ++j) { const f32x4 g = gr[64 * j]; o4[64 * j] = pk4_fp8(clamp_e4m3(v[j].x * r * g.x), clamp_e4m3(v[j].y * r * g.y), clamp_e4m3(v[j].z * r * g.z), clamp_e4m3(v[j].w * r * g.w)); }
}
__device__ __forceinline__ unsigned pk4_fp8(float a, float b, float c, float d) { int w = __builtin_amdgcn_cvt_pk_fp8_f32(a, b, 0, false); w = __builtin_amdgcn_cvt_pk_fp8_f32(c, d, w, true); return (unsigned)w; }
template <bool NT = true> __device__ __forceinline__ void p0_transpose_item_fp8(const float* W, int K, int N, unsigned char* WT, int n0dst, float scale, LAS float* scr, int kb, int nb, int lane) {
    const int k0 = 64 * kb, n0 = 32 * nb;
#pragma unroll
    for (int i = 0; i < 8; ++i) { const int kk = 8 * i + (lane >> 3), n = n0 + 4 * (lane & 7);
        const f32x4 v = (n < N) ? __builtin_nontemporal_load((const f32x4*)(W + (size_t)(k0 + kk) * N + n)) * scale : (f32x4){0.f, 0.f, 0.f, 0.f};
        LAS float* d = scr + kk * 33 + 4 * (lane & 7); d[0] = fminf(fmaxf(v[0], -448.f), 448.f); d[1] = fminf(fmaxf(v[1], -448.f), 448.f); d[2] = fminf(fmaxf(v[2], -448.f), 448.f); d[3] = fminf(fmaxf(v[3], -448.f), 448.f); }
    LDS_WAIT(); asm volatile("" ::: "memory");
    const int c = lane & 7;
#pragma unroll
    for (int j = 0; j < 4; ++j) { const int n = (lane >> 3) + 8 * j; const LAS float* s = scr + (8 * c) * 33 + n;
        v2u o; o.x = pk4_fp8(s[0 * 33], s[1 * 33], s[2 * 33], s[3 * 33]); o.y = pk4_fp8(s[4 * 33], s[5 * 33], s[6 * 33], s[7 * 33]);
        if constexpr (NT) __builtin_nontemporal_store(o, (v2u*)(WT + (size_t)(n0dst + n) * K + k0 + 8 * c)); else *(v2u*)(WT + (size_t)(n0dst + n) * K + k0 + 8 * c) = o; }
    LDS_WAIT(); asm volatile("" ::: "memory");
}
constexpr int P0_I_IN = 16 * 168, P0_I_Q = 6 * 48, P0_I_KV = 4 * 64, P0_I_SQ = 16 * 32, P0_I_GU1 = 16 * 64, P0_I_DN1 = 16 * 32;
constexpr int P0_NITEMS = P0_I_IN + P0_I_Q + P0_I_KV + 3 * P0_I_SQ + NE * P0_I_GU1 + NE * P0_I_DN1;
constexpr int P0_DEFER = 12288;
__device__ __forceinline__ void p0_item(Frame& F, int it, LAS float* scr) {
    int r = it;
    if (r < P0_I_IN) { p0_transpose_item_fp8<false>(F.in[I_WIN], DM, IN_DIM, WSP(unsigned char, WS_WIN), 32 * (r % 168), WGU_SCALE, scr, r / 168, r % 168, F.lane); return; } r -= P0_I_IN;
    if (r < P0_I_Q) { const int nb = r % 48, c0 = 32 * nb, hd = c0 / QKD, d0 = c0 % QKD, pm = d0 < NOPE ? 0 : d0 == NOPE ? 1 : 2;
        p0_transpose_item(F.in[I_WQUP], QRANK, MLA_H * QKD, WSP(bf16, WS_WQ), pm ? hd * QKD + NOPE : c0, F.in[I_GQL], scr, r / 48, nb, F.lane, pm); return; } r -= P0_I_Q;
    if (r < P0_I_KV) { p0_transpose_item(F.in[I_WKVUP], KVRANK, MLA_H * 256, WSP(bf16, WS_WKV), 32 * (r % 64), F.in[I_GKVL], scr, r / 64, r % 64, F.lane); return; } r -= P0_I_KV;
    if (r < P0_I_SQ) { p0_transpose_item(F.in[I_WSSD], DM, DM, WSP(bf16, WS_WSSD), 32 * (r % 32), nullptr, scr, r / 32, r % 32, F.lane); return; } r -= P0_I_SQ;
    if (r < P0_I_SQ) { p0_transpose_item(F.in[I_WMLA], DM, DM, WSP(bf16, WS_WMLA), 32 * (r % 32), nullptr, scr, r / 32, r % 32, F.lane); return; } r -= P0_I_SQ;
    if (r < P0_I_SQ) { p0_transpose_item(F.in[I_WO], DM, DM, WSP(bf16, WS_WO), 32 * (r % 32), nullptr, scr, r / 32, r % 32, F.lane); return; } r -= P0_I_SQ;
    if (r < NE * P0_I_GU1) { const int e = r / P0_I_GU1, q = r % P0_I_GU1, kb = q / 64, nb = q % 64; const int n0 = 32 * nb, j = n0 & 1023;
        const int n0dst = (j >> 7) * 256 + (n0 >= 1024 ? 128 : 0) + (j & 127);
        p0_transpose_item_fp8(F.in[I_WGU] + (size_t)e * DM * 2 * FF, DM, 2 * FF, WSP(unsigned char, WS_WGU) + (size_t)e * 2 * FF * DM, n0dst, WGU_SCALE, scr, kb, nb, F.lane); return; } r -= NE * P0_I_GU1;
    { const int e = r / P0_I_DN1, q = r % P0_I_DN1; p0_transpose_item_fp8(F.in[I_WDN] + (size_t)e * FF * DM, FF, DM, WSP(unsigned char, WS_WDN) + (size_t)e * DM * FF, 32 * (q % 32), WGU_SCALE, scr, q / 32, q % 32, F.lane); }
}
__device__ __forceinline__ void p0_deferred(Frame& F, int nfull) {
    LAS float* scr = (LAS float*)(F.lds + RING_OFF + F.wave * 16384);
    const int c = (int)blockIdx.x, e = nfull ? c - nfull : c, E = nfull ? F.G - nfull : F.G;
    if (e < 0) return;
    for (int it = P0_NITEMS - P0_DEFER + e * NWAVES + F.wave; it < P0_NITEMS; it += E * NWAVES) p0_item(F, it, scr);
}
__device__ __forceinline__ void p0_prologue(Frame& F) {
    LAS float* scr = (LAS float*)(F.lds + RING_OFF + F.wave * 16384);
    const int gw = F.vcu * NWAVES + F.wave, NGW = F.G * NWAVES;
    for (int it = gw; it < P0_NITEMS - P0_DEFER; it += NGW) p0_item(F, it, scr);
    for (int m = gw; m < T; m += NGW) rms_row_to_fp8(F.lane, F.in[I_X] + (size_t)m * DM, F.in[I_GMIX], WSP(unsigned char, WS_XN) + (size_t)m * DM);
    if (F.vcu == 0 && F.wave == 0) { const int lane = F.lane;
        float a = 0.f, b = 0.f;
#pragma unroll
        for (int j = 0; j < 3; ++j) { a = fmaxf(a, fabsf(F.in[I_GQKQ][lane + 64 * j])); b = fmaxf(b, fabsf(F.in[I_GQKK][lane + 64 * j])); }
        a = wave_max(a); b = wave_max(b);
        if (lane == 0) *WSP(float, WS_SMAX) = 13.856406460551018f * 1.4426950408889634f * a * b * 1.03f + 0.25f; }
    { float* RT = WSP(float, WS_ROPE);
      for (int i = F.vcu * NTHR + F.tid; i < SEQ * 32; i += F.G * NTHR) { const int pos = i >> 5, j = i & 31; const float inv = exp2f(-(float)(2 * j) * (1.0f / 64.0f) * 13.287712379549449f);
          float sv, cv; sincosf((float)pos * inv, &sv, &cv); RT[pos * 64 + j] = cv; RT[pos * 64 + 32 + j] = sv; } }
}

struct PrepIn { v4u ql, kl, kr; f32x4 c0, c1, s0, s1; v4u qv[4], kv[4], vv[4]; };
__device__ __forceinline__ void p3_mla_prep(Frame& F) {
    const int gw = F.vcu * NWAVES + F.wave, NGW = F.G * NWAVES, l = F.lane, hl = l & 31, half = l >> 5;
    const bf16* PROJ = WSP(bf16, WS_PROJ); const bf16* QPRE = WSP(bf16, WS_QPRE); const bf16* KVPRE = WSP(bf16, WS_KVPRE); const float* RT = WSP(float, WS_ROPE);
    bf16* Qo = WSP(bf16, WS_Q); bf16* Ko = WSP(bf16, WS_K); bf16* Vo = WSP(bf16, WS_V);
    const bool act = hl < 24, isrope = hl >= 16 && hl < 24, isx2 = hl >= 20;
    const int hlc = act ? hl : 0, jr = 8 * ((hl - 16) & 3);
    float gq[8], gk[8];
#pragma unroll
    for (int e = 0; e < 8; ++e) { gq[e] = act ? F.in[I_GQKQ][8 * hl + e] : 0.f; gk[e] = act ? F.in[I_GQKK][8 * hl + e] : 0.f; }
#define PREP_LOAD(P, tk_) do { const int s_ = (tk_) % SEQ; const bf16* prow = PROJ + (size_t)(tk_) * IN_PAD; \
        P.ql = *(const v4u*)(prow + OFF_QLAT + 8 * (l < 48 ? l : 0)); P.kl = *(const v4u*)(prow + OFF_KVLAT + 8 * (l & 31)); P.kr = *(const v4u*)(prow + OFF_KROPE + 8 * ((hl - 16) & 7)); \
        P.c0 = *(const f32x4*)(RT + s_ * 64 + jr); P.c1 = *(const f32x4*)(RT + s_ * 64 + jr + 4); P.s0 = *(const f32x4*)(RT + s_ * 64 + 32 + jr); P.s1 = *(const f32x4*)(RT + s_ * 64 + 32 + jr + 4); \
        _Pragma("unroll") for (int hp = 0; hp < 4; ++hp) { const int h = 2 * hp + half; \
            P.qv[hp] = *(const v4u*)(QPRE + (size_t)(tk_) * (MLA_H * QKD) + h * QKD + 8 * hlc); \
            P.kv[hp] = *(const v4u*)(KVPRE + (size_t)(tk_) * (MLA_H * 256) + h * 256 + 8 * (hl & 15)); \
            P.vv[hp] = *(const v4u*)(KVPRE + (size_t)(tk_) * (MLA_H * 256) + h * 256 + 128 + 8 * (hl & 15)); } } while (0)
    auto proc = [&](const PrepIn& P, int tk) {
        const int b = tk / SEQ, s = tk % SEQ;
        float v[8]; float ss = 0.f;
        unpack8(P.ql, v);
        if (l < 48) {
#pragma unroll
            for (int e = 0; e < 8; ++e) ss += v[e] * v[e]; }
        const float rq = rsqrtf(wave_sum(ss) * (1.f / QRANK) + EPS);
        ss = 0.f; unpack8(P.kl, v);
        if (l < 32) {
#pragma unroll
            for (int e = 0; e < 8; ++e) ss += v[e] * v[e]; }
        const float rkv = rsqrtf(wave_sum(ss) * (1.f / KVRANK) + EPS);
        const float cs[8] = {P.c0[0], P.c0[1], P.c0[2], P.c0[3], P.c1[0], P.c1[1], P.c1[2], P.c1[3]}, sn[8] = {P.s0[0], P.s0[1], P.s0[2], P.s0[3], P.s1[0], P.s1[1], P.s1[2], P.s1[3]};
        float krp[8]; unpack8(P.kr, krp);
#pragma unroll
        for (int hp = 0; hp < 4; ++hp) {
            const int h = 2 * hp + half;
            { float q[8]; unpack8(P.qv[hp], q);
#pragma unroll
              for (int e = 0; e < 8; ++e) q[e] = act ? q[e] * rq : 0.f;
              float s2 = 0.f;
#pragma unroll
              for (int e = 0; e < 8; ++e) s2 += q[e] * q[e];
#pragma unroll
              for (int o = 1; o < 32; o <<= 1) s2 += __shfl_xor(s2, o);
              const float rs = rsqrtf(s2 * (1.f / QKD) + EPS);
#pragma unroll
              for (int e = 0; e < 8; ++e) { q[e] = q[e] * rs * gq[e]; const float p = __shfl_xor(q[e], 4);
                  if (isrope) q[e] = isx2 ? (q[e] * cs[e] + p * sn[e]) : (q[e] * cs[e] - p * sn[e]);
                  q[e] *= QSCALE; }
              if (act) *(v4u*)(Qo + ((size_t)(b * MLA_H + h) * SEQ + s) * QKD + 8 * hl) = pack8(q); }
            { float k[8]; unpack8(P.kv[hp], k);
#pragma unroll
              for (int e = 0; e < 8; ++e) k[e] = (hl < 16) ? k[e] * rkv : (isrope ? krp[e] : 0.f);
              float s2 = 0.f;
#pragma unroll
              for (int e = 0; e < 8; ++e) s2 += k[e] * k[e];
#pragma unroll
              for (int o = 1; o < 32; o <<= 1) s2 += __shfl_xor(s2, o);
              const float rs = rsqrtf(s2 * (1.f / QKD) + EPS);
#pragma unroll
              for (int e = 0; e < 8; ++e) { k[e] = k[e] * rs * gk[e]; const float p = __shfl_xor(k[e], 4);
                  if (isrope) k[e] = isx2 ? (k[e] * cs[e] + p * sn[e]) : (k[e] * cs[e] - p * sn[e]); }
              if (act) *(v4u*)(Ko + ((size_t)(b * MLA_H + h) * SEQ + s) * QKD + 8 * hl) = pack8(k); }
            if (hl < 16) { float w[8]; unpack8(P.vv[hp], w);
#pragma unroll
                for (int e = 0; e < 8; ++e) w[e] *= rkv;
                *(v4u*)(Vo + ((size_t)(b * MLA_H + h) * SEQ + s) * VD + 8 * hl) = pack8(w); }
        }
    };
    int tk = gw; if (tk >= T) return;
    PrepIn A, B;
    PREP_LOAD(A, tk);
#pragma unroll 1
    for (;;) {
        const int t1 = tk + NGW; const bool h1 = t1 < T;
        PREP_LOAD(B, (h1 ? t1 : tk)); asm volatile("" : "+v"(A.ql.x), "+v"(A.kl.x) :: "memory");
        proc(A, tk);
        if (!h1) break;
        const int t2 = t1 + NGW; const bool h2 = t2 < T;
        PREP_LOAD(A, (h2 ? t2 : t1)); asm volatile("" : "+v"(B.ql.x), "+v"(B.kl.x) :: "memory");
        proc(B, t1);
        if (!h2) break;
        tk = t2;
    }
#undef PREP_LOAD
}

__device__ __forceinline__ void p4_attn_naive(Frame& F) {
    LAS float* qs = (LAS float*)(F.lds);
    LAS bf16* ks = (LAS bf16*)(F.lds + 49152);
    LAS bf16* vs = (LAS bf16*)(F.lds + 49152 + 25600);
    LAS float* ps = (LAS float*)(F.lds + 49152 + 25600 + 16384) + F.wave * 512;
    const bf16* Q = WSP(bf16, WS_Q); const bf16* K = WSP(bf16, WS_K); const bf16* V = WSP(bf16, WS_V); bf16* O = WSP(bf16, WS_OATT);
    const int tid = F.tid, lane = F.lane, w = F.wave;
    const int NIT = BATCH * MLA_H * NCHUNK;
    for (int it0 = 0; it0 < NIT; it0 += F.G) {
        const int it = it0 + (int)blockIdx.x; if (it >= NIT) break;
        const int rnd = it / 256, j = it % 256;
        const int bh = 2 * rnd + (j >> 7), c = (rnd & 1) ? (127 - (j & 127)) : (j & 127);
        const bf16* Qh = Q + ((size_t)bh * SEQ + (size_t)c * 64) * QKD; const bf16* Kh = K + (size_t)bh * SEQ * QKD; const bf16* Vh = V + (size_t)bh * SEQ * VD;
        __syncthreads();
        for (int i = tid; i < 64 * 24; i += NTHR) { float v[8]; unpack8(*(const v4u*)(Qh + (size_t)i * 8), v); const int r = i / 24, d = (i % 24) * 8;
#pragma unroll
            for (int e = 0; e < 8; ++e) qs[r * 192 + d + e] = v[e]; }
        float m[8], lsum[8], o0[8], o1[8];
#pragma unroll
        for (int r = 0; r < 8; ++r) { m[r] = -1e30f; lsum[r] = 0.f; o0[r] = 0.f; o1[r] = 0.f; }
        for (int kt = 0; kt <= c; ++kt) {
            __syncthreads();
            for (int i = tid; i < 64 * 24; i += NTHR) { const int r = i / 24, d = (i % 24) * 8; *(LAS v4u*)(ks + r * 200 + d) = *(const v4u*)(Kh + ((size_t)kt * 64 + r) * QKD + d); }
            for (int i = tid; i < 64 * 16; i += NTHR) { const int r = i / 16, d = (i % 16) * 8; *(LAS v4u*)(vs + r * 128 + d) = *(const v4u*)(Vh + ((size_t)kt * 64 + r) * VD + d); }
            __syncthreads();
            float sc[8];
#pragma unroll
            for (int r = 0; r < 8; ++r) sc[r] = 0.f;
#pragma unroll 2
            for (int d = 0; d < 192; d += 8) { float kv[8]; unpack8(*(const LAS v4u*)(ks + lane * 200 + d), kv);
#pragma unroll
                for (int r = 0; r < 8; ++r) { const f32x4 qa = *(const LAS f32x4*)(qs + (8 * w + r) * 192 + d), qb = *(const LAS f32x4*)(qs + (8 * w + r) * 192 + d + 4);
                    sc[r] += qa[0] * kv[0] + qa[1] * kv[1] + qa[2] * kv[2] + qa[3] * kv[3] + qb[0] * kv[4] + qb[1] * kv[5] + qb[2] * kv[6] + qb[3] * kv[7]; } }
#pragma unroll
            for (int r = 0; r < 8; ++r) { const float tm = wave_max(sc[r]); const float mn = fmaxf(m[r], tm); const float al = exp2f(m[r] - mn); const float p = exp2f(sc[r] - mn);
                lsum[r] = lsum[r] * al + wave_sum(p); o0[r] *= al; o1[r] *= al; m[r] = mn; sc[r] = p; }
            *(LAS f32x4*)(ps + lane * 8) = (f32x4){sc[0], sc[1], sc[2], sc[3]}; *(LAS f32x4*)(ps + lane * 8 + 4) = (f32x4){sc[4], sc[5], sc[6], sc[7]};
            LDS_WAIT(); asm volatile("" ::: "memory");
#pragma unroll 4
            for (int k = 0; k < 64; ++k) { const unsigned vv = *(const LAS unsigned*)(vs + k * 128 + 2 * lane); const float v0 = blo(vv), v1 = bhi(vv);
                const f32x4 pa = *(const LAS f32x4*)(ps + k * 8), pb = *(const LAS f32x4*)(ps + k * 8 + 4);
                o0[0] += pa[0] * v0; o1[0] += pa[0] * v1; o0[1] += pa[1] * v0; o1[1] += pa[1] * v1; o0[2] += pa[2] * v0; o1[2] += pa[2] * v1; o0[3] += pa[3] * v0; o1[3] += pa[3] * v1;
                o0[4] += pb[0] * v0; o1[4] += pb[0] * v1; o0[5] += pb[1] * v0; o1[5] += pb[1] * v1; o0[6] += pb[2] * v0; o1[6] += pb[2] * v1; o0[7] += pb[3] * v0; o1[7] += pb[3] * v1; }
            LDS_WAIT(); asm volatile("" ::: "memory");
        }
        const int b = bh / MLA_H, h = bh % MLA_H;
#pragma unroll
        for (int r = 0; r < 8; ++r) { const float il = 1.0f / lsum[r];
            *(unsigned*)(O + ((size_t)b * SEQ + (size_t)c * 64 + 8 * w + r) * DM + h * VD + 2 * lane) = pk2(o0[r] * il, o1[r] * il); }
    }
}

namespace attn {
typedef float f32x16 __attribute__((ext_vector_type(16)));
typedef short s16x4 __attribute__((ext_vector_type(4)));
constexpr int NW = 8, QBLK = 32, KVBLK = 64, QB = NW * QBLK, DQ = 192, DV = 128, KROW = DQ * 2;
constexpr int SHM_V = KVBLK * DV * 2, SHM_K = KVBLK * DQ * 2;
constexpr int NVB = 3;
constexpr int LDS_BYTES = NVB * SHM_V + 2 * SHM_K + NW * 64 * 4;
constexpr float THR = 8.f;
#define KSWZ(row, colB) ((row) * KROW + ((colB) ^ ((((row) >> 1) & 7) << 4)))
#define SBAR() __builtin_amdgcn_sched_barrier(0)
__device__ __forceinline__ int v_st(int k, int c) { const int kk = (k & ~0xC) | ((k & 4) << 1) | ((k & 8) >> 1); return ((kk >> 3) * 4 + (c >> 5)) * 512 + ((kk & 7) * 32 + (c & 31)) * 2; }
__device__ __forceinline__ int v_rd_base(int lane) { return ((lane & 3) << 3) | (((lane >> 2) & 3) << 6) | (((lane >> 4) & 1) << 5) | (((lane >> 5) & 1) << 8); }
constexpr int v_rd_off(int d0, int ks, int half) { return d0 * 512 + ks * 4096 + half * 2048; }
__device__ __forceinline__ int crow(int r, int hi) { return (r & 3) + 8 * (r >> 2) + 4 * hi; }
__device__ __forceinline__ unsigned cvtpk(float lo, float hi) { unsigned r; asm volatile("v_cvt_pk_bf16_f32 %0, %1, %2" : "=v"(r) : "v"(lo), "v"(hi)); return r; }
__device__ __forceinline__ void partialSM(f32x16& p0, f32x16& p1, float& m_reg, float& mn, float& alpha) {
    float pmax = p0[0];
#pragma unroll
    for (int r = 1; r < 16; ++r) pmax = fmaxf(pmax, p0[r]);
#pragma unroll
    for (int r = 0; r < 16; ++r) pmax = fmaxf(pmax, p1[r]);
    { auto rr = __builtin_amdgcn_permlane32_swap(__float_as_uint(pmax), __float_as_uint(pmax), false, false);
      pmax = fmaxf(__uint_as_float(rr[0]), __uint_as_float(rr[1])); }
    if (__builtin_expect(__all(pmax - m_reg <= THR), 1)) { mn = m_reg; alpha = 1.f; }
    else { mn = fmaxf(m_reg, pmax); alpha = __builtin_amdgcn_exp2f(m_reg - mn); m_reg = mn; }
#pragma unroll
    for (int r = 0; r < 16; ++r) { p0[r] -= mn; p1[r] -= mn; }
#pragma unroll
    for (int r = 0; r < 16; ++r) p0[r] = __builtin_amdgcn_exp2f(p0[r]);
}
__device__ __forceinline__ void finishSM(f32x16& p0, f32x16& p1, float alpha, float& l_reg, bf16x8& pa0, bf16x8& pa1, bf16x8& pa2, bf16x8& pa3) {
#pragma unroll
    for (int r = 0; r < 16; ++r) p1[r] = __builtin_amdgcn_exp2f(p1[r]);
    float ps = 0;
#pragma unroll
    for (int r = 0; r < 16; ++r) ps += p0[r];
#pragma unroll
    for (int r = 0; r < 16; ++r) ps += p1[r];
    { auto rr = __builtin_amdgcn_permlane32_swap(__float_as_uint(ps), __float_as_uint(ps), false, false);
      ps = __uint_as_float(rr[0]) + __uint_as_float(rr[1]); }
    l_reg = l_reg * alpha + ps;
#define PK4(P, B_, OUT) do { unsigned a0 = cvtpk(P[B_+0], P[B_+1]), a1 = cvtpk(P[B_+2], P[B_+3]);                          \
        unsigned b0 = cvtpk(P[B_+4], P[B_+5]), b1 = cvtpk(P[B_+6], P[B_+7]);                                             \
        auto r0 = __builtin_amdgcn_permlane32_swap(a0, b0, false, false); auto r1 = __builtin_amdgcn_permlane32_swap(a1, b1, false, false); \
        v4u w = {r0[0], r1[0], r0[1], r1[1]}; OUT = *reinterpret_cast<bf16x8*>(&w); } while (0)
    PK4(p0, 0, pa0); PK4(p0, 8, pa1); PK4(p1, 0, pa2); PK4(p1, 8, pa3);
#undef PK4
}
__device__ __forceinline__ void partialSMf(f32x16& p0, f32x16& p1, float C) {
    if (__builtin_amdgcn_readfirstlane(__float_as_int(C)) != 0) {
#pragma unroll
        for (int r = 0; r < 16; ++r) { p0[r] -= C; p1[r] -= C; } }
#pragma unroll
    for (int r = 0; r < 16; ++r) p0[r] = __builtin_amdgcn_exp2f(p0[r]);
}
__device__ __forceinline__ void finishSMf(f32x16& p0, f32x16& p1, float& l_reg, bf16x8& pa0, bf16x8& pa1, bf16x8& pa2, bf16x8& pa3) {
#pragma unroll
    for (int r = 0; r < 16; ++r) p1[r] = __builtin_amdgcn_exp2f(p1[r]);
    float ps = 0;
#pragma unroll
    for (int r = 0; r < 16; ++r) ps += p0[r];
#pragma unroll
    for (int r = 0; r < 16; ++r) ps += p1[r];
    { auto rr = __builtin_amdgcn_permlane32_swap(__float_as_uint(ps), __float_as_uint(ps), false, false);
      ps = __uint_as_float(rr[0]) + __uint_as_float(rr[1]); }
    l_reg += ps;
#define PK4(P, B_, OUT) do { unsigned a0 = cvtpk(P[B_+0], P[B_+1]), a1 = cvtpk(P[B_+2], P[B_+3]);                          \
        unsigned b0 = cvtpk(P[B_+4], P[B_+5]), b1 = cvtpk(P[B_+6], P[B_+7]);                                             \
        auto r0 = __builtin_amdgcn_permlane32_swap(a0, b0, false, false); auto r1 = __builtin_amdgcn_permlane32_swap(a1, b1, false, false); \
        v4u w = {r0[0], r1[0], r0[1], r1[1]}; OUT = *reinterpret_cast<bf16x8*>(&w); } while (0)
    PK4(p0, 0, pa0); PK4(p0, 8, pa1); PK4(p1, 0, pa2); PK4(p1, 8, pa3);
#undef PK4
}
template <int KB>
__device__ __forceinline__ void qkt(f32x16& p0, f32x16& p1, const char* K_lds, int lane_in, const bf16x8* qr, bool act) {
    int l_ = lane_in; asm volatile("" : "+v"(l_)); const int r32 = l_ & 31, hi = l_ >> 5;
    if (!act) { const float NEG = -__builtin_inff();
#pragma unroll
        for (int r = 0; r < 16; ++r) { p0[r] = NEG; p1[r] = NEG; } return; }
    const char* kb[4];
    __builtin_amdgcn_s_setprio(1);
#pragma unroll
    for (int dd = 0; dd < 4; ++dd) kb[dd] = K_lds + KB * SHM_K + KSWZ(r32, (dd * 16 + hi * 8) * 2);
    { const f32x16 z = f32x16{};
      const bf16x8 b0 = *reinterpret_cast<const bf16x8*>(kb[0]), b1 = *reinterpret_cast<const bf16x8*>(kb[0] + 32 * KROW);
      p0 = __builtin_amdgcn_mfma_f32_32x32x16_bf16(b0, qr[0], z, 0, 0, 0); p1 = __builtin_amdgcn_mfma_f32_32x32x16_bf16(b1, qr[0], z, 0, 0, 0); }
#pragma unroll
    for (int d0 = 1; d0 < 12; ++d0) { const char* a = kb[d0 & 3] + (d0 >> 2) * 128;
        bf16x8 b0 = *reinterpret_cast<const bf16x8*>(a);
        bf16x8 b1 = *reinterpret_cast<const bf16x8*>(a + 32 * KROW);
        p0 = __builtin_amdgcn_mfma_f32_32x32x16_bf16(b0, qr[d0], p0, 0, 0, 0);
        p1 = __builtin_amdgcn_mfma_f32_32x32x16_bf16(b1, qr[d0], p1, 0, 0, 0); }
    __builtin_amdgcn_s_setprio(0);
    __builtin_amdgcn_sched_group_barrier(0x100, 8, 0);
#pragma unroll
    for (int i = 0; i < 8; ++i) { __builtin_amdgcn_sched_group_barrier(0x8, 2, 0); __builtin_amdgcn_sched_group_barrier(0x100, 2, 0); }
    __builtin_amdgcn_sched_group_barrier(0x8, 8, 0);
}
__device__ __forceinline__ void pv_tile(f32x16* o, int vb0, bf16x8 pa0, bf16x8 pa1, bf16x8 pa2, bf16x8 pa3, bool act) {
    if (!act) return;
#define TRRD(dst, off) asm volatile("ds_read_b64_tr_b16 %0, %1 offset:%2" : "=&v"(dst) : "v"(vb0), "i"(off) : "memory")
#define PV_RD(S_, d0) do { constexpr int b_ = v_rd_off(d0, 0, 0); TRRD(S_##l0, b_); TRRD(S_##h0, b_ + 2048); TRRD(S_##l1, b_ + 4096); TRRD(S_##h1, b_ + 6144); TRRD(S_##l2, b_ + 8192); TRRD(S_##h2, b_ + 10240); TRRD(S_##l3, b_ + 12288); TRRD(S_##h3, b_ + 14336); } while (0)
#define PV_MM(S_, d0) do { \
        o[d0] = __builtin_amdgcn_mfma_f32_32x32x16_bf16(pa0, (bf16x8){S_##l0[0], S_##l0[1], S_##l0[2], S_##l0[3], S_##h0[0], S_##h0[1], S_##h0[2], S_##h0[3]}, o[d0], 0, 0, 0);   \
        o[d0] = __builtin_amdgcn_mfma_f32_32x32x16_bf16(pa1, (bf16x8){S_##l1[0], S_##l1[1], S_##l1[2], S_##l1[3], S_##h1[0], S_##h1[1], S_##h1[2], S_##h1[3]}, o[d0], 0, 0, 0);   \
        o[d0] = __builtin_amdgcn_mfma_f32_32x32x16_bf16(pa2, (bf16x8){S_##l2[0], S_##l2[1], S_##l2[2], S_##l2[3], S_##h2[0], S_##h2[1], S_##h2[2], S_##h2[3]}, o[d0], 0, 0, 0);   \
        o[d0] = __builtin_amdgcn_mfma_f32_32x32x16_bf16(pa3, (bf16x8){S_##l3[0], S_##l3[1], S_##l3[2], S_##l3[3], S_##h3[0], S_##h3[1], S_##h3[2], S_##h3[3]}, o[d0], 0, 0, 0); } while (0)
#define PV_WAIT(n) do { asm volatile("s_waitcnt lgkmcnt(" #n ")" ::: "memory"); SBAR(); } while (0)
    s16x4 Al0, Al1, Al2, Al3, Ah0, Ah1, Ah2, Ah3, Bl0, Bl1, Bl2, Bl3, Bh0, Bh1, Bh2, Bh3;
    PV_RD(A, 0); PV_RD(B, 1); PV_WAIT(8); PV_MM(A, 0); SBAR();
    PV_RD(A, 2); PV_WAIT(8); PV_MM(B, 1); SBAR();
    PV_RD(B, 3); PV_WAIT(8); PV_MM(A, 2); SBAR();
    PV_WAIT(0); PV_MM(B, 3);
#undef PV_RD
#undef PV_MM
#undef PV_WAIT
#undef TRRD
}
struct BlockRef { const bf16* Q; const bf16* K; const bf16* V; bf16* O; int qb; const float* ssq; const float* rq; float smax; };
struct Seam { bf16x8 qr[12]; bf16x8 st_v0, st_v1, st_k0, st_k1, st_k2; };
#define VMW() asm volatile("s_waitcnt vmcnt(0)" ::: "memory")
#define VMWN(n) asm volatile("s_waitcnt vmcnt(%0)" :: "i"(n) : "memory")
#define SLOAD_H(Kp, Vp, t) do { const __amdgpu_buffer_rsrc_t rk_ = __builtin_amdgcn_make_buffer_rsrc((void*)(Kp), 0, SEQ * DQ * 2, 0x00020000), rv_ = __builtin_amdgcn_make_buffer_rsrc((void*)(Vp), 0, SEQ * DV * 2, 0x00020000); \
        int t16_ = tid * 16; asm volatile("" : "+v"(t16_)); const int sk_ = (t) * SHM_K, sv_ = (t) * SHM_V;     \
        S.st_v0 = __builtin_bit_cast(bf16x8, __builtin_amdgcn_raw_buffer_load_b128(rv_, t16_, sv_, 0)); S.st_v1 = __builtin_bit_cast(bf16x8, __builtin_amdgcn_raw_buffer_load_b128(rv_, t16_, sv_ + 8192, 0)); \
        S.st_k0 = __builtin_bit_cast(bf16x8, __builtin_amdgcn_raw_buffer_load_b128(rk_, t16_, sk_, 0)); S.st_k1 = __builtin_bit_cast(bf16x8, __builtin_amdgcn_raw_buffer_load_b128(rk_, t16_, sk_ + 8192, 0)); \
        S.st_k2 = __builtin_bit_cast(bf16x8, __builtin_amdgcn_raw_buffer_load_b128(rk_, t16_, sk_ + 16384, 0)); } while (0)
#define SWRITE_HK(bf) do { int t_ = tid; asm volatile("" : "+v"(t_)); const int c0_ = t_, c1_ = t_ + 512, c2_ = t_ + 1024; char* kb_ = K_lds + (bf) * SHM_K;     \
        *(bf16x8*)(kb_ + KSWZ(c0_ / 24, (c0_ % 24) * 16)) = S.st_k0; *(bf16x8*)(kb_ + KSWZ(c1_ / 24, (c1_ % 24) * 16)) = S.st_k1; *(bf16x8*)(kb_ + KSWZ(c2_ / 24, (c2_ % 24) * 16)) = S.st_k2; } while (0)
#define SWRITE_HV(bf) do { int t_ = tid; asm volatile("" : "+v"(t_)); char* vb_ = V_lds + (bf) * SHM_V + v_st(t_ >> 4, (t_ & 15) * 8); *(bf16x8*)vb_ = S.st_v0; *(bf16x8*)(vb_ + 8192) = S.st_v1; } while (0)
#define SWRITE_H(bf) do { SWRITE_HV(bf); SWRITE_HK(bf); } while (0)
#define QLOAD(ref) do { _Pragma("unroll") for (int d0 = 0; d0 < 12; ++d0) S.qr[d0] = *(const bf16x8*)((ref).Q + (size_t)(wid * QBLK + r32) * DQ + d0 * 16 + hi * 8); } while (0)
#define KW_SETUP()
__device__ __forceinline__ int vbase_of(char* V_lds, int lane) { int l_ = lane; asm volatile("" : "+v"(l_)); return (int)(uintptr_t)V_lds + v_rd_base(l_); }
__device__ __forceinline__ void prime(const BlockRef& cur, char* lds, Seam& S) {
    const int tid = threadIdx.x, wid = __builtin_amdgcn_readfirstlane(tid >> 6), lane = tid & 63, r32 = lane & 31, hi = lane >> 5;
    char* K_lds = lds + NVB * SHM_V;
    QLOAD(cur);
    SLOAD_H(cur.K, cur.V, 0); VMW(); SWRITE_HK(0);
    __syncthreads();
}
__device__ __forceinline__ void block(const BlockRef& cur, const BlockRef& nxt, char* lds, Seam& S) {
    int tid = threadIdx.x; asm volatile("" : "+v"(tid));
    const int wid = __builtin_amdgcn_readfirstlane(tid >> 6), lane = tid & 63, r32 = lane & 31, hi = lane >> 5;
    const int NT = 4 * cur.qb + 4;
    const int tmax = 4 * cur.qb + (wid >> 1);
    char* V_lds = lds; char* K_lds = lds + NVB * SHM_V;
    float* ws = (float*)(lds + NVB * SHM_V + 2 * SHM_K) + wid * 64; float* li_l = ws, * al_l = ws + 32;
    float m_reg = -1e30f, l_reg = 0; f32x16 o[4] = {};
    const bf16* Kh = cur.K; const bf16* Vh = cur.V;
#define RESC(a) do { if (__any((a) < 1.f)) { int l_ = lane; asm volatile("" : "+v"(l_)); const int r32_ = l_ & 31, hi_ = l_ >> 5; if (hi_ == 0) al_l[r32_] = (a); asm volatile("s_waitcnt lgkmcnt(0)" ::: "memory");              \
                     _Pragma("unroll") for (int d_ = 0; d_ < 4; ++d_) _Pragma("unroll") for (int r = 0; r < 16; ++r) o[d_][r] *= al_l[crow(r, hi_)]; } } while (0)
#define ACT(t) ((t) <= tmax)
    f32x16 pA0, pA1, pB0, pB1; float mnA, mnB, alA, alB; bf16x8 pa0, pa1, pa2, pa3;
    SWRITE_HV(0); SBAR();
    SLOAD_H(Kh, Vh, 1);
    SBAR(); qkt<0>(pA0, pA1, K_lds, lane, S.qr, true);
    partialSM(pA0, pA1, m_reg, mnA, alA);
    VMW(); SWRITE_H(1);
    __syncthreads();
    int vr = 0, vw = 2;
#define VROT(x) ((x) == NVB - 1 ? 0 : (x) + 1)
#define HALF_STEP(PX0, PX1, mnX, alX, PY0, PY1, alY, t, KB, SB) do {                                                          \
        SBAR(); if ((t) + 1 < NT) { SLOAD_H(Kh, Vh, (t) + 1); SBAR(); }                 \
        qkt<KB>(PX0, PX1, K_lds, lane, S.qr, ACT(t));                                                                     \
        finishSM(PY0, PY1, alY, l_reg, pa0, pa1, pa2, pa3); SBAR();                                                           \
        pv_tile(o, vbase_of(V_lds, lane) + vr * SHM_V, pa0, pa1, pa2, pa3, ACT((t) - 1));                                                       \
        if ((t) + 1 < NT) { VMW(); SWRITE_HK(SB); SWRITE_HV(vw); SBAR(); }                                                   \
        partialSM(PX0, PX1, m_reg, mnX, alX);                                                                                 \
        RESC(alX); vr = VROT(vr); vw = VROT(vw); __syncthreads(); } while (0)
    for (int t = 1; t + 1 < NT; t += 2) {
        HALF_STEP(pB0, pB1, mnB, alB, pA0, pA1, alA, t, 1, 0);
        HALF_STEP(pA0, pA1, mnA, alA, pB0, pB1, alB, t + 1, 0, 1);
    }
    SBAR(); qkt<1>(pB0, pB1, K_lds, lane, S.qr, ACT(NT - 1)); SBAR();
    SLOAD_H(nxt.K, nxt.V, 0); SBAR();
    QLOAD(nxt);
    SBAR();
    finishSM(pA0, pA1, alA, l_reg, pa0, pa1, pa2, pa3); SBAR();
    pv_tile(o, vbase_of(V_lds, lane) + vr * SHM_V, pa0, pa1, pa2, pa3, ACT(NT - 2));
    partialSM(pB0, pB1, m_reg, mnB, alB); __syncthreads(); RESC(alB);
    finishSM(pB0, pB1, alB, l_reg, pa0, pa1, pa2, pa3); SBAR(); pv_tile(o, vbase_of(V_lds, lane) + VROT(vr) * SHM_V, pa0, pa1, pa2, pa3, ACT(NT - 1));
    SBAR(); VMWN(12); SWRITE_HK(0); SBAR();
    { int le = lane; asm volatile("" : "+v"(le)); const int r32e = le & 31, hie = le >> 5;
      if (hie == 0) li_l[r32e] = l_reg; asm volatile("s_waitcnt lgkmcnt(0)" ::: "memory");
      float rli[16];
#pragma unroll
      for (int r = 0; r < 16; ++r) rli[r] = __builtin_amdgcn_rcpf(li_l[crow(r, hie)]);
      bf16* Ow = cur.O + (size_t)(wid * QBLK) * DM;
#pragma unroll
      for (int r = 0; r < 16; ++r) { const int orow = crow(r, hie);
#pragma unroll
          for (int d0 = 0; d0 < 4; ++d0) { const float v = o[d0][r] * rli[r]; const float vn = __shfl_xor(v, 1);
              if ((r32e & 1) == 0) *(unsigned*)(Ow + (size_t)orow * DM + d0 * 32 + r32e) = cvtpk(v, vn); } } }
    __syncthreads();
#undef RESC
#undef ACT
#undef HALF_STEP
#undef VROT
}
#undef VMW
#undef VMWN
#undef SLOAD_H
#undef SWRITE_HK
#undef SWRITE_HV
#undef SWRITE_H
#undef QLOAD
#undef KW_SETUP
#undef KSWZ
#undef SBAR
}
__device__ __forceinline__ attn::BlockRef attn_ref(Frame& F, int bh, int qb) {
    attn::BlockRef r; const int b = bh / MLA_H, h = bh % MLA_H;
    r.Q = WSP(bf16, WS_Q) + ((size_t)bh * SEQ + (size_t)qb * 256) * QKD; r.K = WSP(bf16, WS_K) + (size_t)bh * SEQ * QKD; r.V = WSP(bf16, WS_V) + (size_t)bh * SEQ * VD;
    r.O = WSP(bf16, WS_OATT) + ((size_t)b * SEQ + (size_t)qb * 256) * DM + h * VD; r.qb = qb;
    r.ssq = WSP(float, WS_SSQ) + ((size_t)b * SEQ + (size_t)qb * 256) * 48 + 6 * h; r.rq = WSP(float, WS_RQ) + (size_t)b * SEQ + (size_t)qb * 256; r.smax = *WSP(float, WS_SMAX); return r;
}
__device__ __forceinline__ void p4_attn_mfma(Frame& F) {
    char* lds = (char*)(F.lds + RING_OFF);
    constexpr int NITEM = BATCH * MLA_H * 16;
    attn::Seam S;
    int it = F.vcu; if (it >= NITEM) return;
    int pass = 0;
    attn::BlockRef cur = attn_ref(F, it / 16, it % 16);
    __syncthreads();
    attn::prime(cur, lds, S);
    for (;;) {
        const bool more_pass = pass == 0, more_item = it + F.G < NITEM, last = !more_pass && !more_item;
        int itn = it, passn = pass + 1; if (!more_pass) { passn = 0; itn = more_item ? it + F.G : it; }
        const attn::BlockRef nxt = last ? cur : attn_ref(F, itn / 16, passn ? 31 - (itn % 16) : itn % 16);
        attn::block(cur, nxt, lds, S);
        if (last) break;
        cur = nxt; it = itn; pass = passn;
    }
}
namespace attn3 {
using namespace attn;
constexpr int NKB = 3, NVB3 = 3;
constexpr int LDS_BYTES3 = NVB3 * SHM_V + NKB * SHM_K + NW * 64 * 4;
#define KSWZ3(row, colB) ((row) * KROW + ((colB) ^ ((((row) >> 1) & 7) << 4)))
#define SBAR3() __builtin_amdgcn_sched_barrier(0)
typedef __attribute__((address_space(3))) unsigned las_u32;
__device__ __forceinline__ void qkt_rt3k(f32x16& p0, f32x16& p1, const char* Kb, const int (&kso)[4], const bf16x8* qr, bool act);
__device__ __forceinline__ void qkt_rt3(f32x16& p0, f32x16& p1, const char* Kb, int lane_in, const bf16x8* qr, bool act) {
    int l_ = lane_in; asm volatile("" : "+v"(l_)); const int r32 = l_ & 31, hi = l_ >> 5;
    if (!act) { const float NEG = -__builtin_inff();
#pragma unroll
        for (int r = 0; r < 16; ++r) { p0[r] = NEG; p1[r] = NEG; } return; }
    const char* kb[4];
#pragma unroll
    for (int dd = 0; dd < 4; ++dd) kb[dd] = Kb + KSWZ3(r32, (dd * 16 + hi * 8) * 2);
    { const f32x16 z = f32x16{};
      const bf16x8 b0 = *reinterpret_cast<const bf16x8*>(kb[0]), b1 = *reinterpret_cast<const bf16x8*>(kb[0] + 32 * KROW);
      p0 = __builtin_amdgcn_mfma_f32_32x32x16_bf16(b0, qr[0], z, 0, 0, 0); p1 = __builtin_amdgcn_mfma_f32_32x32x16_bf16(b1, qr[0], z, 0, 0, 0); }
#pragma unroll
    for (int d0 = 1; d0 < 12; ++d0) { const char* a = kb[d0 & 3] + (d0 >> 2) * 128;
        const bf16x8 b0 = *reinterpret_cast<const bf16x8*>(a), b1 = *reinterpret_cast<const bf16x8*>(a + 32 * KROW);
        p0 = __builtin_amdgcn_mfma_f32_32x32x16_bf16(b0, qr[d0], p0, 0, 0, 0);
        p1 = __builtin_amdgcn_mfma_f32_32x32x16_bf16(b1, qr[d0], p1, 0, 0, 0); }
    __builtin_amdgcn_sched_group_barrier(0x100, 8, 0);
#pragma unroll
    for (int i = 0; i < 8; ++i) { __builtin_amdgcn_sched_group_barrier(0x8, 2, 0); __builtin_amdgcn_sched_group_barrier(0x100, 2, 0); }
    __builtin_amdgcn_sched_group_barrier(0x8, 8, 0);
}
__device__ __forceinline__ void qkt_rt3k(f32x16& p0, f32x16& p1, const char* Kb, const int (&kso)[4], const bf16x8* qr, bool act) {
    if (!act) { const float NEG = -__builtin_inff();
#pragma unroll
        for (int r = 0; r < 16; ++r) { p0[r] = NEG; p1[r] = NEG; } return; }
    const char* kb[4];
#pragma unroll
    for (int dd = 0; dd < 4; ++dd) kb[dd] = Kb + kso[dd];
    { const f32x16 z = f32x16{};
      const bf16x8 b0 = *reinterpret_cast<const bf16x8*>(kb[0]), b1 = *reinterpret_cast<const bf16x8*>(kb[0] + 32 * KROW);
      p0 = __builtin_amdgcn_mfma_f32_32x32x16_bf16(b0, qr[0], z, 0, 0, 0); p1 = __builtin_amdgcn_mfma_f32_32x32x16_bf16(b1, qr[0], z, 0, 0, 0); }
#pragma unroll
    for (int d0 = 1; d0 < 12; ++d0) { const char* a = kb[d0 & 3] + (d0 >> 2) * 128;
        const bf16x8 b0 = *reinterpret_cast<const bf16x8*>(a), b1 = *reinterpret_cast<const bf16x8*>(a + 32 * KROW);
        p0 = __builtin_amdgcn_mfma_f32_32x32x16_bf16(b0, qr[d0], p0, 0, 0, 0);
        p1 = __builtin_amdgcn_mfma_f32_32x32x16_bf16(b1, qr[d0], p1, 0, 0, 0); }
    __builtin_amdgcn_sched_group_barrier(0x100, 8, 0);
#pragma unroll
    for (int i = 0; i < 8; ++i) { __builtin_amdgcn_sched_group_barrier(0x8, 2, 0); __builtin_amdgcn_sched_group_barrier(0x100, 2, 0); }
    __builtin_amdgcn_sched_group_barrier(0x8, 8, 0);
}
template <bool ALWAYS>
__device__ __forceinline__ void qkt_fsm(f32x16& p0, f32x16& p1, const char* Kb, int lane_in, const bf16x8* qr, bool act,
                                        f32x16& y0, f32x16& y1, float alpha, float& l_reg, bf16x8& pa0, bf16x8& pa1, bf16x8& pa2, bf16x8& pa3) {
    if (!ALWAYS && !act) { qkt_rt3(p0, p1, Kb, lane_in, qr, false); finishSM(y0, y1, alpha, l_reg, pa0, pa1, pa2, pa3); return; }
    int l_ = lane_in; asm volatile("" : "+v"(l_)); const int r32 = l_ & 31, hi = l_ >> 5;
    const char* kb[4];
#pragma unroll
    for (int dd = 0; dd < 4; ++dd) kb[dd] = Kb + KSWZ3(r32, (dd * 16 + hi * 8) * 2);
#define KF(d0, B0, B1) do { const char* a_ = kb[(d0) & 3] + ((d0) >> 2) * 128; B0 = *reinterpret_cast<const bf16x8*>(a_); B1 = *reinterpret_cast<const bf16x8*>(a_ + 32 * KROW); } while (0)
#define PK4(P, B_, OUT) do { unsigned a0 = cvtpk(P[B_+0], P[B_+1]), a1 = cvtpk(P[B_+2], P[B_+3]);                          \
        unsigned b0 = cvtpk(P[B_+4], P[B_+5]), b1 = cvtpk(P[B_+6], P[B_+7]);                                             \
        auto r0 = __builtin_amdgcn_permlane32_swap(a0, b0, false, false); auto r1 = __builtin_amdgcn_permlane32_swap(a1, b1, false, false); \
        v4u w = {r0[0], r1[0], r0[1], r1[1]}; OUT = *reinterpret_cast<bf16x8*>(&w); } while (0)
    bf16x8 fa0, fa1, fb0, fb1;
    const f32x16 z = f32x16{};
    float s0, s1, s2, s3;
    KF(0, fa0, fa1); SBAR3();
    KF(1, fb0, fb1); p0 = __builtin_amdgcn_mfma_f32_32x32x16_bf16(fa0, qr[0], z, 0, 0, 0); p1 = __builtin_amdgcn_mfma_f32_32x32x16_bf16(fa1, qr[0], z, 0, 0, 0); SBAR3();
#pragma unroll
    for (int r = 0; r < 4; ++r) y1[r] = __builtin_amdgcn_exp2f(y1[r]); SBAR3();
    KF(2, fa0, fa1); p0 = __builtin_amdgcn_mfma_f32_32x32x16_bf16(fb0, qr[1], p0, 0, 0, 0); p1 = __builtin_amdgcn_mfma_f32_32x32x16_bf16(fb1, qr[1], p1, 0, 0, 0); SBAR3();
#pragma unroll
    for (int r = 4; r < 8; ++r) y1[r] = __builtin_amdgcn_exp2f(y1[r]); SBAR3();
    KF(3, fb0, fb1); p0 = __builtin_amdgcn_mfma_f32_32x32x16_bf16(fa0, qr[2], p0, 0, 0, 0); p1 = __builtin_amdgcn_mfma_f32_32x32x16_bf16(fa1, qr[2], p1, 0, 0, 0); SBAR3();
#pragma unroll
    for (int r = 8; r < 12; ++r) y1[r] = __builtin_amdgcn_exp2f(y1[r]); SBAR3();
    KF(4, fa0, fa1); p0 = __builtin_amdgcn_mfma_f32_32x32x16_bf16(fb0, qr[3], p0, 0, 0, 0); p1 = __builtin_amdgcn_mfma_f32_32x32x16_bf16(fb1, qr[3], p1, 0, 0, 0); SBAR3();
#pragma unroll
    for (int r = 12; r < 16; ++r) y1[r] = __builtin_amdgcn_exp2f(y1[r]); SBAR3();
    KF(5, fb0, fb1); p0 = __builtin_amdgcn_mfma_f32_32x32x16_bf16(fa0, qr[4], p0, 0, 0, 0); p1 = __builtin_amdgcn_mfma_f32_32x32x16_bf16(fa1, qr[4], p1, 0, 0, 0); SBAR3();
    s0 = ((y0[0] + y0[1]) + (y0[2] + y0[3])) + ((y0[4] + y0[5]) + (y0[6] + y0[7])); SBAR3();
    KF(6, fa0, fa1); p0 = __builtin_amdgcn_mfma_f32_32x32x16_bf16(fb0, qr[5], p0, 0, 0, 0); p1 = __builtin_amdgcn_mfma_f32_32x32x16_bf16(fb1, qr[5], p1, 0, 0, 0); SBAR3();
    s1 = ((y0[8] + y0[9]) + (y0[10] + y0[11])) + ((y0[12] + y0[13]) + (y0[14] + y0[15])); SBAR3();
    KF(7, fb0, fb1); p0 = __builtin_amdgcn_mfma_f32_32x32x16_bf16(fa0, qr[6], p0, 0, 0, 0); p1 = __builtin_amdgcn_mfma_f32_32x32x16_bf16(fa1, qr[6], p1, 0, 0, 0); SBAR3();
    s2 = ((y1[0] + y1[1]) + (y1[2] + y1[3])) + ((y1[4] + y1[5]) + (y1[6] + y1[7])); SBAR3();
    KF(8, fa0, fa1); p0 = __builtin_amdgcn_mfma_f32_32x32x16_bf16(fb0, qr[7], p0, 0, 0, 0); p1 = __builtin_amdgcn_mfma_f32_32x32x16_bf16(fb1, qr[7], p1, 0, 0, 0); SBAR3();
    s3 = ((y1[8] + y1[9]) + (y1[10] + y1[11])) + ((y1[12] + y1[13]) + (y1[14] + y1[15])); SBAR3();
    KF(9, fb0, fb1); p0 = __builtin_amdgcn_mfma_f32_32x32x16_bf16(fa0, qr[8], p0, 0, 0, 0); p1 = __builtin_amdgcn_mfma_f32_32x32x16_bf16(fa1, qr[8], p1, 0, 0, 0); SBAR3();
    { float ps = (s0 + s1) + (s2 + s3);
      auto rr = __builtin_amdgcn_permlane32_swap(__float_as_uint(ps), __float_as_uint(ps), false, false); ps = __uint_as_float(rr[0]) + __uint_as_float(rr[1]);
      l_reg = l_reg * alpha + ps; }
    PK4(y0, 0, pa0); SBAR3();
    KF(10, fa0, fa1); p0 = __builtin_amdgcn_mfma_f32_32x32x16_bf16(fb0, qr[9], p0, 0, 0, 0); p1 = __builtin_amdgcn_mfma_f32_32x32x16_bf16(fb1, qr[9], p1, 0, 0, 0); SBAR3();
    PK4(y0, 8, pa1); SBAR3();
    KF(11, fb0, fb1); p0 = __builtin_amdgcn_mfma_f32_32x32x16_bf16(fa0, qr[10], p0, 0, 0, 0); p1 = __builtin_amdgcn_mfma_f32_32x32x16_bf16(fa1, qr[10], p1, 0, 0, 0); SBAR3();
    PK4(y1, 0, pa2); SBAR3();
    p0 = __builtin_amdgcn_mfma_f32_32x32x16_bf16(fb0, qr[11], p0, 0, 0, 0); p1 = __builtin_amdgcn_mfma_f32_32x32x16_bf16(fb1, qr[11], p1, 0, 0, 0); SBAR3();
    PK4(y1, 8, pa3);
#undef KF
#undef PK4
}
__device__ __forceinline__ void block3(const BlockRef& cur, char* lds) {
    int tid = threadIdx.x; asm volatile("" : "+v"(tid));
    const int wid = __builtin_amdgcn_readfirstlane(tid >> 6), lane = tid & 63, r32 = lane & 31, hi = lane >> 5;
    const int NT = 4 * cur.qb + 4;
    const int tmax = 4 * cur.qb + (wid >> 1);
    char* V_lds = lds; char* K_lds = lds + NVB3 * SHM_V;
    float* ws = (float*)(lds + NVB3 * SHM_V + NKB * SHM_K) + wid * 64; float* li_l = ws, * al_l = ws + 32;
    float l_reg = 0; f32x16 o[4] = {}; const float smax = cur.smax > 40.f ? cur.smax - 40.f : 0.f;
    const char* Kg = (const char*)cur.K; const char* Vg = (const char*)cur.V;
    const unsigned ldsK = (unsigned)(uintptr_t)K_lds, ldsV = (unsigned)(uintptr_t)V_lds;
    const int vbase = (int)(uintptr_t)V_lds + v_rd_base(lane);
    int kso[4];
#pragma unroll
    for (int dd = 0; dd < 4; ++dd) kso[dd] = KSWZ3(r32, (dd * 16 + hi * 8) * 2);
    unsigned koff[3], voff[2];
#pragma unroll
    for (int j_ = 0; j_ < 3; ++j_) { const int A_ = (wid * 3 + j_) * 1024 + lane * 16, row_ = A_ / KROW, pc_ = (A_ % KROW) >> 4, c_ = (pc_ & 24) | ((pc_ & 7) ^ ((row_ >> 1) & 7)); koff[j_] = (unsigned)(row_ * KROW + c_ * 16); }
#pragma unroll
    for (int j_ = 0; j_ < 2; ++j_) { const int a_ = (wid * 2 + j_) * 64 + lane, sub_ = a_ >> 5, kk_ = (sub_ >> 2) * 8 + ((a_ & 31) >> 2), k_ = (kk_ & ~0xC) | ((kk_ & 4) << 1) | ((kk_ & 8) >> 1), c_ = (sub_ & 3) * 32 + (a_ & 3) * 8; voff[j_] = (unsigned)(k_ * (DV * 2) + c_ * 2); }
#define DMA_K(t, slot) do { _Pragma("unroll") for (int j_ = 0; j_ < 3; ++j_) \
        __builtin_amdgcn_global_load_lds((const unsigned*)(Kg + (size_t)(t) * SHM_K + koff[j_]), (las_u32*)(uintptr_t)(ldsK + (slot) * SHM_K + (wid * 3 + j_) * 1024), 16, 0, 0); } while (0)
#define DMA_V(t, slot) do { _Pragma("unroll") for (int j_ = 0; j_ < 2; ++j_) \
        __builtin_amdgcn_global_load_lds((const unsigned*)(Vg + (size_t)(t) * SHM_V + voff[j_]), (las_u32*)(uintptr_t)(ldsV + (slot) * SHM_V + (wid * 2 + j_) * 1024), 16, 0, 0); } while (0)
#define WBAR(n) asm volatile("s_waitcnt vmcnt(" #n ") lgkmcnt(0)\n\ts_barrier" ::: "memory")
#define RESC3(a) do { if (__any((a) < 1.f)) { int l_ = lane; asm volatile("" : "+v"(l_)); const int r32_ = l_ & 31, hi_ = l_ >> 5; if (hi_ == 0) al_l[r32_] = (a); asm volatile("s_waitcnt lgkmcnt(0)" ::: "memory");              \
                     _Pragma("unroll") for (int d_ = 0; d_ < 4; ++d_) _Pragma("unroll") for (int r = 0; r < 16; ++r) o[d_][r] *= al_l[crow(r, hi_)]; } } while (0)
#define ACT3(t) ((t) <= tmax)
    if (wid >= 4) __builtin_amdgcn_s_setprio(2);
    WBAR(0);
    DMA_K(0, 0); DMA_V(0, 0); DMA_K(1, 1);
    bf16x8 qr[12];
#pragma unroll
    for (int d0 = 0; d0 < 12; ++d0) qr[d0] = *(const bf16x8*)(cur.Q + (size_t)(wid * QBLK + r32) * DQ + d0 * 16 + hi * 8);
    {
      const float* sp = cur.ssq + (size_t)(wid * QBLK + r32) * 48; const float rqv = cur.rq[wid * QBLK + r32];
      const float ssv = ((sp[0] + sp[1]) + (sp[2] + sp[3])) + (sp[4] + sp[5]);
      const float sc = rqv * rsqrtf(rqv * rqv * ssv * (1.f / 192.f) + 1e-6f) * QSCALE;
      asm volatile("s_waitcnt vmcnt(0)" ::: "memory");
#pragma unroll
      for (int d0 = 0; d0 < 12; ++d0) { v4u w = __builtin_bit_cast(v4u, qr[d0]); v4u o;
          o.x = cvtpk(blo(w.x) * sc, bhi(w.x) * sc); o.y = cvtpk(blo(w.y) * sc, bhi(w.y) * sc); o.z = cvtpk(blo(w.z) * sc, bhi(w.z) * sc); o.w = cvtpk(blo(w.w) * sc, bhi(w.w) * sc);
          qr[d0] = __builtin_bit_cast(bf16x8, o); } }
    asm volatile("s_waitcnt vmcnt(0)" ::: "memory");
#pragma unroll
    for (int d0 = 0; d0 < 12; ++d0) asm volatile("" : "+v"(qr[d0]));
    WBAR(0);
    f32x16 pA0, pA1, pB0, pB1; bf16x8 pa0, pa1, pa2, pa3;
    DMA_K(2, 2); DMA_V(1, 1);
    SBAR3(); qkt_rt3k(pA0, pA1, K_lds, kso, qr, true);
    partialSMf(pA0, pA1, smax);
    WBAR(5);
    int bt = 1;
#define WINDOW3(PX0, PX1, PY0, PY1, t, ALW) do { const int nx_ = bt == 2 ? 0 : bt + 1, pv_ = bt == 0 ? 2 : bt - 1;           \
        SBAR3(); if ((t) + 2 < NT) DMA_K((t) + 2, pv_); if ((t) + 1 < NT) DMA_V((t) + 1, nx_); SBAR3();                                     \
        qkt_rt3k(PX0, PX1, K_lds + bt * SHM_K, kso, qr, ALW || ACT3(t)); finishSMf(PY0, PY1, l_reg, pa0, pa1, pa2, pa3); SBAR3();            \
        pv_tile(o, vbase + pv_ * SHM_V, pa0, pa1, pa2, pa3, ALW || ACT3((t) - 1));                                           \
        partialSMf(PX0, PX1, smax);                                                                                    \
        bt = nx_; SBAR3(); if ((t) + 2 < NT) WBAR(5); else if ((t) + 1 < NT) WBAR(2); else WBAR(0); SBAR3(); } while (0)
    int t = 1;
    for (; t + 1 < NT - 3; t += 2) {
        WINDOW3(pB0, pB1, pA0, pA1, t, true);
        WINDOW3(pA0, pA1, pB0, pB1, t + 1, true);
    }
    for (; t + 1 < NT; t += 2) {
        WINDOW3(pB0, pB1, pA0, pA1, t, false);
        WINDOW3(pA0, pA1, pB0, pB1, t + 1, false);
    }
    WINDOW3(pB0, pB1, pA0, pA1, NT - 1, false);
    finishSMf(pB0, pB1, l_reg, pa0, pa1, pa2, pa3); SBAR3();
    pv_tile(o, vbase + (bt == 0 ? 2 : bt - 1) * SHM_V, pa0, pa1, pa2, pa3, ACT3(NT - 1));
    __builtin_amdgcn_s_setprio(0);
    { int le = lane; asm volatile("" : "+v"(le)); const int r32e = le & 31, hie = le >> 5;
      if (hie == 0) li_l[r32e] = l_reg; asm volatile("s_waitcnt lgkmcnt(0)" ::: "memory");
      float rli[16];
#pragma unroll
      for (int r = 0; r < 16; ++r) rli[r] = __builtin_amdgcn_rcpf(li_l[crow(r, hie)]);
      bf16* Ow = cur.O + (size_t)(wid * QBLK) * DM;
#pragma unroll
      for (int r = 0; r < 16; ++r) { const int orow = crow(r, hie);
#pragma unroll
          for (int d0 = 0; d0 < 4; ++d0) { const float v = o[d0][r] * rli[r]; const float vn = __shfl_xor(v, 1);
              if ((r32e & 1) == 0) *(unsigned*)(Ow + (size_t)orow * DM + d0 * 32 + r32e) = cvtpk(v, vn); } } }
#undef DMA_K
#undef DMA_V
#undef WBAR
#undef RESC3
#undef ACT3
#undef WINDOW3
}
#undef KSWZ3
#undef SBAR3
}
__device__ __forceinline__ void p4_attn_dma(Frame& F) {
    char* lds = (char*)(F.lds + RING_OFF);
    constexpr int NITEM = BATCH * MLA_H * 16;
    for (int it = F.vcu; it < NITEM; it += F.G) {
#pragma unroll 1
        for (int pass = 0; pass < 2; ++pass) { const attn::BlockRef cur = attn_ref(F, it / 16, pass ? 31 - (it % 16) : it % 16); attn3::block3(cur, lds); }
    }
    asm volatile("s_waitcnt vmcnt(0) lgkmcnt(0)" ::: "memory"); __syncthreads();
}
__device__ __forceinline__ void p2_rq(Frame& F) {
    const int gw = F.vcu * NWAVES + F.wave, NGW = F.G * NWAVES, l = F.lane; const bf16* QL = WSP(bf16, WS_QLAT); float* RQ = WSP(float, WS_RQ);
    for (int base = gw; base < T; base += 8 * NGW) {
        v4u w[8];
#pragma unroll
        for (int i = 0; i < 8; ++i) { const int t = base + i * NGW; w[i] = *(const v4u*)(QL + (size_t)(t < T ? t : base) * QRANK + 8 * (l < 48 ? l : 0)); }
#pragma unroll
        for (int i = 0; i < 8; ++i) { const int t = base + i * NGW; float v[8]; unpack8(w[i], v); float ss = 0.f;
            if (l < 48) {
#pragma unroll
                for (int e = 0; e < 8; ++e) ss += v[e] * v[e]; }
            ss = wave_sum(ss); if (l == 0 && t < T) RQ[t] = rsqrtf(ss * (1.f / QRANK) + EPS); }
    }
}
__device__ __forceinline__ void p5a_conv(Frame& F) {
    const bf16* PROJ = WSP(bf16, WS_PROJ); bf16* XC = WSP(bf16, WS_XC);
    const float* cw = F.in[I_CONVW]; const float* cb = F.in[I_CONVB];
    constexpr int TB = 8, NIT = (T / TB) * (CONV_DIM / 8);
    const bool skew = F.G == 256; const int bx = (int)blockIdx.x; const bool lowb = bx < 128;
    const int it0 = !skew ? F.vcu * NTHR + F.tid : lowb ? bx * NTHR + F.tid : NIT / 3 + (bx - 128) * NTHR + F.tid, itE = !skew ? NIT : lowb ? NIT / 3 : NIT, itS = !skew ? F.G * NTHR : 128 * NTHR;
    static_assert(NIT % 3 == 0 && (NIT / 3) % (128 * NTHR) == 0, "conv split");
    for (int it = it0; it < itE; it += itS) {
        const int c0 = (it % (CONV_DIM / 8)) * 8, tk0 = (it / (CONV_DIM / 8)) * TB, s0 = tk0 % SEQ;
        float w[4][8], bias[8];
#pragma unroll
        for (int k = 0; k < 4; ++k) { const f32x4 a = *(const f32x4*)(cw + k * CONV_DIM + c0), b = *(const f32x4*)(cw + k * CONV_DIM + c0 + 4);
            w[k][0] = a[0]; w[k][1] = a[1]; w[k][2] = a[2]; w[k][3] = a[3]; w[k][4] = b[0]; w[k][5] = b[1]; w[k][6] = b[2]; w[k][7] = b[3]; }
        { const f32x4 a = *(const f32x4*)(cb + c0), b = *(const f32x4*)(cb + c0 + 4); bias[0] = a[0]; bias[1] = a[1]; bias[2] = a[2]; bias[3] = a[3]; bias[4] = b[0]; bias[5] = b[1]; bias[6] = b[2]; bias[7] = b[3]; }
        const bf16* src = PROJ + (size_t)tk0 * IN_PAD + OFF_XBC + c0;
        v4u raw[TB + 3];
#pragma unroll
        for (int i = 0; i < TB + 3; ++i) raw[i] = (s0 + i - 3 >= 0) ? *(const v4u*)(src + (ptrdiff_t)(i - 3) * IN_PAD) : (v4u){0u, 0u, 0u, 0u};
#pragma unroll
        for (int i = 0; i < TB; ++i) { float acc[8];
#pragma unroll
            for (int e = 0; e < 8; ++e) acc[e] = bias[e];
#pragma unroll
            for (int k = 0; k < 4; ++k) { float v[8]; unpack8(raw[i + k], v);
#pragma unroll
                for (int e = 0; e < 8; ++e) acc[e] += v[e] * w[k][e]; }
#pragma unroll
            for (int e = 0; e < 8; ++e) acc[e] = siluf_(acc[e]);
            *(v4u*)(XC + (size_t)(tk0 + i) * CONV_DIM + c0) = pack8(acc); }
    }
}

__device__ __forceinline__ void p5_ssd_naive(Frame& F) {
    const bf16* PROJ = WSP(bf16, WS_PROJ); const bf16* XC = WSP(bf16, WS_XC); bf16* YN = WSP(bf16, WS_YN);
    LAS float* sB = (LAS float*)(F.lds); LAS float* sC = sB + 128; LAS float* part = sC + 128;
    const int tid = F.tid, e = tid >> 6, p = tid & 63;
    for (int it = (int)blockIdx.x; it < BATCH * SSD_G; it += F.G) {
        const int b = it / SSD_G, g = it % SSD_G, h = g * SSD_HPG + e, col = h * SSD_P + p;
        const float a = -__expf(F.in[I_ALOG][h]), dtb = F.in[I_DTB][h], dsk = F.in[I_DSKIP][h], gn = F.in[I_GSSD][col];
        float st[128];
#pragma unroll
        for (int n = 0; n < 128; ++n) st[n] = 0.f;
        for (int s = 0; s < SEQ; ++s) {
            const size_t row = (size_t)b * SEQ + s;
            __syncthreads();
            if (tid < 256) { const float v = bf2f(XC[row * CONV_DIM + 1024 + (tid >> 7) * 256 + g * 128 + (tid & 127)]); if (tid < 128) sB[tid] = v; else sC[tid - 128] = v; }
            const float dt = softplusf_(bf2f(PROJ[row * IN_PAD + OFF_DT + h]) + dtb), dA = __expf(dt * a);
            const float x = bf2f(XC[row * CONV_DIM + col]), z = bf2f(PROJ[row * IN_PAD + col]), dx = dt * x;
            __syncthreads();
            float y = 0.f;
#pragma unroll
            for (int n = 0; n < 128; n += 4) { const f32x4 bv = *(const LAS f32x4*)(sB + n), cv = *(const LAS f32x4*)(sC + n);
                st[n] = dA * st[n] + dx * bv[0]; st[n + 1] = dA * st[n + 1] + dx * bv[1]; st[n + 2] = dA * st[n + 2] + dx * bv[2]; st[n + 3] = dA * st[n + 3] + dx * bv[3];
                y += st[n] * cv[0] + st[n + 1] * cv[1] + st[n + 2] * cv[2] + st[n + 3] * cv[3]; }
            y = (y + dsk * x) * siluf_(z);
            const float q = wave_sum(y * y);
            if (p == 0) part[(s & 1) * 8 + e] = q;
            __syncthreads();
            float tot = 0.f;
#pragma unroll
            for (int i = 0; i < 8; ++i) tot += part[(s & 1) * 8 + i];
            YN[row * DM + col] = (bf16)f2bf(y * rsqrtf(tot * (1.f / 512.f) + EPS) * gn);
        }
    }
}
namespace ssd {
typedef float f32x16 __attribute__((ext_vector_type(16)));
constexpr int XT_OFF = 0, BT_OFF = 65536, BN_OFF = 81920, CN_OFF = 99328, SDT_OFF = 116736, SAC_OFF = 118784, SW_OFF = 120832, NP = 272;
__device__ __forceinline__ int xt_addr(int p, int s) { return p * 128 + ((2 * s) ^ (((p >> 1) & 7) << 4)); }
__device__ __forceinline__ int xt_frag(int p, int chunk) { return p * 128 + ((chunk ^ ((p >> 1) & 7)) << 4); }
__device__ __forceinline__ int crow(int r, int hi) { return (r & 3) + 8 * (r >> 2) + 4 * hi; }
}
__device__ __forceinline__ v4u widen_pair(v2u a, v2u b) {
    const auto r0 = __builtin_amdgcn_permlane32_swap(a.x, b.x, false, false); const auto r1 = __builtin_amdgcn_permlane32_swap(a.y, b.y, false, false);
    return (v4u){r0[0], r1[0], r0[1], r1[1]};
}
__device__ __forceinline__ void p5_ssd_c1(Frame& F) {
    using namespace ssd;
    const bf16* PROJ = WSP(bf16, WS_PROJ); const bf16* XC = WSP(bf16, WS_XC); bf16* YDIAG = WSP(bf16, WS_YDIAG); bf16* STATES = WSP(bf16, WS_STATES);
    float* ACUM = WSP(float, WS_ACUM); float* CDEC = WSP(float, WS_CDEC);
    LAS unsigned char* L = F.lds;
    const int lane = F.lane, w = F.wave, r32 = lane & 31, hi = lane >> 5;
    for (int it = (int)blockIdx.x; it < BATCH * NCHUNK * SSD_G; it += F.G) {
        const int g = it & 1, c = (it >> 1) & (NCHUNK - 1), b = it >> 8, h = g * SSD_HPG + w;
        const size_t t0 = (size_t)b * SEQ + (size_t)c * CHUNK;
        __syncthreads();
        { const bf16* xrow = XC + (t0 + lane) * CONV_DIM;
          LAS unsigned char* xb = L + XT_OFF + w * 8192; LAS unsigned char* bb = L + BT_OFF + w * 2048;
          int lx[8];
#pragma unroll
          for (int cc = 0; cc < 8; ++cc) lx[cc] = (2 * lane) ^ (cc << 4);
#pragma unroll
          for (int j = 0; j < 8; ++j) { const int cg = w * 8 + j; const v4u v = *(const v4u*)(xrow + g * 512 + cg * 8); const unsigned e[4] = {v.x, v.y, v.z, v.w};
#pragma unroll
              for (int i = 0; i < 8; ++i) *(LAS unsigned short*)(xb + lx[(4 * j + (i >> 1)) & 7] + (1024 * j + 128 * i)) = (unsigned short)((i & 1) ? (e[i >> 1] >> 16) : (e[i >> 1] & 0xffffu)); }
#pragma unroll
          for (int j = 0; j < 2; ++j) { const int cg = w * 2 + j; const v4u vb = *(const v4u*)(xrow + 1024 + g * 128 + cg * 8), vc = *(const v4u*)(xrow + 1280 + g * 128 + cg * 8);
              *(LAS v4u*)(L + BN_OFF + lane * NP + cg * 16) = vb; *(LAS v4u*)(L + CN_OFF + lane * NP + cg * 16) = vc; const unsigned e[4] = {vb.x, vb.y, vb.z, vb.w};
#pragma unroll
              for (int i = 0; i < 8; ++i) *(LAS unsigned short*)(bb + lx[(4 * j + (i >> 1)) & 7] + (1024 * j + 128 * i)) = (unsigned short)((i & 1) ? (e[i >> 1] >> 16) : (e[i >> 1] & 0xffffu)); } }
        { const float a = -__expf(F.in[I_ALOG][h]);
          const float dtv = softplusf_(bf2f(PROJ[(t0 + lane) * IN_PAD + OFF_DT + h]) + F.in[I_DTB][h]);
          float ac = dtv * a;
#pragma unroll
          for (int o = 1; o < 64; o <<= 1) { const float nb = __shfl_up(ac, o); if (lane >= o) ac += nb; }
          const float alast = __shfl(ac, 63);
          ((LAS float*)(L + SDT_OFF))[w * 64 + lane] = dtv; ((LAS float*)(L + SAC_OFF))[w * 64 + lane] = ac; ((LAS float*)(L + SW_OFF))[w * 64 + lane] = __expf(alast - ac) * dtv;
          ACUM[(t0 + lane) * SSD_H + h] = ac; if (lane == 63) CDEC[((size_t)b * NCHUNK + c) * SSD_H + h] = __expf(ac); }
        __syncthreads();
        f32x4 cacc[2];
#pragma unroll
        for (int j = 0; j < 2; ++j) { const int q = 2 * w + j, bi = q >> 2, bj = q & 3; cacc[j] = (f32x4){0.f, 0.f, 0.f, 0.f};
#pragma unroll
            for (int ks = 0; ks < 4; ++ks) { const bf16x8 af = *(const LAS bf16x8*)(L + CN_OFF + (16 * bi + (lane & 15)) * NP + (32 * ks + 8 * (lane >> 4)) * 2);
                const bf16x8 bfg = *(const LAS bf16x8*)(L + BN_OFF + (16 * bj + (lane & 15)) * NP + (32 * ks + 8 * (lane >> 4)) * 2);
                cacc[j] = __builtin_amdgcn_mfma_f32_16x16x32_bf16(af, bfg, cacc[j], 0, 0, 0); } }
        __syncthreads();
#pragma unroll
        for (int j = 0; j < 2; ++j) { const int q = 2 * w + j, bi = q >> 2, bj = q & 3;
#pragma unroll
            for (int r = 0; r < 4; ++r) *(LAS float*)(L + CN_OFF + (16 * bi + 4 * (lane >> 4) + r) * NP + (16 * bj + (lane & 15)) * 4) = cacc[j][r]; }
        __syncthreads();
        bf16x8 xf[2][4];
#pragma unroll
        for (int pb = 0; pb < 2; ++pb)
#pragma unroll
            for (int ks = 0; ks < 4; ++ks) xf[pb][ks] = *(const LAS bf16x8*)(L + XT_OFF + xt_frag(w * 64 + 32 * pb + r32, 2 * ks + hi));
        const LAS float* sdt = (const LAS float*)(L + SDT_OFF) + w * 64; const LAS float* sac = (const LAS float*)(L + SAC_OFF) + w * 64; const LAS float* sw = (const LAS float*)(L + SW_OFF) + w * 64;
        const float dsk = F.in[I_DSKIP][h];
        f32x16 yacc[2][2];
#pragma unroll
        for (int lb = 0; lb < 2; ++lb)
#pragma unroll
            for (int pb = 0; pb < 2; ++pb) yacc[lb][pb] = f32x16{};
#pragma unroll
        for (int lb = 0; lb < 2; ++lb) { const int l = 32 * lb + r32; const float acl = sac[l];
#pragma unroll
            for (int ks = 0; ks < 4; ++ks) { if (ks >= 2 * lb + 2) continue;
                const int s0 = 16 * ks + 8 * hi;
                const f32x4 c0 = *(const LAS f32x4*)(L + CN_OFF + l * NP + s0 * 4), c1 = *(const LAS f32x4*)(L + CN_OFF + l * NP + s0 * 4 + 16);
                const f32x4 a0 = *(const LAS f32x4*)(sac + s0), a1 = *(const LAS f32x4*)(sac + s0 + 4), d0 = *(const LAS f32x4*)(sdt + s0), d1 = *(const LAS f32x4*)(sdt + s0 + 4);
                float mv[8];
#pragma unroll
                for (int j = 0; j < 8; ++j) { const int s = s0 + j; const float cb = j < 4 ? c0[j & 3] : c1[j & 3], as = j < 4 ? a0[j & 3] : a1[j & 3], ds = j < 4 ? d0[j & 3] : d1[j & 3];
                    float v = (s <= l) ? cb * __expf(acl - as) * ds : 0.f; if (s == l) v += dsk; mv[j] = v; }
                const v4u mw = pack8(mv); const bf16x8 mf = __builtin_bit_cast(bf16x8, mw);
#pragma unroll
                for (int pb = 0; pb < 2; ++pb) yacc[lb][pb] = __builtin_amdgcn_mfma_f32_32x32x16_bf16(xf[pb][ks], mf, yacc[lb][pb], 0, 0, 0); } }
#pragma unroll
        for (int lb = 0; lb < 2; ++lb)
#pragma unroll
            for (int pb = 0; pb < 2; ++pb)
#pragma unroll
                for (int q = 0; q < 4; q += 2) { v2u oa, ob; oa.x = pk2(yacc[lb][pb][4 * q], yacc[lb][pb][4 * q + 1]); oa.y = pk2(yacc[lb][pb][4 * q + 2], yacc[lb][pb][4 * q + 3]);
                    ob.x = pk2(yacc[lb][pb][4 * q + 4], yacc[lb][pb][4 * q + 5]); ob.y = pk2(yacc[lb][pb][4 * q + 6], yacc[lb][pb][4 * q + 7]);
                    *(v4u*)(YDIAG + (t0 + 32 * lb + r32) * DM + h * SSD_P + 32 * pb + 8 * q + 8 * hi) = widen_pair(oa, ob); }
#pragma unroll
        for (int ks = 0; ks < 4; ++ks) { const int s0 = 16 * ks + 8 * hi; const f32x4 w0 = *(const LAS f32x4*)(sw + s0), w1 = *(const LAS f32x4*)(sw + s0 + 4);
#pragma unroll
            for (int pb = 0; pb < 2; ++pb) { float xv[8]; unpack8(__builtin_bit_cast(v4u, xf[pb][ks]), xv);
                xv[0] *= w0[0]; xv[1] *= w0[1]; xv[2] *= w0[2]; xv[3] *= w0[3]; xv[4] *= w1[0]; xv[5] *= w1[1]; xv[6] *= w1[2]; xv[7] *= w1[3];
                xf[pb][ks] = __builtin_bit_cast(bf16x8, pack8(xv)); } }
        bf16* stp = STATES + (((size_t)b * NCHUNK + c) * SSD_H + h) * (SSD_P * SSD_N);
#pragma unroll 1
        for (int nb = 0; nb < 4; ++nb) { bf16x8 bt[4];
#pragma unroll
            for (int ks = 0; ks < 4; ++ks) bt[ks] = *(const LAS bf16x8*)(L + BT_OFF + xt_frag(32 * nb + r32, 2 * ks + hi));
#pragma unroll
            for (int pb = 0; pb < 2; ++pb) { f32x16 sa = f32x16{};
#pragma unroll
                for (int ks = 0; ks < 4; ++ks) sa = __builtin_amdgcn_mfma_f32_32x32x16_bf16(bt[ks], xf[pb][ks], sa, 0, 0, 0);
#pragma unroll
                for (int q = 0; q < 4; q += 2) { v2u oa, ob; oa.x = pk2(sa[4 * q], sa[4 * q + 1]); oa.y = pk2(sa[4 * q + 2], sa[4 * q + 3]); ob.x = pk2(sa[4 * q + 4], sa[4 * q + 5]); ob.y = pk2(sa[4 * q + 6], sa[4 * q + 7]);
                    *(v4u*)(stp + (32 * pb + r32) * SSD_N + 32 * nb + 8 * q + 8 * hi) = widen_pair(oa, ob); } } }
    }
}
__device__ __forceinline__ void p6_ssd_scan(Frame& F) {
    bf16* STATES = WSP(bf16, WS_STATES); const float* CDEC = WSP(float, WS_CDEC);
    constexpr int NEL = BATCH * SSD_H * SSD_P * (SSD_N / 2);
    constexpr size_t CSTR = (size_t)SSD_H * SSD_P * SSD_N / 2;
    constexpr int SB = 16;
    static_assert(NCHUNK % (2 * SB) == 0, "scan batches");
    for (int idx = (int)blockIdx.x * NTHR + F.tid; idx < NEL; idx += F.G * NTHR) {
        const int n2 = idx & 63, p = (idx >> 6) & 63, h = (idx >> 12) & 15, b = idx >> 16;
        unsigned* ptr = (unsigned*)STATES + ((size_t)b * NCHUNK * SSD_H + h) * (SSD_P * SSD_N / 2) + p * (SSD_N / 2) + n2;
        const float* dec = CDEC + (size_t)b * NCHUNK * SSD_H + h;
        float h0 = 0.f, h1 = 0.f;
        unsigned uA[SB], uB[SB]; float dA[SB], dB[SB];
#define SC_LOAD(U, D, c0) do { _Pragma("unroll") for (int i = 0; i < SB; ++i) { U[i] = ptr[(size_t)((c0) + i) * CSTR]; D[i] = dec[((c0) + i) * SSD_H]; } } while (0)
#define SC_PROC(U, D, c0) do { _Pragma("unroll") for (int i = 0; i < SB; ++i) { const unsigned pv = pk2(h0, h1); h0 = D[i] * h0 + blo(U[i]); h1 = D[i] * h1 + bhi(U[i]); ptr[(size_t)((c0) + i) * CSTR] = pv; } } while (0)
        SC_LOAD(uA, dA, 0);
#pragma unroll 1
        for (int c = 0; c < NCHUNK; c += 2 * SB) {
            SC_LOAD(uB, dB, c + SB); asm volatile("" : "+v"(uA[0]) :: "memory");
            SC_PROC(uA, dA, c);
            const int cn = (c + 2 * SB < NCHUNK) ? c + 2 * SB : c + SB;
            SC_LOAD(uA, dA, cn); asm volatile("" : "+v"(uB[0]) :: "memory");
            SC_PROC(uB, dB, c + SB);
        }
#undef SC_LOAD
#undef SC_PROC
    }
}
__device__ __forceinline__ void p7_ssd_c3(Frame& F) {
    using namespace ssd;
    const bf16* PROJ = WSP(bf16, WS_PROJ); const bf16* XC = WSP(bf16, WS_XC); const bf16* YDIAG = WSP(bf16, WS_YDIAG); const bf16* STATES = WSP(bf16, WS_STATES);
    const float* ACUM = WSP(float, WS_ACUM); bf16* YN = WSP(bf16, WS_YN);
    LAS unsigned char* L = F.lds; LAS float* red = (LAS float*)(L + 64 * NP);
    const int tid = F.tid, lane = F.lane, w = F.wave, r32 = lane & 31, hi = lane >> 5;
    for (int it = (int)blockIdx.x; it < BATCH * NCHUNK * SSD_G; it += F.G) {
        const int g = it & 1, c = (it >> 1) & (NCHUNK - 1), b = it >> 8, h = g * SSD_HPG + w;
        const size_t t0 = (size_t)b * SEQ + (size_t)c * CHUNK;
        __syncthreads();
        { const int row = tid >> 3;
#pragma unroll
          for (int j = 0; j < 2; ++j) { const int ch = (tid & 7) * 2 + j; *(LAS v4u*)(L + row * NP + ch * 16) = *(const v4u*)(XC + (t0 + row) * CONV_DIM + 1280 + g * 128 + ch * 8); } }
        __syncthreads();
        const bf16* prev = STATES + (((size_t)b * NCHUNK + c) * SSD_H + h) * (SSD_P * SSD_N);
        bf16x8 bq[2][8];
#pragma unroll
        for (int pb = 0; pb < 2; ++pb)
#pragma unroll
            for (int ks = 0; ks < 8; ++ks) bq[pb][ks] = *(const bf16x8*)(prev + (32 * pb + r32) * SSD_N + 16 * ks + 8 * hi);
        float eac[2]; v2u yd[2][2][4], zz[2][2][4];
#pragma unroll
        for (int lb = 0; lb < 2; ++lb) { const size_t row = t0 + 32 * lb + r32; eac[lb] = ACUM[row * SSD_H + h];
#pragma unroll
            for (int pb = 0; pb < 2; ++pb)
#pragma unroll
                for (int q = 0; q < 4; ++q) { const int col = h * SSD_P + 32 * pb + 8 * q + 4 * hi; yd[lb][pb][q] = *(const v2u*)(YDIAG + row * DM + col); zz[lb][pb][q] = *(const v2u*)(PROJ + row * IN_PAD + col); } }
        f32x16 acc[2][2];
#pragma unroll
        for (int pb = 0; pb < 2; ++pb)
#pragma unroll
            for (int lb = 0; lb < 2; ++lb) acc[pb][lb] = f32x16{};
#pragma unroll
        for (int ks = 0; ks < 8; ++ks) { bf16x8 af[2];
#pragma unroll
            for (int lb = 0; lb < 2; ++lb) af[lb] = *(const LAS bf16x8*)(L + (32 * lb + r32) * NP + (16 * ks + 8 * hi) * 2);
#pragma unroll
            for (int pb = 0; pb < 2; ++pb)
#pragma unroll
                for (int lb = 0; lb < 2; ++lb) acc[pb][lb] = __builtin_amdgcn_mfma_f32_32x32x16_bf16(bq[pb][ks], af[lb], acc[pb][lb], 0, 0, 0); }
#pragma unroll
        for (int lb = 0; lb < 2; ++lb) { const float ea = __expf(eac[lb]); float ss = 0.f;
#pragma unroll
            for (int pb = 0; pb < 2; ++pb)
#pragma unroll
                for (int q = 0; q < 4; ++q) { const float y4[4] = {blo(yd[lb][pb][q].x), bhi(yd[lb][pb][q].x), blo(yd[lb][pb][q].y), bhi(yd[lb][pb][q].y)};
                    const float z4[4] = {blo(zz[lb][pb][q].x), bhi(zz[lb][pb][q].x), blo(zz[lb][pb][q].y), bhi(zz[lb][pb][q].y)};
#pragma unroll
                    for (int i = 0; i < 4; ++i) { const float y = (y4[i] + ea * acc[pb][lb][4 * q + i]) * siluf_(z4[i]); acc[pb][lb][4 * q + i] = y; ss += y * y; } }
            ss += __shfl_xor(ss, 32);
            if (hi == 0) red[w * 64 + 32 * lb + r32] = ss; }
        __syncthreads();
#pragma unroll
        for (int lb = 0; lb < 2; ++lb) { const size_t row = t0 + 32 * lb + r32; float tot = 0.f;
#pragma unroll
            for (int i = 0; i < 8; ++i) tot += red[i * 64 + 32 * lb + r32];
            const float rs = rsqrtf(tot * (1.f / 512.f) + EPS);
#pragma unroll
            for (int pb = 0; pb < 2; ++pb)
#pragma unroll
                for (int q = 0; q < 4; q += 2) { const int col = h * SSD_P + 32 * pb + 8 * q + 4 * hi; const f32x4 ga = *(const f32x4*)(F.in[I_GSSD] + col), gb = *(const f32x4*)(F.in[I_GSSD] + col + 8); v2u oa, ob;
                    oa.x = pk2(acc[pb][lb][4 * q] * rs * ga[0], acc[pb][lb][4 * q + 1] * rs * ga[1]); oa.y = pk2(acc[pb][lb][4 * q + 2] * rs * ga[2], acc[pb][lb][4 * q + 3] * rs * ga[3]);
                    ob.x = pk2(acc[pb][lb][4 * q + 4] * rs * gb[0], acc[pb][lb][4 * q + 5] * rs * gb[1]); ob.y = pk2(acc[pb][lb][4 * q + 6] * rs * gb[2], acc[pb][lb][4 * q + 7] * rs * gb[3]);
                    *(v4u*)(YN + row * DM + h * SSD_P + 32 * pb + 8 * q + 8 * hi) = widen_pair(oa, ob); } }
    }
}
__device__ __forceinline__ int wr_off(int k, int slot) { return (k >> 1) * 64 + (k & 1) * 32 + ((slot ^ ((k >> 1) & 7)) << 2); }
__device__ __forceinline__ void p11_router(Frame& F) {
    LAS float* wr = (LAS float*)(F.lds);
    LAS unsigned* cnt = (LAS unsigned*)(F.lds + LDSCTL_OFF);
    const float* x1 = F.out; unsigned char* H2 = WSP(unsigned char, WS_XN); int* TOPI = WSP(int, WS_TOPI); float* TOPG = WSP(float, WS_TOPG); int* CNT = WSP(int, WS_CNT);
    const int tid = F.tid, lane = F.lane, w = F.wave;
    typedef float f32x2_ __attribute__((ext_vector_type(2)));
    __syncthreads();
    { f32x4 tw[16];
#pragma unroll
      for (int it = 0; it < 16; ++it) tw[it] = *(const f32x4*)(F.in[I_WR] + (size_t)(tid + it * NTHR) * 4);
#pragma unroll
      for (int it = 0; it < 16; ++it) { const int i = tid + it * NTHR, k = i >> 3, sl = i & 7; *(LAS f32x4*)(wr + wr_off(k, sl)) = tw[it]; } }
    const int e = lane & 31, hf = lane >> 5;
    const float bre = F.in[I_BR][e];
    const LAS float* wb[8];
#pragma unroll
    for (int sl = 0; sl < 8; ++sl) wb[sl] = wr + (lane >> 1) * 64 + (lane & 1) * 32 + ((sl ^ ((lane >> 1) & 7)) << 2);
    LAS float* gfl = (LAS float*)(F.lds + LDSCTL_OFF + 4096);
    for (int i = tid; i < DM; i += NTHR) gfl[i] = F.in[I_GFFN][i];
    const LAS float* gfp = gfl + lane;
    for (int vb = (int)blockIdx.x; vb < T / 64; vb += F.G) {
        __syncthreads();
        if (tid < 32) cnt[tid] = 0u;
        __syncthreads();
        float hvA[16], hvB[16];
#pragma unroll
        for (int j = 0; j < 16; ++j) { hvA[j] = x1[(size_t)(vb * 64 + w * 8) * DM + lane + 64 * j]; hvB[j] = x1[(size_t)(vb * 64 + w * 8 + 1) * DM + lane + 64 * j]; }
#pragma unroll 1
        for (int tp = 0; tp < 4; ++tp) {
            const int tkA = vb * 64 + w * 8 + 2 * tp;
            float ssA = 0.f, ssB = 0.f;
#pragma unroll
            for (int j = 0; j < 16; ++j) { ssA += hvA[j] * hvA[j]; ssB += hvB[j] * hvB[j]; }
            const float* xn = x1 + (size_t)(tkA + (tp < 3 ? 2 : 0)) * DM;
            float rA, rB;
            { float s2 = (hf ? ssB : ssA) + __shfl_xor(hf ? ssA : ssB, 32);
#pragma unroll
              for (int o = 1; o < 32; o <<= 1) s2 += __shfl_xor(s2, o);
              const float r = rsqrtf(s2 * (1.f / DM) + EPS); rA = __shfl(r, 0); rB = __shfl(r, 32); }
            f32x2_ lgA[16], lgB[16];
#pragma unroll
            for (int i = 0; i < 16; ++i) { lgA[i] = (f32x2_){0.f, 0.f}; lgB[i] = (f32x2_){0.f, 0.f}; }
#pragma unroll
            for (int j = 0; j < 16; ++j) { const float gj = gfp[64 * j]; const float ha = hvA[j] * rA * gj, hb = hvB[j] * rB * gj;
                H2[(size_t)tkA * DM + lane + 64 * j] = (unsigned char)(__builtin_amdgcn_cvt_pk_fp8_f32(fminf(fmaxf(ha * H2_SCALE, -448.f), 448.f), 0.f, 0, false) & 0xff);
                H2[(size_t)(tkA + 1) * DM + lane + 64 * j] = (unsigned char)(__builtin_amdgcn_cvt_pk_fp8_f32(fminf(fmaxf(hb * H2_SCALE, -448.f), 448.f), 0.f, 0, false) & 0xff);
                hvA[j] = xn[lane + 64 * j]; hvB[j] = xn[DM + lane + 64 * j];
                const f32x2_ ha2 = (f32x2_){ha, ha}, hb2 = (f32x2_){hb, hb};
#pragma unroll
                for (int sl = 0; sl < 8; ++sl) { const f32x4 wv = *(const LAS f32x4*)(wb[sl] + j * 2048);
                    const f32x2_ w01 = (f32x2_){wv[0], wv[1]}, w23 = (f32x2_){wv[2], wv[3]};
                    lgA[2 * sl] = ha2 * w01 + lgA[2 * sl]; lgA[2 * sl + 1] = ha2 * w23 + lgA[2 * sl + 1];
                    lgB[2 * sl] = hb2 * w01 + lgB[2 * sl]; lgB[2 * sl + 1] = hb2 * w23 + lgB[2 * sl + 1]; }
                if (j & 1) __builtin_amdgcn_sched_barrier(0); }
            float lg[32];
#pragma unroll
            for (int i = 0; i < 32; ++i) { const float a = (i & 1) ? lgA[i >> 1].y : lgA[i >> 1].x, b = (i & 1) ? lgB[i >> 1].y : lgB[i >> 1].x; lg[i] = (hf ? b : a) + __shfl_xor(hf ? a : b, 32); }
#define RED_STEP(NV, MSK) { const bool up = (lane & (MSK)) != 0; _Pragma("unroll") for (int i = 0; i < (NV) / 2; ++i) { const float snd = up ? lg[i] : lg[i + (NV) / 2]; const float kp = up ? lg[i + (NV) / 2] : lg[i]; lg[i] = kp + __shfl_xor(snd, (MSK)); } }
            RED_STEP(32, 16) RED_STEP(16, 8) RED_STEP(8, 4) RED_STEP(4, 2) RED_STEP(2, 1)
#undef RED_STEP
            const float v = lg[0] + bre;
            float tv[4]; int tix[4];
            { const unsigned vb_ = __float_as_uint(v); float key = __uint_as_float((vb_ & ~31u) | (unsigned)((vb_ >> 31) ? e : 31 - e));
#pragma unroll
              for (int k = 0; k < 4; ++k) { float mx = key;
#pragma unroll
                  for (int o = 1; o < 32; o <<= 1) mx = fmaxf(mx, __shfl_xor(mx, o));
                  const unsigned mb = __float_as_uint(mx); const int es = (mb >> 31) ? (int)(mb & 31u) : 31 - (int)(mb & 31u);
                  tv[k] = mx; tix[k] = es; if (e == es) key = -INFINITY; } }
            const float e1 = __expf(tv[1] - tv[0]), e2 = __expf(tv[2] - tv[0]), e3 = __expf(tv[3] - tv[0]), inv = 1.0f / (1.0f + e1 + e2 + e3);
            if (e == 0) { const int tk = tkA + hf; *(int4*)(TOPI + (size_t)tk * 4) = make_int4(tix[0], tix[1], tix[2], tix[3]); *(f32x4*)(TOPG + (size_t)tk * 4) = (f32x4){inv, e1 * inv, e2 * inv, e3 * inv};
                __hip_atomic_fetch_add(&cnt[tix[0]], 1u, __ATOMIC_RELAXED, __HIP_MEMORY_SCOPE_WORKGROUP); __hip_atomic_fetch_add(&cnt[tix[1]], 1u, __ATOMIC_RELAXED, __HIP_MEMORY_SCOPE_WORKGROUP); __hip_atomic_fetch_add(&cnt[tix[2]], 1u, __ATOMIC_RELAXED, __HIP_MEMORY_SCOPE_WORKGROUP); __hip_atomic_fetch_add(&cnt[tix[3]], 1u, __ATOMIC_RELAXED, __HIP_MEMORY_SCOPE_WORKGROUP); }
        }
        __syncthreads();
        if (tid < 32) CNT[vb * 32 + tid] = (int)cnt[tid];
    }
}

__device__ __forceinline__ void p12_slots(Frame& F) {
    LAS int* tot = (LAS int*)(F.lds); LAS int* pre = tot + 32; LAS int* start = pre + 32; LAS int* cur = start + 32; LAS int* nmt_s = cur + 32; LAS int* psum = nmt_s + 32; LAS int* ppre = psum + 512;
    const int* CNT = WSP(int, WS_CNT); const int* TOPI = WSP(int, WS_TOPI); int* SLOT = WSP(int, WS_SLOT); int* ROWTOK = WSP(int, WS_ROWTOK); int* MTE = WSP(int, WS_MTE);
    const int tid = F.tid, lane = F.lane;
    for (int vb = (int)blockIdx.x; vb < T / 64; vb += F.G) {
        __syncthreads();
        const int4 ti = *(const int4*)(TOPI + (size_t)(vb * 64 + lane) * 4);
        { const int e = tid & 31, part = tid >> 5; int a = 0, p = 0;
#pragma unroll
          for (int i = 0; i < 16; ++i) { const int c = CNT[(part * 16 + i) * 32 + e]; if (part * 16 + i < vb) p += c; a += c; }
          psum[part * 32 + e] = a; ppre[part * 32 + e] = p; }
        __syncthreads();
        if (tid < 64) { const int e = lane & 31; int a = 0, p = 0;
#pragma unroll
            for (int i = 0; i < 16; ++i) { a += psum[i * 32 + e]; p += ppre[i * 32 + e]; }
            const int pd = ((a + 255) >> 8) << 8; int incl = pd;
#pragma unroll
            for (int o = 1; o < 32; o <<= 1) { const int nb = __shfl_up(incl, o); if ((lane & 31) >= o) incl += nb; }
            if (lane < 32) { tot[e] = a; start[e] = incl - pd; cur[e] = incl - pd + p; if (e == 31) nmt_s[0] = incl >> 8; } }
        __syncthreads();
        if (tid < 64) {
            const int tk = vb * 64 + lane; int ex[4] = {ti.x, ti.y, ti.z, ti.w}; int sl[4] = {0, 0, 0, 0};
#pragma unroll 4
            for (int ee = 0; ee < 32; ++ee) {
                const bool mine = (ex[0] == ee) | (ex[1] == ee) | (ex[2] == ee) | (ex[3] == ee);
                const unsigned long long mk = __ballot(mine);
                const int below = (int)__builtin_amdgcn_mbcnt_hi((unsigned)(mk >> 32), __builtin_amdgcn_mbcnt_lo((unsigned)mk, 0u));
                const int base = cur[ee] + below;
#pragma unroll
                for (int k = 0; k < 4; ++k) if (ex[k] == ee) sl[k] = base;
            }
            *(int4*)(SLOT + (size_t)tk * 4) = make_int4(sl[0], sl[1], sl[2], sl[3]);
#pragma unroll
            for (int k = 0; k < 4; ++k) ROWTOK[sl[k]] = tk;
        }
        if (vb < 32) {
            const int e = vb, n = tot[e], pd = ((n + 255) >> 8) << 8; for (int i = n + tid; i < pd; i += NTHR) ROWTOK[start[e] + i] = 0;
            for (int i = tid; i < (pd >> 8); i += NTHR) MTE[(start[e] >> 8) + i] = e;
            if (vb == 0 && tid == 0) MTE[MT_MAX] = nmt_s[0];
        }
    }
}

__device__ __forceinline__ void p13_gateup_naive(Frame& F) {
    LAS bf16* hs = (LAS bf16*)(F.lds);
    const bf16* H2 = WSP(bf16, WS_XN); const int* ROWTOK = WSP(int, WS_ROWTOK); const int* MTE = WSP(int, WS_MTE); bf16* ACT = WSP(bf16, WS_ACT);
    const int tid = F.tid, nmt = MTE[MT_MAX];
    for (int it = (int)blockIdx.x; it < nmt * 16; it += F.G) {
        const int mt = it >> 4, s0 = it * 16, e = MTE[mt];
        __syncthreads();
        for (int i = tid; i < 16 * 128; i += NTHR) { const int r = i >> 7, c = (i & 127) * 8; *(LAS v4u*)(hs + r * 1024 + c) = *(const v4u*)(H2 + (size_t)ROWTOK[s0 + r] * DM + c); }
        __syncthreads();
        const bf16* We = WSP(bf16, WS_WGU) + (size_t)e * 2 * FF * DM;
#pragma unroll 1
        for (int jj = 0; jj < 2; ++jj) {
            const int j = tid + 512 * jj, rowg = (j >> 7) * 256 + (j & 127), rowl = rowg + 128;
            float ag[16], al[16];
#pragma unroll
            for (int s = 0; s < 16; ++s) { ag[s] = 0.f; al[s] = 0.f; }
#pragma unroll 1
            for (int k = 0; k < DM; k += 8) { float wg[8], wl[8]; unpack8(*(const v4u*)(We + (size_t)rowg * DM + k), wg); unpack8(*(const v4u*)(We + (size_t)rowl * DM + k), wl);
#pragma unroll
                for (int s = 0; s < 16; ++s) { float hv[8]; unpack8(*(const LAS v4u*)(hs + s * 1024 + k), hv);
#pragma unroll
                    for (int q = 0; q < 8; ++q) { ag[s] += hv[q] * wg[q]; al[s] += hv[q] * wl[q]; } } }
            const float bg = F.in[I_BGU][(size_t)e * 2 * FF + j], bl = F.in[I_BGU][(size_t)e * 2 * FF + FF + j];
#pragma unroll
            for (int s = 0; s < 16; ++s) { const float glu = fminf(ag[s] + bg, 7.0f), lin = fminf(fmaxf(al[s] + bl, -7.0f), 7.0f);
                ACT[(size_t)(s0 + s) * FF + j] = (bf16)f2bf(glu * (1.0f / (1.0f + __expf(-1.702f * glu))) * (lin + 1.0f)); }
        }
    }
}
__device__ __forceinline__ void p14_down_naive(Frame& F) {
    LAS bf16* as = (LAS bf16*)(F.lds);
    const int* MTE = WSP(int, WS_MTE); const bf16* ACT = WSP(bf16, WS_ACT); bf16* YS = WSP(bf16, WS_YS);
    const int tid = F.tid, nmt = MTE[MT_MAX];
    for (int it = (int)blockIdx.x; it < nmt * 16; it += F.G) {
        const int mt = it >> 4, s0 = it * 16, e = MTE[mt];
        __syncthreads();
        for (int i = tid; i < 16 * 128; i += NTHR) { const int r = i >> 7, c = (i & 127) * 8; *(LAS v4u*)(as + r * 1024 + c) = *(const v4u*)(ACT + (size_t)(s0 + r) * FF + c); }
        __syncthreads();
        const bf16* We = WSP(bf16, WS_WDN) + (size_t)e * DM * FF;
#pragma unroll 1
        for (int jj = 0; jj < 2; ++jj) {
            const int j = tid + 512 * jj;
            float a[16];
#pragma unroll
            for (int s = 0; s < 16; ++s) a[s] = 0.f;
#pragma unroll 1
            for (int k = 0; k < FF; k += 8) { float wv[8]; unpack8(*(const v4u*)(We + (size_t)j * FF + k), wv);
#pragma unroll
                for (int s = 0; s < 16; ++s) { float hv[8]; unpack8(*(const LAS v4u*)(as + s * 1024 + k), hv);
#pragma unroll
                    for (int q = 0; q < 8; ++q) a[s] += hv[q] * wv[q]; } }
            const float bd = F.in[I_BDN][(size_t)e * DM + j];
#pragma unroll
            for (int s = 0; s < 16; ++s) YS[(size_t)(s0 + s) * DM + j] = (bf16)f2bf(a[s] + bd);
        }
    }
}
__device__ __forceinline__ void p15_combine(Frame& F) {
    const bf16* YS = WSP(bf16, WS_YS); const int* SLOT = WSP(int, WS_SLOT); const float* TOPG = WSP(float, WS_TOPG);
    const int gw = F.vcu * NWAVES + F.wave, NGW = F.G * NWAVES, lane = F.lane;
    for (int tk = gw; tk < T; tk += NGW) {
        const int4 sl = *(const int4*)(SLOT + (size_t)tk * 4); const f32x4 g = *(const f32x4*)(TOPG + (size_t)tk * 4);
        const int s4[4] = {sl.x, sl.y, sl.z, sl.w}; const float g4[4] = {g[0], g[1], g[2], g[3]};
        float* orow = F.out + (size_t)tk * DM;
#pragma unroll
        for (int j = 0; j < 4; ++j) { f32x4 o = *(const f32x4*)(orow + 4 * lane + 256 * j);
#pragma unroll
            for (int k = 0; k < 4; ++k) { const v2u y = __builtin_nontemporal_load((const v2u*)(YS + (size_t)s4[k] * DM + 4 * lane + 256 * j));
                o[0] += g4[k] * blo(y.x); o[1] += g4[k] * bhi(y.x); o[2] += g4[k] * blo(y.y); o[3] += g4[k] * bhi(y.y); }
            __builtin_nontemporal_store(o, (f32x4*)(orow + 4 * lane + 256 * j)); }
    }
}
namespace pg8 {
__device__ __forceinline__ float xsum4(float v) { v += __shfl_xor(v, 16); v += __shfl_xor(v, 32); return v; }
struct EpiQUp {
    static constexpr bool PERM = true, AFTER_DRAIN = false;
    const float* gq; unsigned char* ws;
    __device__ __forceinline__ void operator()(f32x4 (&acc)[2][2][4][2], const Unit& u, int wr, int wc, int fr, int fq) const {
        asm volatile("" : "+v"(fr), "+v"(fq));
        PG8_ZDECL();
        const int row0 = u.pm * BM + wr * 64 + fr; const float* RT = (const float*)(ws + WS_ROPE); bf16_t* Q = (bf16_t*)(ws + WS_Q); float* SSQ = (float*)(ws + WS_SSQ);
#pragma unroll
        for (int bj = 0; bj < 2; ++bj) {
            const int colg = u.pn * BM + bj * HALF + wc * 32, h = colg / 192, d0 = colg % 192, g32 = colg >> 5;
            const bool rope = d0 >= 128; const int i4 = rope ? ((d0 - 128) >> 3) + fq : 0;
            const float* gp = gq + (rope ? 128 + 4 * i4 : d0 + 8 * fq); const f32x4 g0 = *(const f32x4*)gp, g1 = *(const f32x4*)(gp + (rope ? 32 : 4));
            f32x4 cs[8], sn[8];
            if (rope) {
#pragma unroll
                for (int q = 0; q < 8; ++q) { const int s = (row0 + (q >> 2) * HALF + (q & 3) * 16) & (8192 - 1); cs[q] = *(const f32x4*)(RT + s * 64 + 4 * i4); sn[q] = *(const f32x4*)(RT + s * 64 + 32 + 4 * i4); } }
#pragma unroll
            for (int q = 0; q < 8; ++q) { const int ai = q >> 2, m = q & 3, row = row0 + ai * HALF + m * 16, b = row >> 13, s = row & (8192 - 1);
                const f32x4 v0 = acc[ai][bj][m][0], v1 = acc[ai][bj][m][1];
                const float ss = xsum4(((v0[0] * v0[0] + v0[1] * v0[1]) + (v0[2] * v0[2] + v0[3] * v0[3])) + ((v1[0] * v1[0] + v1[1] * v1[1]) + (v1[2] * v1[2] + v1[3] * v1[3])));
                if (fq == 0) SSQ[(size_t)row * 48 + g32] = ss;
                bf16_t* qrow = Q + ((size_t)(b * 8 + h) * 8192 + s) * 192;
                const f32x4 x1 = v0 * g0, x2 = v1 * g1;
                if (!rope) { u32x4 w; w.x = cvt_pk_bf16(x1[0], x1[1]); w.y = cvt_pk_bf16(x1[2], x1[3]); w.z = cvt_pk_bf16(x2[0], x2[1]); w.w = cvt_pk_bf16(x2[2], x2[3]); *(u32x4*)(qrow + d0 + 8 * fq) = w; }
                else { const f32x4 o1 = x1 * cs[q] - x2 * sn[q], o2 = x2 * cs[q] + x1 * sn[q]; typedef unsigned u32x2_ __attribute__((ext_vector_type(2)));
                    *(u32x2_*)(qrow + 128 + 4 * i4) = (u32x2_){cvt_pk_bf16(o1[0], o1[1]), cvt_pk_bf16(o1[2], o1[3])}; *(u32x2_*)(qrow + 160 + 4 * i4) = (u32x2_){cvt_pk_bf16(o2[0], o2[1]), cvt_pk_bf16(o2[2], o2[3])}; }
                PG8_ZACC(acc[ai][bj][m][0]); PG8_ZACC(acc[ai][bj][m][1]); }
        }
    }
};
struct EpiKVUp {
    static constexpr bool PERM = true, AFTER_DRAIN = false;
    const float* gk; unsigned char* ws; PG8_LAS float* lds;
    __device__ __forceinline__ void operator()(f32x4 (&acc)[2][2][4][2], const Unit& u, int wr, int wc, int fr, int fq) const {
        asm volatile("" : "+v"(fr), "+v"(fq));
        PG8_ZDECL();
        PG8_LAS float* part = lds; PG8_LAS float* rkvl = lds + 1024; PG8_LAS float* sskl = lds + 1280;
        const float* RT = (const float*)(ws + WS_ROPE); const bf16_t* KVL = (const bf16_t*)(ws + WS_KVLAT); const bf16_t* KR = (const bf16_t*)(ws + WS_PROJ) + OFF_KROPE; constexpr int ldkr = IN_PAD;
        bf16_t* K = (bf16_t*)(ws + WS_K); bf16_t* V = (bf16_t*)(ws + WS_V);
        const int h = u.pn, rl0 = wr * 64 + fr;
#pragma unroll
        for (int aj = 0; aj < 2; ++aj) { const int rl = rl0 + aj * HALF + wc * 16, row = u.pm * BM + rl;
            const u32x4* lp = (const u32x4*)(KVL + (size_t)row * 256 + 64 * fq); u32x4 lw[8];
#pragma unroll
            for (int j = 0; j < 8; ++j) lw[j] = lp[j];
            const u32x4 k1 = *(const u32x4*)(KR + (size_t)row * ldkr + 8 * fq), k2 = *(const u32x4*)(KR + (size_t)row * ldkr + 32 + 8 * fq);
            float ss = 0.f;
#pragma unroll
            for (int j = 0; j < 8; ++j) { const unsigned ww[4] = {lw[j].x, lw[j].y, lw[j].z, lw[j].w};
#pragma unroll
                for (int e = 0; e < 4; ++e) { const float a = bf_lo(ww[e]), b2 = bf_hi(ww[e]); ss += a * a + b2 * b2; } }
            ss = xsum4(ss);
            float sk = 0.f; { const unsigned ww[8] = {k1.x, k1.y, k1.z, k1.w, k2.x, k2.y, k2.z, k2.w};
#pragma unroll
                for (int e = 0; e < 8; ++e) { const float a = bf_lo(ww[e]), b2 = bf_hi(ww[e]); sk += a * a + b2 * b2; } }
            sk = xsum4(sk);
            if (fq == 0) { rkvl[rl] = rsqrtf(ss * (1.f / 256.f) + 1e-6f); sskl[rl] = sk; }
            asm volatile("" ::: "memory"); }
#pragma unroll
        for (int q = 0; q < 8; ++q) { const int ai = q >> 2, m = q & 3; const f32x4 v0 = acc[ai][0][m][0], v1 = acc[ai][0][m][1];
            const float ss = xsum4(((v0[0] * v0[0] + v0[1] * v0[1]) + (v0[2] * v0[2] + v0[3] * v0[3])) + ((v1[0] * v1[0] + v1[1] * v1[1]) + (v1[2] * v1[2] + v1[3] * v1[3])));
            if (fq == 0) part[(rl0 + ai * HALF + m * 16) * 4 + wc] = ss; }
        const float* gp = gk + wc * 32 + 8 * fq; const f32x4 g0 = *(const f32x4*)gp, g1 = *(const f32x4*)(gp + 4);
        const f32x4 gr1a = *(const f32x4*)(gk + 128 + 8 * fq), gr1b = *(const f32x4*)(gk + 128 + 8 * fq + 4), gr2a = *(const f32x4*)(gk + 160 + 8 * fq), gr2b = *(const f32x4*)(gk + 160 + 8 * fq + 4);
        asm volatile("s_waitcnt lgkmcnt(0)" ::: "memory"); __builtin_amdgcn_s_barrier(); asm volatile("" ::: "memory");
        u32x4 kr1[2], kr2[2]; f32x4 c1[2], c2[2], s1[2], s2[2];
#pragma unroll
        for (int aj = 0; aj < 2; ++aj) { const int row = u.pm * BM + rl0 + aj * HALF + wc * 16, s = row & (8192 - 1);
            kr1[aj] = *(const u32x4*)(KR + (size_t)row * ldkr + 8 * fq); kr2[aj] = *(const u32x4*)(KR + (size_t)row * ldkr + 32 + 8 * fq);
            c1[aj] = *(const f32x4*)(RT + s * 64 + 8 * fq); c2[aj] = *(const f32x4*)(RT + s * 64 + 8 * fq + 4); s1[aj] = *(const f32x4*)(RT + s * 64 + 32 + 8 * fq); s2[aj] = *(const f32x4*)(RT + s * 64 + 32 + 8 * fq + 4); }
#pragma unroll
        for (int q = 0; q < 8; ++q) { const int ai = q >> 2, m = q & 3, rl = rl0 + ai * HALF + m * 16, row = u.pm * BM + rl, b = row >> 13, s = row & (8192 - 1);
            const f32x4 pp = *(const PG8_LAS f32x4*)(part + rl * 4); const float rkv = rkvl[rl], sk = sskl[rl];
            const float rs = rsqrtf((rkv * rkv * ((pp[0] + pp[1]) + (pp[2] + pp[3])) + sk) * (1.f / 192.f) + 1e-6f), kn = rkv * rs;
            const size_t tb = (size_t)(b * 8 + h) * 8192 + s;
            { const f32x4 x0 = acc[ai][0][m][0] * g0 * kn, x1 = acc[ai][0][m][1] * g1 * kn; u32x4 w; w.x = cvt_pk_bf16(x0[0], x0[1]); w.y = cvt_pk_bf16(x0[2], x0[3]); w.z = cvt_pk_bf16(x1[0], x1[1]); w.w = cvt_pk_bf16(x1[2], x1[3]);
              *(u32x4*)(K + tb * 192 + wc * 32 + 8 * fq) = w; }
            { const f32x4 x0 = acc[ai][1][m][0] * rkv, x1 = acc[ai][1][m][1] * rkv; u32x4 w; w.x = cvt_pk_bf16(x0[0], x0[1]); w.y = cvt_pk_bf16(x0[2], x0[3]); w.z = cvt_pk_bf16(x1[0], x1[1]); w.w = cvt_pk_bf16(x1[2], x1[3]);
              *(u32x4*)(V + tb * 128 + wc * 32 + 8 * fq) = w; }
            PG8_ZACC(acc[ai][0][m][0]); PG8_ZACC(acc[ai][0][m][1]); PG8_ZACC(acc[ai][1][m][0]); PG8_ZACC(acc[ai][1][m][1]); }
#pragma unroll
        for (int aj = 0; aj < 2; ++aj) { const int rl = rl0 + aj * HALF + wc * 16, row = u.pm * BM + rl, b = row >> 13, s = row & (8192 - 1);
            const f32x4 pp = *(const PG8_LAS f32x4*)(part + rl * 4); const float rkv = rkvl[rl], sk = sskl[rl];
            const float rs = rsqrtf((rkv * rkv * ((pp[0] + pp[1]) + (pp[2] + pp[3])) + sk) * (1.f / 192.f) + 1e-6f);
            const f32x4 a1 = (f32x4){bf_lo(kr1[aj].x), bf_hi(kr1[aj].x), bf_lo(kr1[aj].y), bf_hi(kr1[aj].y)} * gr1a * rs, b1 = (f32x4){bf_lo(kr1[aj].z), bf_hi(kr1[aj].z), bf_lo(kr1[aj].w), bf_hi(kr1[aj].w)} * gr1b * rs;
            const f32x4 a2 = (f32x4){bf_lo(kr2[aj].x), bf_hi(kr2[aj].x), bf_lo(kr2[aj].y), bf_hi(kr2[aj].y)} * gr2a * rs, b2 = (f32x4){bf_lo(kr2[aj].z), bf_hi(kr2[aj].z), bf_lo(kr2[aj].w), bf_hi(kr2[aj].w)} * gr2b * rs;
            const f32x4 oa1 = a1 * c1[aj] - a2 * s1[aj], ob1 = b1 * c2[aj] - b2 * s2[aj], oa2 = a2 * c1[aj] + a1 * s1[aj], ob2 = b2 * c2[aj] + b1 * s2[aj];
            bf16_t* kp = K + ((size_t)(b * 8 + h) * 8192 + s) * 192;
            u32x4 w; w.x = cvt_pk_bf16(oa1[0], oa1[1]); w.y = cvt_pk_bf16(oa1[2], oa1[3]); w.z = cvt_pk_bf16(ob1[0], ob1[1]); w.w = cvt_pk_bf16(ob1[2], ob1[3]); *(u32x4*)(kp + 128 + 8 * fq) = w;
            w.x = cvt_pk_bf16(oa2[0], oa2[1]); w.y = cvt_pk_bf16(oa2[2], oa2[3]); w.z = cvt_pk_bf16(ob2[0], ob2[1]); w.w = cvt_pk_bf16(ob2[2], ob2[3]); *(u32x4*)(kp + 160 + 8 * fq) = w; }
    }
};
}
struct Args { const float* in[25]; float* out; unsigned char* ws; int ph_lo, ph_hi; };
constexpr int NPHASE = 16;
__global__ void __launch_bounds__(NTHR, 2) mega_fwd(Args args) {
    extern __shared__ __attribute__((aligned(16))) unsigned char lds[];
    Frame F;
    F.lds = (LAS unsigned char*)lds;
    F.MISC = (volatile LAS unsigned*)(F.lds + MISC_OFF);
    F.tid = threadIdx.x; F.lane = F.tid & 63; F.wave = __builtin_amdgcn_readfirstlane(F.tid >> 6);
    F.G = gridDim.x; { const int bx = blockIdx.x; F.vcu = (F.G % 8 == 0) ? (bx % 8) * (F.G / 8) + bx / 8 : bx; }
#pragma unroll
    for (int i = 0; i < 25; ++i) F.in[i] = args.in[i];
    F.out = args.out; F.ws = args.ws;
    F.ctl = (gu32*)(F.ws + WS_CTL);
    for (int u = F.tid; u < (LDS_BYTES - LDSCTL_OFF) / 4; u += NTHR) ((LAS unsigned*)(F.lds + LDSCTL_OFF))[u] = 0u;
    __syncthreads();
    const int lo = args.ph_lo, hi = args.ph_hi;
    const bool multi = (hi - lo) > 1;
    XcdBarrier bar; bar.bar = (unsigned*)(F.ctl + CW_BAR); bar.x = 0; bar.st = nullptr;
    if (multi) bar = xcd_barrier_post((unsigned*)(F.ctl + CW_BAR), F.MISC + 8);
#ifndef PH_MASK
#define PH_MASK 0xFFFFFF
#endif
#define IN(k) (((PH_MASK >> (k)) & 1) && lo <= (k) && (k) < hi)
#define SEAM(k) do { if (IN(k) && IN((k) + 1)) xcd_barrier(bar); } while (0)
    using namespace pg8;
    bf16* PROJ = WSP(bf16, WS_PROJ);
    if (IN(0)) { p0_prologue(F); } SEAM(0);
    if (IN(1)) { Gemm g{WSP(bf16, WS_XN), WSP(bf16, WS_WIN), T, IN_PAD, DM / 2, DM / 2, 0x7b7b7b7b, 0x76767676}; StaticOrder S;
        S.init(T, IN_PAD, F.G, (int)blockIdx.x);
        EpiPerm8<FStoreProj> E{{PROJ, IN_PAD, WSP(bf16, WS_QLAT), WSP(bf16, WS_KVLAT)}}; gemm_phase<EpiPerm8<FStoreProj>, StaticOrder, true, true, true>(F.lds + RING_OFF, g, S, E);
        p0_deferred(F, ((T / 256) * (IN_PAD / 256)) % F.G); } SEAM(1);
    if (IN(2)) {
        { Gemm g{WSP(bf16, WS_QLAT), WSP(bf16, WS_WQ), T, MLA_H * QKD, QRANK, QRANK}; StaticOrder S; S.init(T, MLA_H * QKD, F.G, (int)blockIdx.x);
          EpiQUp E{F.in[I_GQKQ], F.ws}; gemm_phase<EpiQUp, StaticOrder, true, true>(F.lds + RING_OFF, g, S, E); }
        { Gemm g{WSP(bf16, WS_KVLAT), WSP(bf16, WS_WKV), T, MLA_H * 256, KVRANK, KVRANK}; StaticOrder S; S.init(T, MLA_H * 256, F.G, (int)blockIdx.x);
          EpiKVUp E{F.in[I_GQKK], F.ws, (LAS float*)(F.lds + LDSCTL_OFF + 1024)};
          gemm_phase<EpiKVUp, StaticOrder, true, true>(F.lds + RING_OFF, g, S, E); }
        p2_rq(F);
        p5a_conv(F); } SEAM(2);
    if (IN(4)) { p5_ssd_c1(F); } SEAM(4);
    if (IN(5)) { p4_attn_dma(F); }
    if (IN(6)) { p6_ssd_scan(F); } SEAM(6);
    if (IN(7)) { p7_ssd_c3(F); } SEAM(7);
    if (IN(8)) { Gemm g{WSP(bf16, WS_YN), WSP(bf16, WS_WSSD), T, DM, DM, DM}; StaticOrder S; S.init(T, DM, F.G, (int)blockIdx.x);
        EpiPipe8<GGate1> E{{PROJ + OFF_GATE, IN_PAD, WSP(bf16, WS_MRG), DM}}; gemm_phase<EpiPipe8<GGate1>, StaticOrder, true, true>(F.lds + RING_OFF, g, S, E); }
    if (IN(9)) { Gemm g{WSP(bf16, WS_OATT), WSP(bf16, WS_WMLA), T, DM, DM, DM}; StaticOrder S; S.init(T, DM, F.G, (int)blockIdx.x);
        EpiPipe8<GGate2> E{{PROJ + OFF_GATE + DM, IN_PAD, WSP(bf16, WS_MRG), DM}}; gemm_phase<EpiPipe8<GGate2>, StaticOrder, true, true>(F.lds + RING_OFF, g, S, E); } SEAM(9);
    if (IN(10)) { Gemm g{WSP(bf16, WS_MRG), WSP(bf16, WS_WO), T, DM, DM, DM}; StaticOrder S; S.init(T, DM, F.G, (int)blockIdx.x);
        EpiPipe8<GResF32> E{{F.in[I_X], F.out, DM}}; gemm_phase<EpiPipe8<GResF32>, StaticOrder, true, true>(F.lds + RING_OFF, g, S, E); } SEAM(10);
    if (IN(11)) { p11_router(F); } SEAM(11);
    if (IN(12)) { p12_slots(F); } SEAM(12);
    if (IN(13)) { const int* MTE = WSP(int, WS_MTE); const int nmt = MTE[MT_MAX]; Gemm g{WSP(bf16, WS_XN), WSP(bf16, WS_WGU), nmt * 256, 2 * FF, DM / 2, DM / 2, 0x7b7b7b7b, 0x76767676};
        MoeOrder S; S.init(nmt, 2 * FF, F.G, (int)blockIdx.x, WSP(int, WS_ROWTOK), MTE, (size_t)2 * FF * DM);
        EpiGateUp E{F.in[I_BGU], MTE, WSP(unsigned char, WS_ACT)}; gemm_phase<EpiGateUp, MoeOrder, true, true, true>(F.lds + RING_OFF, g, S, E); } SEAM(13);
    if (IN(14)) { const int* MTE = WSP(int, WS_MTE); const int nmt = MTE[MT_MAX]; Gemm g{WSP(bf16, WS_ACT), WSP(bf16, WS_WDN), nmt * 256, DM, FF / 2, FF / 2, 0x7d7d7d7d, 0x76767676};
        MoeOrder S; S.init(nmt, DM, F.G, (int)blockIdx.x, nullptr, MTE, (size_t)DM * FF);
        EpiDown E{F.in[I_BDN], MTE, WSP(bf16, WS_YS)}; gemm_phase<EpiDown, MoeOrder, true, true, true>(F.lds + RING_OFF, g, S, E); } SEAM(14);
    if (IN(15)) { p15_combine(F); }
#undef IN
#undef SEAM
}

#ifndef MK_SINGLE
#define MK_SINGLE 1
#endif
extern "C" void kernel_launch(void* const* d_in, const int* in_sizes, int n_in, void* d_out, int out_size, void* d_ws, size_t ws_size, hipStream_t stream) {
    static int grid = 0;
    if (grid == 0) {
        if (n_in != 25 || in_sizes[0] != T * DM || out_size != T * DM || ws_size < WS_END) { fprintf(stderr, "kernel_launch: unexpected shapes (n_in %d, in0 %d, out %d, ws %zu); nothing launched\n", n_in, n_in > 0 ? in_sizes[0] : -1, out_size, ws_size); grid = -1; return; }
        int dev = 0, cus = 0;
        if (hipGetDevice(&dev) != hipSuccess || hipDeviceGetAttribute(&cus, hipDeviceAttributeMultiprocessorCount, dev) != hipSuccess) { grid = -1; return; }
        if (hipFuncSetAttribute((const void*)mega_fwd, hipFuncAttributeMaxDynamicSharedMemorySize, LDS_BYTES) != hipSuccess) { fprintf(stderr, "kernel_launch: hipFuncSetAttribute failed\n"); grid = -1; return; }
        (void)hipGetLastError();
        int per_cu = 0;
        if (hipOccupancyMaxActiveBlocksPerMultiprocessor(&per_cu, (const void*)mega_fwd, NTHR, LDS_BYTES) != hipSuccess || per_cu < 1) { fprintf(stderr, "kernel_launch: occupancy query says the workgroup does not fit a CU\n"); grid = -1; return; }
        grid = cus;
    }
    if (grid < 0) return;
    unsigned char* const ws_base = (unsigned char*)d_ws + ((ws_size - WS_END) & ~((size_t)(2u << 20) - 1));
    if (hipMemsetAsync((char*)ws_base + WS_CTL, 0, CTL_ZERO_BYTES, stream) != hipSuccess) return;
    Args a{};
    for (int i = 0; i < 25; ++i) a.in[i] = (const float*)d_in[i];
    a.out = (float*)d_out; a.ws = ws_base;
    if (MK_SINGLE) { a.ph_lo = 0; a.ph_hi = NPHASE; hipLaunchKernelGGL(mega_fwd, dim3(grid), dim3(NTHR), LDS_BYTES, stream, a);
#ifdef PROBE_PHASE
        a.ph_lo = PROBE_PHASE; a.ph_hi = PROBE_PHASE + 1; hipLaunchKernelGGL(mega_fwd, dim3(grid), dim3(NTHR), LDS_BYTES, stream, a);
#endif
    }
    else for (int p = 0; p < NPHASE; ++p) { a.ph_lo = p; a.ph_hi = p + 1; hipLaunchKernelGGL(mega_fwd, dim3(grid), dim3(NTHR), LDS_BYTES, stream, a); }
}
```
